# Optimizing an MI355X kernel written in HIP

```python
import math
import jax, jax.numpy as jnp
from jax import lax
import numpy as np

D_MODEL = 1024
BATCH = 2
SEQ = 16384
DEPTH = 4

GRID_W = 64
CTX_LEN = 256
N_MIXERS = 3
N_LAYERS_A = (DEPTH + 2) // 3
N_LAYERS_B = (DEPTH + 1) // 3
N_LAYERS_C = DEPTH // 3
EPS = 1e-6
N_MOD = 6
ROPE_BASE = 10000.0

DA_HEAD_DIM = 64
DA_V_DIM = 2 * DA_HEAD_DIM
DA_HEADS = D_MODEL // DA_V_DIM
Q_BLOCK = 128

RET_QK_DIM = 256
RET_HEADS = D_MODEL // RET_QK_DIM
RET_V_DIM = 2 * RET_QK_DIM
RET_CHUNK = 128

HY_ORDER = 2
HY_EMB = 33
HY_BANDS = (HY_EMB - 1) // 2
HY_FFN = 64
HY_TARGET = 1e-2
HY_FAST_DECAY_PCT = 0.3
HY_SLOW_DECAY_PCT = 1.5

N_EXPERTS = 16
EC_CAPACITY_FACTOR = 2
D_EXPERT = D_MODEL

kernel_name = "hybrid_diffattn_retention_hyena_ec_moe"

F32 = jnp.float32


def rms_norm(x, g):
    xf = x.astype(F32)
    y = xf * lax.rsqrt(jnp.mean(xf * xf, axis=-1, keepdims=True) + EPS)
    return (y * g.astype(F32)).astype(x.dtype)


def modulate(x, g, shift, scale):
    return rms_norm(x, g) * (1.0 + scale) + shift


def rope(x, cos, sin):
    n, A, F = cos.shape
    xr = x.astype(F32).reshape(x.shape[:-1] + (A, 2, F))
    x1, x2 = xr[..., 0, :], xr[..., 1, :]
    out = jnp.stack([x1 * cos - x2 * sin, x2 * cos + x1 * sin], axis=-2)
    return out.reshape(x.shape).astype(x.dtype)


def axial_rope_tables(rows, dim):
    f = dim // 4
    inv = 1.0 / (ROPE_BASE ** (jnp.arange(f, dtype=F32) / f))
    row = jnp.repeat(jnp.arange(rows), GRID_W).astype(F32)
    col = jnp.tile(jnp.arange(GRID_W), rows).astype(F32)
    ang = jnp.stack([row[:, None] * inv, col[:, None] * inv], axis=1)
    return jnp.cos(ang), jnp.sin(ang)


def retention_rope_tables(n):
    f = RET_QK_DIM // 2
    inv = 1.0 / (ROPE_BASE ** jnp.linspace(0.0, 1.0, f, dtype=F32))
    ang = jnp.arange(n, dtype=F32)[:, None] * inv
    return jnp.cos(ang)[:, None, :], jnp.sin(ang)[:, None, :]


def diff_attention(hc, hl, w_in, q_g, k_g, lam, sub_g, w_out, lambda_init, cos, sin, need_ctx):
    B, L, _ = hl.shape
    H, dh, dv = DA_HEADS, DA_HEAD_DIM, DA_V_DIM

    def project(h, rotate):
        n = h.shape[1]
        q, k, v = jnp.split(h @ w_in, [H * 2 * dh, 2 * H * 2 * dh], axis=-1)
        q = rms_norm(q.reshape(B, n, H, 2, dh), q_g).transpose(0, 2, 3, 1, 4)
        k = rms_norm(k.reshape(B, n, H, 2, dh), k_g).transpose(0, 2, 3, 1, 4)
        v = v.reshape(B, n, H, dv).transpose(0, 2, 1, 3)
        if rotate:
            q, k = rope(q, cos, sin), rope(k, cos, sin)
        return q, k, v

    q_c, k_c, v_c = project(hc, False)
    q_l, k_l, v_l = project(hl, True)
    lamf = lam.astype(F32)
    lam_val = jnp.exp(jnp.sum(lamf[0] * lamf[1])) - jnp.exp(jnp.sum(lamf[2] * lamf[3])) + lambda_init
    scale = dh ** -0.5

    def attend(q, k, v):
        s = jnp.einsum('bhcqd,bhckd->bhcqk', q, k).astype(F32) * scale
        p = jax.nn.softmax(s, axis=-1)
        a = p[:, :, 0] - lam_val * p[:, :, 1]
        return jnp.einsum('bhqk,bhkd->bhqd', a.astype(v.dtype), v)

    k_all = jnp.concatenate([k_c, k_l], axis=3)
    v_all = jnp.concatenate([v_c, v_l], axis=2)
    nb = L // Q_BLOCK
    qb = q_l.reshape(B, H, 2, nb, Q_BLOCK, dh).transpose(3, 0, 1, 2, 4, 5)
    ob = lax.map(lambda qblk: attend(qblk, k_all, v_all), qb)
    o_l = ob.transpose(1, 2, 0, 3, 4).reshape(B, H, L, dv)

    def finish(o):
        n = o.shape[2]
        o = rms_norm(o, sub_g) * (1.0 - lambda_init)
        return o.transpose(0, 2, 1, 3).reshape(B, n, H * dv) @ w_out

    out_c = finish(attend(q_c, k_c, v_c)) if need_ctx else None
    return out_c, finish(o_l)


def retention_chunks(q, k, v, log_g, state0, strict):
    B, H, N, dk = q.shape
    dv = v.shape[-1]
    T = RET_CHUNK
    nc = N // T
    i = jnp.arange(T, dtype=F32)
    diff = i[:, None] - i[None, :]
    mask = (diff > 0) if strict else (diff >= 0)
    dmask = jnp.where(mask[None], jnp.exp(jnp.where(mask, diff, 0.0)[None] * log_g[:, None, None]), 0.0)
    xi = jnp.exp((i + 1.0)[None] * log_g[:, None])[..., None]
    zeta = jnp.exp((T - 1.0 - i)[None] * log_g[:, None])[..., None]
    chunk_decay = jnp.exp(T * log_g)[:, None, None]

    def to_chunks(a):
        return a.reshape(B, H, nc, T, a.shape[-1]).transpose(2, 0, 1, 3, 4)

    def step(state, qkv):
        qc, kc, vc = qkv
        inner = jnp.einsum('bhid,bhjd->bhij', qc, kc) * dmask
        o = jnp.einsum('bhij,bhjd->bhid', inner, vc) + jnp.einsum('bhid,bhde->bhie', qc, state) * xi
        state = state * chunk_decay + jnp.einsum('bhjd,bhje->bhde', kc * zeta, vc)
        return state, o

    _, o = lax.scan(step, state0, (to_chunks(q), to_chunks(k), to_chunks(v)))
    return o.transpose(1, 2, 0, 3, 4).reshape(B, H, N, dv)


def retention_final_state(k, v, log_g):
    n = k.shape[2]
    w = jnp.exp((n - 1.0 - jnp.arange(n, dtype=F32))[None] * log_g[:, None])[..., None]
    return jnp.einsum('bhnd,bhne->bhde', k * w, v)


def retention(hc, hl, w_in, log_alpha, gn_g, w_out, cos, sin, need_ctx):
    B, L, _ = hl.shape
    H, dk, dv = RET_HEADS, RET_QK_DIM, RET_V_DIM
    log_g = jnp.log1p(-jnp.exp(log_alpha.astype(F32)))

    def project(h, rotate):
        n = h.shape[1]
        q, k, v, g = jnp.split(h @ w_in, [H * dk, 2 * H * dk, 2 * H * dk + H * dv], axis=-1)
        q = q.reshape(B, n, H, dk).transpose(0, 2, 1, 3).astype(F32)
        k = k.reshape(B, n, H, dk).transpose(0, 2, 1, 3).astype(F32) * (dk ** -0.5)
        v = v.reshape(B, n, H, dv).transpose(0, 2, 1, 3).astype(F32)
        if rotate:
            q, k = rope(q, cos, sin), rope(k, cos, sin)
        return q, k, v, g

    def flip(a):
        return jnp.flip(a, axis=2)

    q_c, k_c, v_c, g_c = project(hc, False)
    q_l, k_l, v_l, g_l = project(hl, True)
    s_f = retention_final_state(k_c, v_c, log_g[0])
    s_b = retention_final_state(flip(k_c), flip(v_c), log_g[1])

    def both_dirs(q, k, v, s0f, s0b):
        of = retention_chunks(q, k, v, log_g[0], s0f, False)
        ob = flip(retention_chunks(flip(q), flip(k), flip(v), log_g[1], s0b, True))
        return of + ob

    def finish(y, g):
        n = y.shape[2]
        y = rms_norm(y, gn_g).transpose(0, 2, 1, 3).reshape(B, n, H * dv)
        return (jax.nn.silu(g) * y.astype(g.dtype)) @ w_out

    out_l = finish(both_dirs(q_l, k_l, v_l, s_f, s_b), g_l)
    if need_ctx:
        zero = jnp.zeros_like(s_f)
        out_c = finish(both_dirs(q_c, k_c, v_c, zero, zero), g_c)
    else:
        out_c = None
    return out_c, out_l


def short_conv(u, w, b):
    n = u.shape[1]
    up = jnp.pad(u, ((0, 0), (1, 1), (0, 0)))
    return up[:, :n] * w[0] + up[:, 1:n + 1] * w[1] + up[:, 2:] * w[2] + b


def hyena_filter_spectra(n, w1, b1, w2, b2, freq, w3):
    t = jnp.linspace(0.0, 1.0, n, dtype=F32)[:, None]
    w = 2.0 * math.pi * jnp.arange(n, dtype=F32)[:, None] / n
    f = jnp.linspace(1e-4, HY_BANDS - 1, HY_BANDS, dtype=F32)[None]
    z = jnp.concatenate([t, jnp.cos(f * w), -jnp.sin(f * w)], axis=-1)
    a = jnp.sin(freq[0].astype(F32) * (z @ w1.astype(F32) + b1.astype(F32)))
    a = jnp.sin(freq[1].astype(F32) * (a @ w2.astype(F32) + b2.astype(F32)))
    C = w3.shape[-1] // (2 * HY_ORDER)
    h = (a @ w3.astype(F32)).reshape(n, HY_ORDER, 2, C)
    max_decay = math.log(HY_TARGET) / HY_FAST_DECAY_PCT
    min_decay = math.log(HY_TARGET) / HY_SLOW_DECAY_PCT
    deltas = jnp.abs(jnp.linspace(min_decay, max_decay, C, dtype=F32))
    h = h * jnp.exp(-t * deltas)[:, None, None, :]
    buf = jnp.concatenate([h[:, :, 0], jnp.zeros((1, HY_ORDER, C), F32),
                           jnp.flip(h[1:, :, 1], axis=0)], axis=0)
    buf = buf / jnp.sum(jnp.abs(buf), axis=0, keepdims=True)
    return jnp.fft.rfft(buf, axis=0)


def fft_long_conv(u, hf, bias):
    n = u.shape[1]
    uf = u.astype(F32)
    y = jnp.fft.irfft(jnp.fft.rfft(uf, n=2 * n, axis=1) * hf[None], n=2 * n, axis=1)[:, :n]
    return (y + uf * bias.astype(F32)).astype(u.dtype)


def hyena(h, w_in, b_in, conv_w, conv_b, w1, b1, w2, b2, freq, w3, fbias, w_out, b_out):
    n = h.shape[1]
    v, x1, x2 = jnp.split(short_conv(h @ w_in + b_in, conv_w, conv_b), 3, axis=-1)
    hf = hyena_filter_spectra(n, w1, b1, w2, b2, freq, w3)
    z = x1 * fft_long_conv(v, hf[:, 0], fbias[0])
    z = x2 * fft_long_conv(z, hf[:, 1], fbias[1])
    return z @ w_out + b_out


def expert_choice_ffn(h, router_w, w1, w3, w2):
    B, n, D = h.shape
    cap = EC_CAPACITY_FACTOR * n // N_EXPERTS
    aff = jax.nn.softmax((h @ router_w).astype(F32), axis=-1)
    gate, idx = lax.top_k(aff.transpose(0, 2, 1), cap)
    xg = jax.vmap(lambda hb, ib: hb[ib])(h, idx)
    hid = jax.nn.silu(jnp.einsum('becd,edf->becf', xg, w1)) * jnp.einsum('becd,edf->becf', xg, w3)
    y = jnp.einsum('becf,efd->becd', hid, w2) * gate[..., None].astype(h.dtype)
    return jax.vmap(lambda ib, yb: jnp.zeros((n, D), h.dtype).at[ib.reshape(-1)].add(yb.reshape(-1, D)))(idx, y)


def setup_inputs(seed: int = 0) -> dict:
    key = jax.random.key(seed)
    ks = iter(jax.random.split(key, 48))
    D, E, F = D_MODEL, N_EXPERTS, D_EXPERT

    def nrm(shape, scale=1.0):
        return jax.random.normal(next(ks), shape, F32) * scale

    def gain(shape):
        return 1.0 + nrm(shape, 0.02)

    ret_base = -(5.0 + jnp.arange(RET_HEADS, dtype=F32)) * math.log(2.0)
    return {
        "x": nrm((BATCH, SEQ, D)),
        "c": nrm((BATCH, D)),
        "ctx": nrm((BATCH, CTX_LEN, D)),
        "c_ctx": nrm((D,)),
        "norm_mix_g": gain((DEPTH, D)),
        "norm_ffn_g": gain((DEPTH, D)),
        "mod_w": nrm((DEPTH, D, N_MOD * D), 0.5 * D ** -0.5),
        "mod_b": nrm((DEPTH, N_MOD * D), 0.02),
        "da_w_in": nrm((N_LAYERS_A, D, 3 * D), D ** -0.5),
        "da_q_norm": gain((N_LAYERS_A, DA_HEAD_DIM)),
        "da_k_norm": gain((N_LAYERS_A, DA_HEAD_DIM)),
        "da_lambda": nrm((N_LAYERS_A, 4, DA_HEAD_DIM), 0.1),
        "da_sub_norm": gain((N_LAYERS_A, DA_V_DIM)),
        "da_w_out": nrm((N_LAYERS_A, D, D), D ** -0.5),
        "ret_w_in": nrm((N_LAYERS_B, D, 2 * RET_HEADS * RET_QK_DIM + 2 * RET_HEADS * RET_V_DIM), D ** -0.5),
        "ret_log_alpha": ret_base + nrm((N_LAYERS_B, 2, RET_HEADS), 0.05),
        "ret_group_norm": gain((N_LAYERS_B, RET_V_DIM)),
        "ret_w_out": nrm((N_LAYERS_B, RET_HEADS * RET_V_DIM, D), (RET_HEADS * RET_V_DIM) ** -0.5),
        "hy_w_in": nrm((N_LAYERS_C, D, 3 * D), D ** -0.5),
        "hy_b_in": nrm((N_LAYERS_C, 3 * D), 0.02),
        "hy_conv_w": nrm((N_LAYERS_C, 3, 3 * D), 3 ** -0.5),
        "hy_conv_b": nrm((N_LAYERS_C, 3 * D), 0.02),
        "hy_ffn_w1": nrm((N_LAYERS_C, HY_EMB, HY_FFN), HY_EMB ** -0.5),
        "hy_ffn_b1": nrm((N_LAYERS_C, HY_FFN), 0.02),
        "hy_ffn_w2": nrm((N_LAYERS_C, HY_FFN, HY_FFN), HY_FFN ** -0.5),
        "hy_ffn_b2": nrm((N_LAYERS_C, HY_FFN), 0.02),
        "hy_sin_freq": 1.0 + nrm((N_LAYERS_C, 2, HY_FFN), 0.1),
        "hy_ffn_w3": nrm((N_LAYERS_C, HY_FFN, 2 * HY_ORDER * D), HY_FFN ** -0.5),
        "hy_filter_bias": nrm((N_LAYERS_C, HY_ORDER, D)),
        "hy_w_out": nrm((N_LAYERS_C, D, D), D ** -0.5),
        "hy_b_out": nrm((N_LAYERS_C, D), 0.02),
        "router_w": nrm((DEPTH, D, E), D ** -0.5),
        "exp_w1": nrm((DEPTH, E, D, F), D ** -0.5),
        "exp_w3": nrm((DEPTH, E, D, F), D ** -0.5),
        "exp_w2": nrm((DEPTH, E, F, D), F ** -0.5),
    }


def reference(x, c, ctx, c_ctx, norm_mix_g, norm_ffn_g, mod_w, mod_b,
              da_w_in, da_q_norm, da_k_norm, da_lambda, da_sub_norm, da_w_out,
              ret_w_in, ret_log_alpha, ret_group_norm, ret_w_out,
              hy_w_in, hy_b_in, hy_conv_w, hy_conv_b, hy_ffn_w1, hy_ffn_b1, hy_ffn_w2, hy_ffn_b2,
              hy_sin_freq, hy_ffn_w3, hy_filter_bias, hy_w_out, hy_b_out,
              router_w, exp_w1, exp_w3, exp_w2):
    B, L, D = x.shape
    ROWS = L // GRID_W
    a_cos, a_sin = axial_rope_tables(ROWS, DA_HEAD_DIM)
    r_cos, r_sin = retention_rope_tables(L)
    silu_c = jax.nn.silu(c)
    silu_cc = jax.nn.silu(c_ctx)
    for i in range(DEPTH):
        last = i == DEPTH - 1
        m, s = i % N_MIXERS, i // N_MIXERS
        sh_l, sc_l, g_l, sh2_l, sc2_l, g2_l = jnp.split((silu_c @ mod_w[i] + mod_b[i])[:, None, :], N_MOD, axis=-1)
        sh_c, sc_c, g_c, sh2_c, sc2_c, g2_c = jnp.split(silu_cc @ mod_w[i] + mod_b[i], N_MOD, axis=-1)
        hl = modulate(x, norm_mix_g[i], sh_l, sc_l)
        if m == 0:
            hc = modulate(ctx, norm_mix_g[i], sh_c, sc_c)
            lambda_init = 0.8 - 0.6 * math.exp(-0.3 * i)
            oc, ol = diff_attention(hc, hl, da_w_in[s], da_q_norm[s], da_k_norm[s], da_lambda[s],
                                    da_sub_norm[s], da_w_out[s], lambda_init, a_cos, a_sin, not last)
        elif m == 1:
            hc = modulate(ctx, norm_mix_g[i], sh_c, sc_c)
            oc, ol = retention(hc, hl, ret_w_in[s], ret_log_alpha[s], ret_group_norm[s], ret_w_out[s],
                               r_cos, r_sin, not last)
        else:
            hy_p = (hy_w_in[s], hy_b_in[s], hy_conv_w[s], hy_conv_b[s], hy_ffn_w1[s], hy_ffn_b1[s],
                    hy_ffn_w2[s], hy_ffn_b2[s], hy_sin_freq[s], hy_ffn_w3[s], hy_filter_bias[s],
                    hy_w_out[s], hy_b_out[s])
            ol = hyena(hl, *hy_p)
            oc = None if last else hyena(modulate(ctx, norm_mix_g[i], sh_c, sc_c), *hy_p)
        x = x + g_l * ol
        x = x + g2_l * expert_choice_ffn(modulate(x, norm_ffn_g[i], sh2_l, sc2_l),
                                         router_w[i], exp_w1[i], exp_w3[i], exp_w2[i])
        if not last:
            ctx = ctx + g_c * oc
            ctx = ctx + g2_c * expert_choice_ffn(modulate(ctx, norm_ffn_g[i], sh2_c, sc2_c),
                                                 router_w[i], exp_w1[i], exp_w3[i], exp_w2[i])
    return x
```

```cpp
#include <hip/hip_runtime.h>
#include <hip/hip_bf16.h>
#include <cstdio>
#include <cstdint>

#define LAS __attribute__((address_space(3)))
typedef __hip_bfloat16 bf16;
typedef __attribute__((ext_vector_type(8))) short bf16x8;
typedef __attribute__((ext_vector_type(4))) short s16x4;
typedef __attribute__((ext_vector_type(4))) float f32x4;
typedef __attribute__((ext_vector_type(16))) float f32x16;
typedef __attribute__((ext_vector_type(4))) unsigned u32x4;
typedef __attribute__((ext_vector_type(2))) unsigned u32x2;

constexpr int NB = 2, SEQL = 16384, CTX = 256, NTOK = SEQL + CTX, D = 1024, MALL = NB * NTOK;
constexpr int NTHR = 512;
constexpr int NEXP = 16, CAPL = 2048, CAPC = 32;
constexpr float EPS = 1e-6f;

enum { I_X = 0, I_C, I_CTX, I_CCTX, I_NMG, I_NFG, I_MODW, I_MODB, I_DAWIN, I_DAQN, I_DAKN, I_DALAM, I_DASUB, I_DAWOUT,
       I_RWIN, I_RLA, I_RGN, I_RWOUT, I_HWIN, I_HBIN, I_HCW, I_HCB, I_HW1, I_HB1, I_HW2, I_HB2, I_HFREQ, I_HW3, I_HFB, I_HWOUT, I_HBOUT,
       I_RTW, I_EW1, I_EW3, I_EW2, N_IN };

constexpr size_t AL(size_t x) { return (x + 255) / 256 * 256; }
constexpr size_t WS_CTL = 0;
constexpr size_t WS_RETC = 32768;
constexpr size_t WS_MODS = 65536;
constexpr size_t WS_CTXX = WS_MODS + AL(4 * 3 * 6144 * 4);
constexpr size_t WS_AFFL = WS_CTXX + AL((size_t)NB * CTX * D * 4);
constexpr size_t WS_AFFC = WS_AFFL + AL((size_t)NB * NEXP * SEQL * 4);
constexpr size_t WS_SLOTL = WS_AFFC + AL((size_t)NB * NEXP * CTX * 4);
constexpr size_t WS_SLOTC = WS_SLOTL + AL((size_t)NB * NEXP * SEQL * 4);
constexpr int NFLAT = NB * NEXP * CAPL + NB * NEXP * 256;
constexpr size_t WS_ROWS = WS_SLOTC + AL((size_t)NB * NEXP * CTX * 4);
constexpr size_t WS_GATEV = WS_ROWS + AL((size_t)NFLAT * 4);
constexpr size_t WS_RROPE = WS_GATEV + AL((size_t)NFLAT * 4);
constexpr size_t WS_AROPE = WS_RROPE + AL((size_t)SEQL * 128 * 8);
constexpr size_t WS_A2P = WS_AROPE + AL((size_t)320 * 16 * 8);
constexpr size_t WS_W3P = WS_A2P + AL((size_t)SEQL * 256 * 2);
constexpr size_t WS_A2C = WS_W3P + AL((size_t)4096 * 256 * 2);
constexpr size_t WS_WT = WS_A2C + AL((size_t)CTX * 64 * 4);
constexpr size_t WT_DAIN = 0, WT_DAOUT = WT_DAIN + 2ull * 3072 * 1024, WT_RIN = WT_DAOUT + 2ull * 1024 * 1024, WT_ROUT = WT_RIN + 6144ull * 1024,
                 WT_HIN = WT_ROUT + 1024ull * 2048, WT_HOUT = WT_HIN + 3072ull * 1024, WT_END = WT_HOUT + 1024ull * 1024;
constexpr size_t WS_SCR = WS_WT + AL(WT_END * 2);
constexpr size_t S_H = WS_SCR;
constexpr size_t S_B1 = S_H + AL((size_t)MALL * D * 2);
constexpr size_t S_QKV = S_B1;
constexpr size_t S_AO = S_QKV + AL((size_t)MALL * 3072 * 2);
constexpr size_t S_EXPW = S_B1;
constexpr size_t S_HID = S_EXPW + AL((size_t)NEXP * 3072 * 1024 * 2);
constexpr size_t S_Y = S_HID + AL((size_t)NFLAT * D * 2);
constexpr int RCH = 256, RNC = NTOK / RCH;
constexpr size_t R_Q = S_B1;
constexpr size_t R_KR = R_Q + AL((size_t)MALL * D * 2);
constexpr size_t R_KFT = R_KR + AL((size_t)MALL * D * 2);
constexpr size_t R_KBT = R_KFT + AL((size_t)8 * 256 * NTOK * 2);
constexpr size_t R_VT = R_KBT + AL((size_t)8 * 256 * NTOK * 2);
constexpr size_t R_SG = R_VT + AL((size_t)8 * 512 * NTOK * 2);
constexpr size_t R_ST = R_SG + AL((size_t)MALL * 2048 * 2);
constexpr size_t R_END = R_ST + AL((size_t)2 * 8 * 512 * NTOK * 2);
constexpr size_t R_P = S_H;
constexpr size_t R_O = R_KFT;
constexpr int FN = SEQL;
constexpr size_t H_PT = S_B1;
constexpr size_t H_HT = H_PT + AL((size_t)3072 * MALL * 2);
constexpr size_t H_ZT = H_HT + AL((size_t)4096 * FN * 2);
constexpr size_t H_Z = H_ZT + AL((size_t)1024 * MALL * 2);
constexpr size_t H_WG = H_Z + AL((size_t)MALL * D * 2);
constexpr size_t H_WG_BYTES = (size_t)9 * FN * 4;
constexpr size_t H_END = H_WG + 256 * H_WG_BYTES;
constexpr size_t WS_NEED_MOE = S_Y + AL((size_t)NFLAT * D * 2);
constexpr size_t WS_NEED = (R_END > WS_NEED_MOE ? R_END : WS_NEED_MOE) > H_END ? (R_END > WS_NEED_MOE ? R_END : WS_NEED_MOE) : H_END;

constexpr int LDS_BYTES = 147456 + 512;
constexpr int LDS_WTAB = 147456;

extern __shared__ __attribute__((aligned(16))) unsigned char lds_raw[];
__device__ __forceinline__ int lane_id_v() { int l; asm volatile("v_mbcnt_lo_u32_b32 %0, -1, 0\n\tv_mbcnt_hi_u32_b32 %0, -1, %0" : "=v"(l)); return l; }
__device__ __forceinline__ int wave_id_u() {
    const unsigned hw = (unsigned)__builtin_amdgcn_s_getreg((5 << 11) | 4) & 63u;
    return __builtin_amdgcn_readfirstlane(*(volatile LAS int*)((LAS unsigned char*)lds_raw + LDS_WTAB + hw * 4));
}
__device__ __forceinline__ int opaque_tid() { return wave_id_u() * 64 + lane_id_v(); }
#define TIDX opaque_tid()

#define XB_TMO      128
#define XB_XCNT(j)  (256  + 64 * (j))
#define XB_XSUB(j)  (1280 + 64 * (j))
#define XB_XGEN(j)  (2304 + 64 * (j))
#define XB_TOP      3328
#define XB_TOPGEN   3392
#define XCD_BAR_WORDS 3456
#define XB_SPIN_CAP (1u << 18)

__device__ __forceinline__ unsigned xb_ld(unsigned* p)              { return __hip_atomic_load(p, __ATOMIC_RELAXED, __HIP_MEMORY_SCOPE_AGENT); }
__device__ __forceinline__ unsigned xb_add(unsigned* p, unsigned v) { return __hip_atomic_fetch_add(p, v, __ATOMIC_RELAXED, __HIP_MEMORY_SCOPE_AGENT); }
__device__ __forceinline__ unsigned xb_xcc_id() { return (unsigned)__builtin_amdgcn_s_getreg((3 << 11) | 20) & 0xFu; }
#define XB_SPIN(cond, bar) do { unsigned _sp = 0; while (cond) { __builtin_amdgcn_s_sleep(1); \
    if ((++_sp & 255u) == 0u) { if (xb_ld(&(bar)[XB_TMO])) break; if (_sp > XB_SPIN_CAP) { atomicAdd(&(bar)[XB_TMO], 1u); break; } } } } while (0)

struct XcdBarrier { unsigned* bar; unsigned x; volatile LAS unsigned* st; };

__device__ __forceinline__ XcdBarrier xcd_barrier_post(unsigned* bar, volatile LAS unsigned* st) {
    XcdBarrier b; b.bar = bar; b.x = xb_xcc_id(); b.st = st;
    if (TIDX == 0) (void)xb_add(&bar[XB_XCNT(b.x)], 1u);
    return b;
}
__device__ __forceinline__ void xcd_barrier_complete(unsigned* bar, unsigned x, unsigned& nloc, unsigned& nx) {
    const unsigned G = gridDim.x * gridDim.y * gridDim.z;
    unsigned sum, cnt, mine, sp = 0u;
    for (;;) {
        sum = 0u; cnt = 0u; mine = 0u;
#pragma unroll
        for (unsigned j = 0; j < 16; ++j) { const unsigned c = xb_ld(&bar[XB_XCNT(j)]); sum += c; cnt += (c > 0u) ? 1u : 0u; mine = (j == x) ? c : mine; }
        if (sum == G) break;
        __builtin_amdgcn_s_sleep(1);
        if ((++sp & 255u) == 0u) { if (xb_ld(&bar[XB_TMO])) break; if (sp > XB_SPIN_CAP) { atomicAdd(&bar[XB_TMO], 1u); break; } }
    }
    nloc = mine > 0u ? mine : 1u; nx = cnt > 0u ? cnt : 1u;
}
__device__ __forceinline__ void xcd_barrier(const XcdBarrier& b) {
    asm volatile("s_waitcnt vmcnt(0)" ::: "memory");
    __syncthreads();
    if (TIDX == 0) {
        unsigned* bar = b.bar;
        __builtin_amdgcn_s_waitcnt(0);
        unsigned nloc = b.st[0], nx = b.st[1];
        if (nloc == 0u) { xcd_barrier_complete(bar, b.x, nloc, nx); b.st[0] = nloc; b.st[1] = nx; }
        const unsigned old = xb_add(&bar[XB_XSUB(b.x)], 1u);
        const unsigned gen = old / nloc;
        if (old + 1u == (gen + 1u) * nloc) {
            __builtin_amdgcn_fence(__ATOMIC_RELEASE, "agent");
            asm volatile("s_waitcnt vmcnt(0)" ::: "memory");
            const unsigned og = xb_add(&bar[XB_TOP], 1u);
            const unsigned tg = og / nx;
            if (og + 1u == (tg + 1u) * nx) xb_add(&bar[XB_TOPGEN], 1u);
            else XB_SPIN(xb_ld(&bar[XB_TOPGEN]) == tg, bar);
            __builtin_amdgcn_fence(__ATOMIC_ACQUIRE, "agent");
            xb_add(&bar[XB_XGEN(b.x)], 1u);
            asm volatile("s_waitcnt vmcnt(0)" ::: "memory");
        } else {
            XB_SPIN(xb_ld(&bar[XB_XGEN(b.x)]) == gen, bar);
            __builtin_amdgcn_fence(__ATOMIC_ACQUIRE, "agent");
            asm volatile("s_waitcnt vmcnt(0)" ::: "memory");
        }
    }
    __syncthreads();
}

__device__ __forceinline__ unsigned cvtpk(float lo, float hi) {
    unsigned r; asm volatile("v_cvt_pk_bf16_f32 %0, %1, %2" : "=v"(r) : "v"(lo), "v"(hi)); return r;
}
__device__ __forceinline__ unsigned short f2bf(float x) { return (unsigned short)(cvtpk(x, 0.f) & 0xffffu); }
__device__ __forceinline__ float bf2f(unsigned short u) { return __uint_as_float(((unsigned)u) << 16); }
__device__ __forceinline__ float wave_sum(float v) {
#pragma unroll
    for (int o = 32; o > 0; o >>= 1) v += __shfl_xor(v, o, 64);
    return v;
}
__device__ __forceinline__ float silu_f(float x) { return x / (1.f + __expf(-x)); }
__device__ __forceinline__ float silu_fast(float x) { return x * __builtin_amdgcn_rcpf(1.f + __expf(-x)); }

struct Args { const float* in[N_IN]; float* out; unsigned char* ws; int ph_lo, ph_hi; };

struct Ctx {
    const float* const* in; float* out; unsigned char* ws; char* lds;
    int tid, lane, wave, G, bid;
};

__device__ __forceinline__ float* xrow(const Ctx& F, int r) {
    const int b = r / NTOK, t = r - b * NTOK;
    return (t < CTX) ? (float*)(F.ws + WS_CTXX) + ((size_t)(b * CTX + t)) * D : F.out + ((size_t)(b * SEQL + (t - CTX))) * D;
}
__device__ __forceinline__ const float* xrow_in(const Ctx& F, int r) {
    const int b = r / NTOK, t = r - b * NTOK;
    return (t < CTX) ? F.in[I_CTX] + ((size_t)(b * CTX + t)) * D : F.in[I_X] + ((size_t)(b * SEQL + (t - CTX))) * D;
}
__device__ __forceinline__ int mod_sel(int r) { const int b = r / NTOK, t = r - b * NTOK; return (t < CTX) ? 2 : b; }

typedef f32x4 Acc[2][2][4][2];
struct GUnit { const char* a; const char* b; int id; };
constexpr int G_BK = 64, G_HALF = 128, G_HTB = G_HALF * G_BK * 2;
constexpr int GEMM_LDS = 8 * G_HTB;

__device__ __forceinline__ int g_lds_byte(int r, int c) {
    int st = (r >> 4) * 2 + (c >> 5), rr = r & 15, cc = c & 31, ob = rr * 64 + cc * 2;
    return st * 1024 + (ob ^ (((ob >> 9) & 1) << 5));
}
__device__ __forceinline__ void g_stage_rc(int b, int& R, int& C) {
    int st = b / 1024, sb = b % 1024, swz = sb ^ (((sb >> 9) & 1) << 5);
    R = (st >> 1) * 16 + swz / 64; C = (st & 1) * 32 + (swz % 64) / 2;
}
__device__ __forceinline__ void acc_zero(Acc& acc) {
#pragma unroll
    for (int ai = 0; ai < 2; ++ai)
#pragma unroll
        for (int bj = 0; bj < 2; ++bj)
#pragma unroll
            for (int m = 0; m < 4; ++m)
#pragma unroll
                for (int n = 0; n < 2; ++n) acc[ai][bj][m][n] = f32x4{0.f, 0.f, 0.f, 0.f};
}
#define WAIT_V(n) asm volatile("s_waitcnt vmcnt(" #n ")" ::: "memory")
#define WAIT_L(n) asm volatile("s_waitcnt lgkmcnt(" #n ")" ::: "memory")

typedef int v8i32 __attribute__((ext_vector_type(8)));
typedef short s16x16_t __attribute__((ext_vector_type(16)));
template <bool SWAP, class Sched, class Epi, bool GATHER = false, bool FP8 = false, bool PERMB = false>
__device__ __forceinline__ void gemm_phase(char* ldsp, const int lda, const int ldb, const int K, const Sched& S, const Epi& E) {
    LAS unsigned char* lds = (LAS unsigned char*)ldsp;
    const int tid = TIDX, wid = __builtin_amdgcn_readfirstlane(tid >> 6), lane = tid & 63, wr = wid >> 2, wc = wid & 3, fr = lane & 15, fq = lane >> 4;
    int nt = K / G_BK; asm volatile("" : "+s"(nt));
    unsigned voffA[2], voffB[2];
#pragma unroll
    for (int i = 0; i < 2; ++i) { int R, C; g_stage_rc(tid * 16 + i * 8192, R, C); voffA[i] = (unsigned)(R * lda + C) * 2u; voffB[i] = (unsigned)(R * ldb + C) * 2u; }
    unsigned voffBp[2][2] = {{0u, 0u}, {0u, 0u}};
    if (PERMB) {
#pragma unroll
        for (int h = 0; h < 2; ++h)
#pragma unroll
            for (int i = 0; i < 2; ++i) { int R, C; g_stage_rc(tid * 16 + i * 8192, R, C);
                const int L = ((R >> 5) & 3) * 64 + ((R >> 2) & 3) * 16 + h * 8 + ((R >> 4) & 1) * 4 + (R & 3); voffBp[h][i] = (unsigned)(L * ldb + C) * 2u; } }
    const size_t kstep = (size_t)(G_BK * 2);
    const size_t hstepA = (size_t)G_HALF * lda * 2, hstepB = (size_t)G_HALF * ldb * 2;
    const unsigned ldsw = (unsigned)wid * 1024u;
    const int aoff = g_lds_byte(wr * 64 + fr, FP8 ? fq * 16 : fq * 8), boff = g_lds_byte(wc * 32 + fr, FP8 ? fq * 16 : fq * 8);
#define PG_SA(b, h) (((b) * 2 + (h)) * G_HTB)
#define PG_STAGEB(bufoff, kp, h) do { if (PERMB) PG_STAGE(bufoff, kp, voffBp[h]); else PG_STAGE(bufoff, (const char*)(kp) + (h) * hstepB, voffB); } while (0)
#define PG_SB(b, h) ((4 + (b) * 2 + (h)) * G_HTB)
#define PG_STAGE(bufoff, gbase, voff) do { _Pragma("unroll") for (int _i = 0; _i < 2; ++_i) \
        __builtin_amdgcn_global_load_lds((const unsigned*)((const char*)(gbase) + (voff)[_i]), (LAS unsigned*)(lds + (bufoff) + ldsw + _i * 8192), 16, 0, 0); } while (0)
    unsigned vgC[4] = {0u, 0u, 0u, 0u}, vgN[4] = {0u, 0u, 0u, 0u};
    int gR[2]; { int C_; g_stage_rc(tid * 16, gR[0], C_); g_stage_rc(tid * 16 + 8192, gR[1], C_); }
#define PG_GLOAD(dst, u_) do { const int* rw_ = S.rows(u_); _Pragma("unroll") for (int h_ = 0; h_ < 2; ++h_) _Pragma("unroll") for (int i_ = 0; i_ < 2; ++i_) \
        dst[h_ * 2 + i_] = (unsigned)rw_[h_ * 128 + gR[i_]] * (unsigned)(lda * 2) + (voffA[i_] - (unsigned)(gR[i_] * lda * 2)); } while (0)
#define PG_STAGEA(bufoff, kp, h, NX) do { if (GATHER) { _Pragma("unroll") for (int _i = 0; _i < 2; ++_i) \
            __builtin_amdgcn_global_load_lds((const unsigned*)((const char*)(kp) + ((NX) ? vgN[(h) * 2 + _i] : vgC[(h) * 2 + _i])), (LAS unsigned*)(lds + (bufoff) + ldsw + _i * 8192), 16, 0, 0); } \
        else PG_STAGE(bufoff, (const char*)(kp) + (h) * hstepA, voffA); } while (0)
#define PG_CAT(P) __builtin_bit_cast(v8i32, (s16x16_t)__builtin_shufflevector(*(const LAS bf16x8*)(P), *(const LAS bf16x8*)((P) + 16), 0, 1, 2, 3, 4, 5, 6, 7, 8, 9, 10, 11, 12, 13, 14, 15))
#define PG_LDA(dst, b, h) do { if (FP8) { _Pragma("unroll") for (int m = 0; m < 4; ++m) dst##8[m] = PG_CAT(lds + PG_SA(b, h) + aoff + m * 2048); } \
        else { _Pragma("unroll") for (int m = 0; m < 4; ++m) _Pragma("unroll") for (int k = 0; k < 2; ++k) dst[m][k] = *(const LAS bf16x8*)(lds + PG_SA(b, h) + aoff + m * 2048 + k * 1024); } } while (0)
#define PG_LDB(dst, b, h) do { if (FP8) { _Pragma("unroll") for (int n = 0; n < 2; ++n) dst##8[n] = PG_CAT(lds + PG_SB(b, h) + boff + n * 2048); } \
        else { _Pragma("unroll") for (int n = 0; n < 2; ++n) _Pragma("unroll") for (int k = 0; k < 2; ++k) dst[n][k] = *(const LAS bf16x8*)(lds + PG_SB(b, h) + boff + n * 2048 + k * 1024); } } while (0)
#define PG_MMA(ai, bj, At, Bt) do { __builtin_amdgcn_s_setprio(1); _Pragma("unroll") for (int m = 0; m < 4; ++m) _Pragma("unroll") for (int n = 0; n < 2; ++n) { \
        if (FP8) {     \
            if (SWAP) asm volatile("v_mfma_scale_f32_16x16x128_f8f6f4 %0, %1, %2, %0, %3, %3 op_sel_hi:[0,0,0]" : "+v"(acc[ai][bj][m][n]) : "v"(Bt##8[n]), "v"(At##8[m]), "v"(one_e8m0)); \
            else      asm volatile("v_mfma_scale_f32_16x16x128_f8f6f4 %0, %1, %2, %0, %3, %3 op_sel_hi:[0,0,0]" : "+v"(acc[ai][bj][m][n]) : "v"(At##8[m]), "v"(Bt##8[n]), "v"(one_e8m0)); } \
        else { _Pragma("unroll") for (int k = 0; k < 2; ++k) \
            acc[ai][bj][m][n] = SWAP ? __builtin_amdgcn_mfma_f32_16x16x32_bf16(Bt[n][k], At[m][k], acc[ai][bj][m][n], 0, 0, 0) \
                                     : __builtin_amdgcn_mfma_f32_16x16x32_bf16(At[m][k], Bt[n][k], acc[ai][bj][m][n], 0, 0, 0); } } __builtin_amdgcn_s_setprio(0); } while (0)
#define PG_BAR __builtin_amdgcn_s_barrier()
#define PG_SCHED __builtin_amdgcn_sched_barrier(0)
    GUnit cur, nxt; int ui = 0;
    __syncthreads();
    if (!S.get(0, cur)) return;
    Acc acc; acc_zero(acc);
    bf16x8 At[4][2], B0[2][2], B1[2][2];
    v8i32 At8[4], B08[2], B18[2];
    int one_e8m0 = 127; asm volatile("" : "+v"(one_e8m0));
    const char* cA = cur.a; const char* cB = cur.b;
    if constexpr (GATHER) { PG_GLOAD(vgC, cur); asm volatile("s_waitcnt vmcnt(0)" ::: "memory"); }
    PG_STAGEB(PG_SB(0, 0), cB, 0); PG_STAGEA(PG_SA(0, 0), cA, 0, false); PG_STAGEB(PG_SB(0, 1), cB, 1); PG_STAGEA(PG_SA(0, 1), cA, 1, false);
    if (wr == 1) PG_BAR;
    WAIT_V(4); PG_BAR;
    PG_STAGEB(PG_SB(1, 0), cB + kstep, 0); PG_STAGEA(PG_SA(1, 0), cA + kstep, 0, false); PG_STAGEB(PG_SB(1, 1), cB + kstep, 1);
    WAIT_V(6); PG_BAR;
    for (;;) {
        const bool has_next = S.get(ui + 1, nxt);
        const char* nA = has_next ? nxt.a : cA; const char* nB = has_next ? nxt.b : cB;
        if constexpr (GATHER) { if (has_next) PG_GLOAD(vgN, nxt); else { _Pragma("unroll") for (int q_ = 0; q_ < 4; ++q_) vgN[q_] = vgC[q_]; } }
#pragma unroll 1
        for (int t = 0; t < nt; t += 2) {
            const bool last = (t == nt - 2);
            const char* a1 = cA + (size_t)(t + 1) * kstep;
            const char* a2 = last ? nA : cA + (size_t)(t + 2) * kstep; const char* b2 = last ? nB : cB + (size_t)(t + 2) * kstep;
            const char* a3 = a2 + kstep; const char* b3 = b2 + kstep;
            PG_LDB(B0, 0, 0); PG_SCHED; PG_LDA(At, 0, 0); PG_STAGEA(PG_SA(1, 1), a1, 1, false);
            WAIT_L(8); PG_BAR; WAIT_L(0); PG_MMA(0, 0, At, B0); PG_BAR; PG_SCHED;
            PG_LDB(B1, 0, 1); PG_STAGEB(PG_SB(0, 0), b2, 0);
            PG_BAR; WAIT_L(0); PG_MMA(0, 1, At, B1); PG_BAR;
            PG_LDA(At, 0, 1); PG_STAGEA(PG_SA(0, 0), a2, 0, last);
            PG_BAR; WAIT_L(0); PG_MMA(1, 0, At, B0); PG_BAR; PG_SCHED;
            PG_STAGEB(PG_SB(0, 1), b2, 1);
            WAIT_V(6); PG_BAR; PG_MMA(1, 1, At, B1); PG_BAR;
            PG_LDB(B0, 1, 0); PG_SCHED; PG_LDA(At, 1, 0); PG_STAGEA(PG_SA(0, 1), a2, 1, last);
            WAIT_L(8); PG_BAR; WAIT_L(0); PG_MMA(0, 0, At, B0); PG_BAR; PG_SCHED;
            PG_LDB(B1, 1, 1); PG_STAGEB(PG_SB(1, 0), b3, 0);
            PG_BAR; WAIT_L(0); PG_MMA(0, 1, At, B1); PG_BAR;
            PG_LDA(At, 1, 1); PG_STAGEA(PG_SA(1, 0), a3, 0, last);
            PG_BAR; WAIT_L(0); PG_MMA(1, 0, At, B0); PG_BAR; PG_SCHED;
            PG_STAGEB(PG_SB(1, 1), b3, 1);
            WAIT_V(6); PG_BAR; PG_MMA(1, 1, At, B1); PG_BAR;
        }
        if (FP8) asm volatile("s_nop 15\n\ts_nop 7" ::: "memory");
        const bool z = E(acc, cur.id);
        if (!has_next) break;
        if (z) acc_zero(acc);
        cur = nxt; cA = nA; cB = nB; ++ui;
        if (GATHER) { _Pragma("unroll") for (int q_ = 0; q_ < 4; ++q_) vgC[q_] = vgN[q_]; }
    }
    WAIT_V(0);
    if (wr == 0) PG_BAR;
    PG_BAR;
#undef PG_SA
#undef PG_STAGEB
#undef PG_SB
#undef PG_STAGE
#undef PG_STAGEA
#undef PG_GLOAD
#undef PG_LDA
#undef PG_CAT
#undef PG_LDB
#undef PG_MMA
#undef PG_BAR
#undef PG_SCHED
}
__device__ __forceinline__ void store_rows_bf16(bf16* base, size_t ld, int fr, int fq, const f32x4 x00, const f32x4 x01, const f32x4 x10, const f32x4 x11) {
    const bool hi = (fr & 8) != 0;
    const u32x4 h0 = {cvtpk(x00[0], x00[1]), cvtpk(x00[2], x00[3]), cvtpk(x01[0], x01[1]), cvtpk(x01[2], x01[3])};
    const u32x4 h1 = {cvtpk(x10[0], x10[1]), cvtpk(x10[2], x10[3]), cvtpk(x11[0], x11[1]), cvtpk(x11[2], x11[3])};
    const u32x4 send = hi ? h0 : h1; u32x4 recv;
#pragma unroll
    for (int i = 0; i < 4; ++i) recv[i] = (unsigned)__builtin_amdgcn_update_dpp(0, (int)send[i], 0x128, 0xf, 0xf, false);
    const u32x4 d0 = hi ? recv : h0, d1 = hi ? h1 : recv;
    bf16* p = base + (size_t)(fr & 7) * ld + fq * 16 + (hi ? 8 : 0);
    *reinterpret_cast<u32x4*>(p) = d0;
    *reinterpret_cast<u32x4*>(p + 8 * ld) = d1;
}
template <bool SWAP, class Fn> __device__ __forceinline__ void acc_foreach(const Acc& acc, Fn fn) {
    const int _t = opaque_tid(), _w = _t >> 6, _l = _t & 63, _wr = _w >> 2, _wc = _w & 3, _fr = _l & 15, _fq = _l >> 4;
#pragma unroll
    for (int ai = 0; ai < 2; ++ai)
#pragma unroll
        for (int bj = 0; bj < 2; ++bj)
#pragma unroll
            for (int m = 0; m < 4; ++m)
#pragma unroll
                for (int n = 0; n < 2; ++n) {
                    if (SWAP) fn(ai * 128 + _wr * 64 + m * 16 + _fr, bj * 128 + _wc * 32 + n * 16 + 4 * _fq, acc[ai][bj][m][n]);
                    else      fn(ai * 128 + _wr * 64 + m * 16 + 4 * _fq, bj * 128 + _wc * 32 + n * 16 + _fr, acc[ai][bj][m][n]);
                    __builtin_amdgcn_sched_barrier(0);
                }
}
struct DenseSched {
    const char* A; const char* B; size_t tstepA, tstepB; int nN, nM, bid, G; bool latent_only;
    __device__ __forceinline__ bool get(int i, GUnit& u) const {
        int pm, pn;
        if ((G & 7) == 0) {
            const int x = bid & 7, lb = bid >> 3, W = G >> 3, v = lb + i * W;
            const int own = (nM - x + 7) >> 3;
            if (v >= own * nN) return false;
            const int q = v / nN; pm = x + 8 * q; pn = v - q * nN;
        } else {
            const int t = bid + i * G; if (t >= nM * nN) return false;
            pm = t / nN; pn = t - pm * nN;
        }
        if (latent_only) pm += 1 + (pm >= 64 ? 1 : 0);
        u.a = A + (size_t)pm * tstepA; u.b = B + (size_t)pn * tstepB; u.id = pm * nN + pn; return true; }
};
__device__ __forceinline__ DenseSched dense_sched(const Ctx& F, const bf16* A, int lda, const bf16* Bt, int ldb, int M, int N) {
    DenseSched s; s.A = (const char*)A; s.B = (const char*)Bt; s.tstepA = (size_t)256 * lda * 2; s.tstepB = (size_t)256 * ldb * 2; s.nN = N / 256; s.nM = M / 256; s.bid = F.bid; s.G = F.G; s.latent_only = false; return s;
}

__device__ __forceinline__ void cvt_tile(const Ctx& F, const float* __restrict__ src, int ldsrc, bf16* __restrict__ dst, int lddst, int k0, int n0, int mode) {
    float* t = (float*)F.lds;
    const int kk = F.tid >> 5, nn = (F.tid & 31) * 4;
    f32x4 v[8];
#pragma unroll
    for (int h = 0; h < 8; ++h) v[h] = *reinterpret_cast<const f32x4*>(src + (size_t)(k0 + kk + 16 * h) * ldsrc + n0 + nn);
    __syncthreads();
#pragma unroll
    for (int h = 0; h < 8; ++h) *reinterpret_cast<f32x4*>(t + (kk + 16 * h) * 132 + nn) = v[h];
    __syncthreads();
#pragma unroll
    for (int h = 0; h < 4; ++h) {
        const int n = (F.tid & 31) + 32 * h, k8 = (F.tid >> 5) * 8;
        const float* p = t + k8 * 132 + n;
        u32x4 w = {cvtpk(p[0], p[132]), cvtpk(p[2 * 132], p[3 * 132]), cvtpk(p[4 * 132], p[5 * 132]), cvtpk(p[6 * 132], p[7 * 132])};
        const int ng = n0 + n;
        const int p3 = (ng & ~255) | (((ng >> 5) & 1) << 7) | (((ng >> 6) & 3) << 5) | (ng & 31);
        const int p4 = (ng & ~255) | (((ng >> 3) & 1) << 7) | (((ng >> 6) & 3) << 5) | (((ng >> 2) & 1) << 4) | (((ng >> 4) & 3) << 2) | (ng & 3);
        const int row = (mode == 0) ? ng : (mode == 5) ? (ng < 2048 ? p3 : p4)
                                         : (mode == 6) ? (ng < 4096 ? ng : p4)
                                         : ((ng >> 4) * 32 + (ng & 15) + (mode == 2 ? 16 : 0));
        *reinterpret_cast<u32x4*>(dst + (size_t)row * lddst + k0 + k8) = w;
    }
}
__device__ __forceinline__ void cvt_matrix(const Ctx& F, const float* src, int K, int N, bf16* dst, int lddst, int mode, int& rot, int lo = 0) {
    const int tk = K / 128, tn = N / 128, ntile = tk * tn, Gs = F.G - lo;
    if (F.bid >= lo) {
        int first = (F.bid - lo - rot) % Gs; if (first < 0) first += Gs;
        for (int i = first; i < ntile; i += Gs) cvt_tile(F, src, N, dst, lddst, (i / tn) * 128, (i % tn) * 128, mode);
    }
    rot = (rot + ntile) % Gs;
}

__device__ __forceinline__ void p0_prologue(const Ctx& F) {
    {
        float* sv = (float*)F.lds;
        float* red = sv + 3 * 1024;
        for (int i = F.tid; i < 3 * 1024; i += NTHR) sv[i] = silu_f(i < 2048 ? F.in[I_C][i] : F.in[I_CCTX][i - 2048]);
        __syncthreads();
        const int col = F.tid & 63, kg = F.tid >> 6;
        for (int it = F.bid; it < 4 * 96; it += F.G) {
            const int layer = it / 96, n0 = (it % 96) * 64;
            const float* W = F.in[I_MODW] + (size_t)layer * D * 6144 + n0 + col;
            float a0 = 0.f, a1 = 0.f, a2 = 0.f;
#pragma unroll 32
            for (int k = kg * 128; k < kg * 128 + 128; ++k) {
                const float w = W[(size_t)k * 6144];
                a0 += sv[k] * w; a1 += sv[1024 + k] * w; a2 += sv[2048 + k] * w;
            }
            __syncthreads();
            red[(kg * 3 + 0) * 64 + col] = a0; red[(kg * 3 + 1) * 64 + col] = a1; red[(kg * 3 + 2) * 64 + col] = a2;
            __syncthreads();
            if (F.tid < 192) {
                const int s = F.tid >> 6; float v = 0.f;
                for (int g = 0; g < 8; ++g) v += red[(g * 3 + s) * 64 + col];
                ((float*)(F.ws + WS_MODS))[((size_t)layer * 3 + s) * 6144 + n0 + col] = v + F.in[I_MODB][layer * 6144 + n0 + col];
            }
        }
        __syncthreads();
    }
    {
        float2* rr = (float2*)(F.ws + WS_RROPE);
        const float invf = 1.f / powf(10000.f, (float)(F.tid & 127) * (1.f / 127.f));
        for (int i = F.bid * NTHR + F.tid; i < SEQL * 128; i += F.G * NTHR) {
            const int pos = i >> 7; const float ang = (float)pos * invf;
            rr[i] = make_float2(cosf(ang), sinf(ang)); }
        float2* ar = (float2*)(F.ws + WS_AROPE);
        for (int i = F.bid * NTHR + F.tid; i < 320 * 16; i += F.G * NTHR) {
            const int p = i >> 4, f = i & 15; const float ang = (float)(p < 256 ? p : p - 256) * (1.f / powf(10000.f, (float)f * (1.f / 16.f)));
            ar[i] = make_float2(cosf(ang), sinf(ang)); }
    }
    if (F.bid == 0 && F.tid < 8) ((float*)(F.ws + WS_RETC))[F.tid] = log1pf(-expf(F.in[I_RLA][F.tid])) * 1.4426950408889634f;
    {
        bf16* wt = (bf16*)(F.ws + WS_WT); int rot = 0;
        for (int s = 0; s < 2; ++s) {
            cvt_matrix(F, F.in[I_DAWIN] + (size_t)s * 1024 * 3072, 1024, 3072, wt + WT_DAIN + (size_t)s * 3072 * 1024, 1024, 5, rot);
            cvt_matrix(F, F.in[I_DAWOUT] + (size_t)s * 1024 * 1024, 1024, 1024, wt + WT_DAOUT + (size_t)s * 1024 * 1024, 1024, 0, rot);
        }
        cvt_matrix(F, F.in[I_RWIN], 1024, 6144, wt + WT_RIN, 1024, 6, rot);
        cvt_matrix(F, F.in[I_RWOUT], 2048, 1024, wt + WT_ROUT, 2048, 0, rot);
        cvt_matrix(F, F.in[I_HWIN], 1024, 3072, wt + WT_HIN, 1024, 0, rot);
        cvt_matrix(F, F.in[I_HWOUT], 1024, 1024, wt + WT_HOUT, 1024, 0, rot);
    }
}

__device__ __forceinline__ void ph_modulate(const Ctx& F, int layer, int which, bf16* __restrict__ H, bool from_input = false) {
    const float* gn = F.in[which ? I_NFG : I_NMG] + layer * D;
    for (int r = F.bid * 8 + F.wave; r < MALL; r += F.G * 8) {
        const float* xp = from_input ? xrow_in(F, r) : xrow(F, r);
        const float* mb = (const float*)(F.ws + WS_MODS) + ((size_t)layer * 3 + mod_sel(r)) * 6144 + which * 3072;
        float4 v[4]; float ss = 0.f;
#pragma unroll
        for (int i = 0; i < 4; ++i) { v[i] = *reinterpret_cast<const float4*>(xp + i * 256 + F.lane * 4); ss += v[i].x * v[i].x + v[i].y * v[i].y + v[i].z * v[i].z + v[i].w * v[i].w; }
        ss = wave_sum(ss);
        const float rstd = rsqrtf(ss * (1.f / D) + EPS);
#pragma unroll
        for (int i = 0; i < 4; ++i) {
            const int e = i * 256 + F.lane * 4;
            const float4 g = *reinterpret_cast<const float4*>(gn + e), sh = *reinterpret_cast<const float4*>(mb + e), sc = *reinterpret_cast<const float4*>(mb + 1024 + e);
            const float a = v[i].x * rstd * g.x * (1.f + sc.x) + sh.x, b = v[i].y * rstd * g.y * (1.f + sc.y) + sh.y;
            const float c = v[i].z * rstd * g.z * (1.f + sc.z) + sh.z, d = v[i].w * rstd * g.w * (1.f + sc.w) + sh.w;
            u32x2 w = {cvtpk(a, b), cvtpk(c, d)};
            *reinterpret_cast<u32x2*>(H + (size_t)r * D + e) = w;
        }
    }
}

struct EpiBf16 { bf16* C; int ldc, nN;
    __device__ __forceinline__ bool operator()(Acc& acc, int t) const {
        const int brow = (t / nN) * 256, bcol = (t % nN) * 256;
        acc_foreach<true>(acc, [&](int row, int col4, f32x4 v) {
            u32x2 w = {cvtpk(v[0], v[1]), cvtpk(v[2], v[3])};
            *reinterpret_cast<u32x2*>(C + (size_t)(brow + row) * ldc + bcol + col4) = w; });
        return true; } };
__device__ __forceinline__ void ph_gemm_bf16(const Ctx& F, const bf16* A, int lda, const bf16* Bt, int ldb, int M, int N, int K, bf16* C, int ldc) {
    const DenseSched S = dense_sched(F, A, lda, Bt, ldb, M, N);
    const EpiBf16 E{C, ldc, N / 256};
    gemm_phase<true>(F.lds, lda, ldb, K, S, E);
}
struct EpiResid { float* xlat; float* xctx; const float* slat; const float* sctx; const float* mods; const float* bias;
    __device__ __forceinline__ bool operator()(Acc& acc, int t) const {
        const int brow = (t / 4) * 256, bcol = (t % 4) * 256;
        const int b = brow / NTOK, tt = brow - b * NTOK;
        float* xb = (tt < CTX) ? xctx + (size_t)(b * CTX) * D : xlat + (size_t)(b * SEQL + tt - CTX) * D;
        const float* sb = (tt < CTX) ? sctx + (size_t)(b * CTX) * D : slat + (size_t)(b * SEQL + tt - CTX) * D;
        const float* gate = mods + (size_t)((tt < CTX) ? 2 : b) * 6144;
        const int _t = opaque_tid(), _w = _t >> 6, _l = _t & 63, _wr = _w >> 2, _wc = _w & 3, _fr = _l & 15, _fq = _l >> 4;
        const int c0 = bcol + _wc * 32 + 4 * _fq;
        f32x4 g[4], bs[4];
#pragma unroll
        for (int q = 0; q < 4; ++q) { g[q] = *reinterpret_cast<const f32x4*>(gate + c0 + (q >> 1) * 128 + (q & 1) * 16);
            bs[q] = f32x4{0.f, 0.f, 0.f, 0.f}; if (bias) bs[q] = *reinterpret_cast<const f32x4*>(bias + c0 + (q >> 1) * 128 + (q & 1) * 16); }
        const size_t ro = (size_t)(_wr * 64 + _fr) * D + c0;
        const float* sp = sb + ro; float* xp = xb + ro;
        f32x4 cur[4], nxt[4];
#pragma unroll
        for (int q = 0; q < 4; ++q) cur[q] = *reinterpret_cast<const f32x4*>(sp + (q >> 1) * 128 + (q & 1) * 16);
#pragma unroll
        for (int k = 0; k < 8; ++k) {
            const int ai = k >> 2, m = k & 3;
            if (k + 1 < 8) {
                const size_t rn = (size_t)(((k + 1) >> 2) * 128 + ((k + 1) & 3) * 16) * D;
#pragma unroll
                for (int q = 0; q < 4; ++q) nxt[q] = *reinterpret_cast<const f32x4*>(sp + rn + (q >> 1) * 128 + (q & 1) * 16);
            }
            const size_t rk = (size_t)(ai * 128 + m * 16) * D;
#pragma unroll
            for (int q = 0; q < 4; ++q) *reinterpret_cast<f32x4*>(xp + rk + (q >> 1) * 128 + (q & 1) * 16) = cur[q] + g[q] * (acc[ai][q >> 1][m][q & 1] + bs[q]);
#pragma unroll
            for (int q = 0; q < 4; ++q) cur[q] = nxt[q];
            __builtin_amdgcn_sched_barrier(0);
        }
        return true; } };
__device__ __forceinline__ void ph_gemm_resid(const Ctx& F, const bf16* A, int lda, const bf16* Bt, int K, int layer, int gate_off, const float* bias, bool from_input = false, bool latent_only = false) {
    DenseSched S = dense_sched(F, A, lda, Bt, K, MALL, D);
    if (latent_only) { S.nM = 128; S.latent_only = true; }
    const EpiResid E{F.out, (float*)(F.ws + WS_CTXX), from_input ? F.in[I_X] : F.out, from_input ? F.in[I_CTX] : (const float*)(F.ws + WS_CTXX),
                     (const float*)(F.ws + WS_MODS) + (size_t)layer * 3 * 6144 + gate_off, bias};
    gemm_phase<true>(F.lds, lda, K, K, S, E);
}

struct EpiQKV { bf16* C; const float* gq; const float* gk; const float2* art;
    __device__ __forceinline__ bool operator()(Acc& acc, int t) const {
        const int pm = t / 12, pn = t - pm * 12, brow = pm * 256;
        const int b = brow / NTOK, tt0 = brow - b * NTOK;
        const int _t = opaque_tid(), _w = _t >> 6, _l = _t & 63, _wr = _w >> 2, _wc = _w & 3, _fr = _l & 15, _fq = _l >> 4;
        bf16* dst = C + (size_t)brow * 3072 + pn * 256 + _wc * 64;
        if (pn < 8) {
            const float* gn = (pn < 4 ? gq : gk) + 4 * _fq;
            const float qs = (pn < 4) ? 0.125f * 1.4426950408889634f : 1.f;
            const f32x4 g00 = *reinterpret_cast<const f32x4*>(gn), g01 = *reinterpret_cast<const f32x4*>(gn + 16), g10 = *reinterpret_cast<const f32x4*>(gn + 32), g11 = *reinterpret_cast<const f32x4*>(gn + 48);
            const bool lat = tt0 >= CTX;
            f32x4 rc_[4] = {}, rn_[4] = {};
            const float2* artl = art + 4 * _fq;
            if (lat) { const int pos = tt0 - CTX + _wr * 64 + _fr;
                const f32x4* t0 = reinterpret_cast<const f32x4*>(artl + (pos >> 6) * 16); const f32x4* t1 = reinterpret_cast<const f32x4*>(artl + (256 + (pos & 63)) * 16);
                rc_[0] = t0[0]; rc_[1] = t0[1]; rc_[2] = t1[0]; rc_[3] = t1[1]; }
#pragma unroll
            for (int ai = 0; ai < 2; ++ai)
#pragma unroll
                for (int m = 0; m < 4; ++m) {
                    if (lat && (ai * 4 + m) < 7) { const int kn = ai * 4 + m + 1; const int pos = tt0 - CTX + (kn >> 2) * 128 + _wr * 64 + (kn & 3) * 16 + _fr;
                        const f32x4* t0 = reinterpret_cast<const f32x4*>(artl + (pos >> 6) * 16); const f32x4* t1 = reinterpret_cast<const f32x4*>(artl + (256 + (pos & 63)) * 16);
                        rn_[0] = t0[0]; rn_[1] = t0[1]; rn_[2] = t1[0]; rn_[3] = t1[1]; }
                    f32x4 x00 = acc[ai][0][m][0], x01 = acc[ai][0][m][1], x10 = acc[ai][1][m][0], x11 = acc[ai][1][m][1];
                    const f32x4 sq = x00 * x00 + x01 * x01 + x10 * x10 + x11 * x11;
                    float ss = (sq[0] + sq[1]) + (sq[2] + sq[3]);
                    ss += __shfl_xor(ss, 16, 64); ss += __shfl_xor(ss, 32, 64);
                    const float r = rsqrtf(ss * (1.f / 64.f) + EPS) * qs;
                    x00 = x00 * r * g00; x01 = x01 * r * g01; x10 = x10 * r * g10; x11 = x11 * r * g11;
                    if (lat) {
                        const f32x4 a01 = rc_[0], a23 = rc_[1], b01 = rc_[2], b23 = rc_[3];
                        const float ca[4] = {a01[0], a01[2], a23[0], a23[2]}, sa[4] = {a01[1], a01[3], a23[1], a23[3]};
                        const float cb[4] = {b01[0], b01[2], b23[0], b23[2]}, sb[4] = {b01[1], b01[3], b23[1], b23[3]};
#pragma unroll
                        for (int j = 0; j < 4; ++j) {
                            const float p = x00[j], q = x01[j]; x00[j] = p * ca[j] - q * sa[j]; x01[j] = q * ca[j] + p * sa[j];
                            const float u = x10[j], v = x11[j]; x10[j] = u * cb[j] - v * sb[j]; x11[j] = v * cb[j] + u * sb[j];
                        }
                    }
                    store_rows_bf16(dst + (size_t)(ai * 128 + _wr * 64 + m * 16) * 3072, 3072, _fr, _fq, x00, x01, x10, x11);
#pragma unroll
                    for (int q = 0; q < 4; ++q) rc_[q] = rn_[q];
                    __builtin_amdgcn_sched_barrier(0);
                }
        } else {
#pragma unroll
            for (int ai = 0; ai < 2; ++ai)
#pragma unroll
                for (int m = 0; m < 4; ++m) {
                    store_rows_bf16(dst + (size_t)(ai * 128 + _wr * 64 + m * 16) * 3072, 3072, _fr, _fq, acc[ai][0][m][0], acc[ai][0][m][1], acc[ai][1][m][0], acc[ai][1][m][1]);
                    __builtin_amdgcn_sched_barrier(0);
                }
        }
        return true; } };
__device__ __forceinline__ void ph_gemm_qkv(const Ctx& F, int s, const bf16* A, const bf16* Bt, bf16* QKV) {
    const DenseSched S = dense_sched(F, A, D, Bt, D, MALL, 3072);
    const EpiQKV E{QKV, F.in[I_DAQN] + s * 64, F.in[I_DAKN] + s * 64, (const float2*)(F.ws + WS_AROPE)};
    gemm_phase<true>(F.lds, D, D, D, S, E);
}
__device__ __forceinline__ void ph_qknorm_rope(const Ctx& F, int s, bf16* __restrict__ QKV) {
    const int g = F.lane >> 1, half = F.lane & 1;
    const float* gn = F.in[(g < 16) ? I_DAQN : I_DAKN] + s * 64 + half * 32;
    float gv[32];
#pragma unroll
    for (int i = 0; i < 32; ++i) gv[i] = gn[i];
    const float2* art = (const float2*)(F.ws + WS_AROPE);
    for (int r = F.bid * 8 + F.wave; r < MALL; r += F.G * 8) {
        const int t = r % NTOK;
        bf16x8* p = reinterpret_cast<bf16x8*>(QKV + (size_t)r * 3072 + F.lane * 32);
        bf16x8 raw[4]; float x[32]; float ss = 0.f;
#pragma unroll
        for (int i = 0; i < 4; ++i) raw[i] = p[i];
#pragma unroll
        for (int i = 0; i < 32; ++i) { x[i] = bf2f((unsigned short)raw[i >> 3][i & 7]); ss += x[i] * x[i]; }
        ss += __shfl_xor(ss, 1, 64);
        const float rstd = rsqrtf(ss * (1.f / 64.f) + EPS);
        const float qs = (g < 16) ? 0.125f * 1.4426950408889634f : 1.f;
#pragma unroll
        for (int i = 0; i < 32; ++i) x[i] = x[i] * (rstd * qs) * gv[i];
        if (t >= CTX) {
            const int pos = t - CTX; const float2* tp = art + (half == 0 ? (pos >> 6) : 256 + (pos & 63)) * 16;
#pragma unroll
            for (int f = 0; f < 16; ++f) {
                const float2 csn = tp[f]; const float cs = csn.x, sn = csn.y;
                const float a = x[f], b = x[16 + f];
                x[f] = a * cs - b * sn; x[16 + f] = b * cs + a * sn;
            }
        }
#pragma unroll
        for (int i = 0; i < 4; ++i) { u32x4 w = {cvtpk(x[i * 8 + 0], x[i * 8 + 1]), cvtpk(x[i * 8 + 2], x[i * 8 + 3]), cvtpk(x[i * 8 + 4], x[i * 8 + 5]), cvtpk(x[i * 8 + 6], x[i * 8 + 7])};
            *reinterpret_cast<u32x4*>(&p[i]) = w; }
    }
}

#define KSWZ(row, colB) ((row) * 256 + ((colB) ^ (((row) & 7) << 4)))
#define SBAR() __builtin_amdgcn_sched_barrier(0)
constexpr int AT_SHM_V = 64 * 128 * 2, AT_SHM_K = 64 * 128 * 2;
#ifndef AT_SDEPTH
#define AT_SDEPTH 1
#endif
__device__ __forceinline__ int crow(int r, int hi) { return (r & 3) + 8 * (r >> 2) + 4 * hi; }
__device__ __forceinline__ int v_st(int k, int c) { const int kk = (k & ~0xC) | ((k & 4) << 1) | ((k & 8) >> 1); return ((kk >> 3) * 4 + (c >> 5)) * 512 + ((kk & 7) * 32 + (c & 31)) * 2; }
__device__ __forceinline__ int v_rd_base(int lane) { return ((lane & 3) << 3) | (((lane >> 2) & 3) << 6) | (((lane >> 4) & 1) << 5) | (((lane >> 5) & 1) << 8); }
constexpr int v_rd_off(int d0, int ks, int half) { return d0 * 512 + ks * 4096 + half * 2048; }
template <int OFF> __device__ __forceinline__ s16x4 tr_read(int vb) {
    s16x4 r; asm volatile("ds_read_b64_tr_b16 %0, %1 offset:%2" : "=&v"(r) : "v"(vb), "i"(OFF) : "memory"); return r;
}
template <int D0> __device__ __forceinline__ void pv_one(f32x16& od, int vb, bf16x8 pa0, bf16x8 pa1, bf16x8 pa2, bf16x8 pa3) {
#define PK(L, H) (bf16x8){L[0], L[1], L[2], L[3], H[0], H[1], H[2], H[3]}
    {   const s16x4 l0 = tr_read<v_rd_off(D0, 0, 0)>(vb), h0 = tr_read<v_rd_off(D0, 0, 1)>(vb), l1 = tr_read<v_rd_off(D0, 1, 0)>(vb), h1 = tr_read<v_rd_off(D0, 1, 1)>(vb);
        asm volatile("s_waitcnt lgkmcnt(0)" ::: "memory"); SBAR();
        od = __builtin_amdgcn_mfma_f32_32x32x16_bf16(pa0, PK(l0, h0), od, 0, 0, 0);
        od = __builtin_amdgcn_mfma_f32_32x32x16_bf16(pa1, PK(l1, h1), od, 0, 0, 0);
        asm volatile("" : "+v"(od)); }
    {   const s16x4 l2 = tr_read<v_rd_off(D0, 2, 0)>(vb), h2 = tr_read<v_rd_off(D0, 2, 1)>(vb), l3 = tr_read<v_rd_off(D0, 3, 0)>(vb), h3 = tr_read<v_rd_off(D0, 3, 1)>(vb);
        asm volatile("s_waitcnt lgkmcnt(0)" ::: "memory"); SBAR();
        od = __builtin_amdgcn_mfma_f32_32x32x16_bf16(pa2, PK(l2, h2), od, 0, 0, 0);
        od = __builtin_amdgcn_mfma_f32_32x32x16_bf16(pa3, PK(l3, h3), od, 0, 0, 0);
        asm volatile("" : "+v"(od)); }
#undef PK
}
__device__ __forceinline__ void pv_d0(f32x16* o, int vb, bf16x8 pa0, bf16x8 pa1, bf16x8 pa2, bf16x8 pa3) {
    pv_one<0>(o[0], vb, pa0, pa1, pa2, pa3); pv_one<1>(o[1], vb, pa0, pa1, pa2, pa3); pv_one<2>(o[2], vb, pa0, pa1, pa2, pa3); pv_one<3>(o[3], vb, pa0, pa1, pa2, pa3);
}
template <bool SHIFT> __device__ __forceinline__ void at_exp_half(f32x16& p, float nsh) {
#pragma unroll
    for (int r = 0; r < 16; ++r) p[r] = __builtin_amdgcn_exp2f(SHIFT ? p[r] + nsh : p[r]);
}

template <int D0> __device__ __forceinline__ void pv_two(f32x16& oa, f32x16& ob, int vb, const bf16x8 (&pa)[4], const bf16x8 (&pb)[4]) {
    const s16x4 l0 = tr_read<v_rd_off(D0, 0, 0)>(vb), h0 = tr_read<v_rd_off(D0, 0, 1)>(vb), l1 = tr_read<v_rd_off(D0, 1, 0)>(vb), h1 = tr_read<v_rd_off(D0, 1, 1)>(vb);
    const s16x4 l2 = tr_read<v_rd_off(D0, 2, 0)>(vb), h2 = tr_read<v_rd_off(D0, 2, 1)>(vb), l3 = tr_read<v_rd_off(D0, 3, 0)>(vb), h3 = tr_read<v_rd_off(D0, 3, 1)>(vb);
    asm volatile("s_waitcnt lgkmcnt(0)" ::: "memory"); SBAR();
#define PK(L, H) (bf16x8){L[0], L[1], L[2], L[3], H[0], H[1], H[2], H[3]}
    const bf16x8 v0 = PK(l0, h0), v1 = PK(l1, h1), v2 = PK(l2, h2), v3 = PK(l3, h3);
#undef PK
    oa = __builtin_amdgcn_mfma_f32_32x32x16_bf16(pa[0], v0, oa, 0, 0, 0); ob = __builtin_amdgcn_mfma_f32_32x32x16_bf16(pb[0], v0, ob, 0, 0, 0);
    oa = __builtin_amdgcn_mfma_f32_32x32x16_bf16(pa[1], v1, oa, 0, 0, 0); ob = __builtin_amdgcn_mfma_f32_32x32x16_bf16(pb[1], v1, ob, 0, 0, 0);
    oa = __builtin_amdgcn_mfma_f32_32x32x16_bf16(pa[2], v2, oa, 0, 0, 0); ob = __builtin_amdgcn_mfma_f32_32x32x16_bf16(pb[2], v2, ob, 0, 0, 0);
    oa = __builtin_amdgcn_mfma_f32_32x32x16_bf16(pa[3], v3, oa, 0, 0, 0); ob = __builtin_amdgcn_mfma_f32_32x32x16_bf16(pb[3], v3, ob, 0, 0, 0);
}
#define PK(L, H) (bf16x8){L[0], L[1], L[2], L[3], H[0], H[1], H[2], H[3]}
#define VRD(D0_, L0, H0, L1, H1) const s16x4 L0 = tr_read<v_rd_off(D0_, 2 * KH, 0)>(vb), H0 = tr_read<v_rd_off(D0_, 2 * KH, 1)>(vb), L1 = tr_read<v_rd_off(D0_, 2 * KH + 1, 0)>(vb), H1 = tr_read<v_rd_off(D0_, 2 * KH + 1, 1)>(vb)
#define VMM(OD, L0, H0, L1, H1) do { __builtin_amdgcn_s_setprio(1); OD = __builtin_amdgcn_mfma_f32_32x32x16_bf16(paA, PK(L0, H0), OD, 0, 0, 0); OD = __builtin_amdgcn_mfma_f32_32x32x16_bf16(paB, PK(L1, H1), OD, 0, 0, 0); __builtin_amdgcn_s_setprio(0); asm volatile("" : "+v"(OD)); } while (0)
template <int KH> __device__ __forceinline__ void pv_half4(f32x16 (&o)[4], int vb, bf16x8 paA, bf16x8 paB) {
    VRD(0, a0, a1, a2, a3);
    VRD(1, b0, b1, b2, b3);
    asm volatile("s_waitcnt lgkmcnt(4)" ::: "memory"); SBAR(); VMM(o[0], a0, a1, a2, a3);
    VRD(2, c0, c1, c2, c3);
    asm volatile("s_waitcnt lgkmcnt(4)" ::: "memory"); SBAR(); VMM(o[1], b0, b1, b2, b3);
    VRD(3, d0, d1, d2, d3);
    asm volatile("s_waitcnt lgkmcnt(4)" ::: "memory"); SBAR(); VMM(o[2], c0, c1, c2, c3);
    asm volatile("s_waitcnt lgkmcnt(0)" ::: "memory"); SBAR(); VMM(o[3], d0, d1, d2, d3);
}
#undef VMM
#undef VRD
#undef PK
template <int OFF> __device__ __forceinline__ bf16x8 lds_read128(int addr) {
    bf16x8 r; asm volatile("ds_read_b128 %0, %1 offset:%2" : "=&v"(r) : "v"(addr), "i"(OFF) : "memory"); return r;
}
template <int KOFF, int CMAP, bool SHIFT> __device__ __forceinline__ void at_half(const LAS unsigned char* ldsl, const int (&ksw)[4], const int (&qsw)[4], float C, float nsh, float& lsum, bf16x8& paA, bf16x8& paB) {
    f32x16 p = f32x16{};
    {
        const int lb = 0;
        const bf16x8 k0 = lds_read128<KOFF + CMAP * 8192>(lb + ksw[0]), q0 = lds_read128<CMAP * 32768>(lb + qsw[0]);
        const bf16x8 k1 = lds_read128<KOFF + CMAP * 8192>(lb + ksw[1]), q1 = lds_read128<CMAP * 32768>(lb + qsw[1]);
        const bf16x8 k2 = lds_read128<KOFF + CMAP * 8192>(lb + ksw[2]), q2 = lds_read128<CMAP * 32768>(lb + qsw[2]);
        const bf16x8 k3 = lds_read128<KOFF + CMAP * 8192>(lb + ksw[3]), q3 = lds_read128<CMAP * 32768>(lb + qsw[3]);
        asm volatile("s_waitcnt lgkmcnt(6)" ::: "memory"); SBAR(); p = __builtin_amdgcn_mfma_f32_32x32x16_bf16(k0, q0, p, 0, 0, 0);
        asm volatile("s_waitcnt lgkmcnt(4)" ::: "memory"); SBAR(); p = __builtin_amdgcn_mfma_f32_32x32x16_bf16(k1, q1, p, 0, 0, 0);
        asm volatile("s_waitcnt lgkmcnt(2)" ::: "memory"); SBAR(); p = __builtin_amdgcn_mfma_f32_32x32x16_bf16(k2, q2, p, 0, 0, 0);
        asm volatile("s_waitcnt lgkmcnt(0)" ::: "memory"); SBAR(); p = __builtin_amdgcn_mfma_f32_32x32x16_bf16(k3, q3, p, 0, 0, 0);
    }
    at_exp_half<SHIFT>(p, nsh);
    float ps = 0.f;
#pragma unroll
    for (int r = 0; r < 16; ++r) ps += p[r];
    lsum += ps;
    asm volatile("" : "+v"(lsum));
#define PK4(P, BASE, OUT) do { unsigned a0 = cvtpk(P[BASE + 0], P[BASE + 1]), a1 = cvtpk(P[BASE + 2], P[BASE + 3]);   \
    unsigned b0 = cvtpk(P[BASE + 4], P[BASE + 5]), b1 = cvtpk(P[BASE + 6], P[BASE + 7]);                              \
    auto r0 = __builtin_amdgcn_permlane32_swap(a0, b0, false, false); auto r1 = __builtin_amdgcn_permlane32_swap(a1, b1, false, false); \
    u32x4 w = {r0[0], r1[0], r0[1], r1[1]}; OUT = *reinterpret_cast<bf16x8*>(&w); } while (0)
    PK4(p, 0, paA); PK4(p, 8, paB);
#undef PK4
}
template <bool SHIFT> __device__ __forceinline__ void attn_unit(const Ctx& F, const bf16* __restrict__ QKV, bf16* __restrict__ AO, int qrow0, int krow0, int nkeys, int h,
                                          float C, float nsh, float lam, float osc, const float* __restrict__ subg) {
    LAS unsigned char* ldsl = (LAS unsigned char*)F.lds;
    char* lds = F.lds;
    const int tid = opaque_tid(), wid = __builtin_amdgcn_readfirstlane(tid >> 6), lane = tid & 63, r32a = lane & 31, hia = lane >> 5;
    constexpr int OFF_V = 0, OFF_K = 2 * AT_SHM_V, OFF_Q = 2 * AT_SHM_V + 2 * AT_SHM_K, OFF_L = OFF_Q + 256 * 256;
    const int krow = 8 * wid + (lane >> 3), kcol = ((lane & 7) ^ ((krow >> 1) & 7)) * 8;
    const int vst = 2 * wid + (lane >> 5), vkk = (vst >> 2) * 8 + ((lane & 31) >> 2), vkey = (vkk & ~0xC) | ((vkk & 4) << 1) | ((vkk & 8) >> 1), vcol = (vst & 3) * 32 + (lane & 3) * 8;
    const unsigned koff = (unsigned)(krow * 3072 + kcol) * 2u, voff = (unsigned)(vkey * 3072 + vcol) * 2u;
    const char* Kh = (const char*)(QKV + (size_t)krow0 * 3072 + 1024 + h * 128);
    const char* Vh = (const char*)(QKV + (size_t)krow0 * 3072 + 2048 + h * 128);
    const char* Qh = (const char*)(QKV + (size_t)qrow0 * 3072 + h * 128);
    const unsigned ldsw = (unsigned)wid * 1024u;
#define DMA_KV(buf, k0) do { _Pragma("unroll") for (int m_ = 0; m_ < 2; ++m_) { \
        __builtin_amdgcn_global_load_lds((const unsigned*)(Kh + (size_t)(k0) * 6144 + m_ * 128 + koff), (LAS unsigned*)(ldsl + OFF_K + (buf) * AT_SHM_K + ldsw + m_ * 8192), 16, 0, 0); \
        __builtin_amdgcn_global_load_lds((const unsigned*)(Vh + (size_t)((k0) + 32 * m_) * 6144 + voff), (LAS unsigned*)(ldsl + OFF_V + (buf) * AT_SHM_V + ldsw + m_ * 8192), 16, 0, 0); } } while (0)
    const int NT = nkeys / 64;
    __syncthreads();
#pragma unroll
    for (int m_ = 0; m_ < 8; ++m_) __builtin_amdgcn_global_load_lds((const unsigned*)(Qh + (size_t)(64 * (m_ & 3)) * 6144 + (m_ >> 2) * 128 + koff), (LAS unsigned*)(ldsl + OFF_Q + ldsw + m_ * 8192), 16, 0, 0);
    DMA_KV(0, 0);
    float lsum0 = 0.f, lsum1 = 0.f; f32x16 o0[4] = {}, o1[4] = {};
    const int vb0 = (int)(uintptr_t)(lds + OFF_V) + v_rd_base(lane);
    int ksw[4], qsw[4];
#pragma unroll
    for (int d0 = 0; d0 < 4; ++d0) { ksw[d0] = (int)(uintptr_t)lds + r32a * 128 + (((d0 * 2 + hia) ^ ((r32a >> 1) & 7)) << 4); qsw[d0] = ksw[d0] + wid * 4096 + OFF_Q; }
    asm volatile("s_waitcnt vmcnt(0)" ::: "memory"); __builtin_amdgcn_s_barrier();
#define AT_MAPHALF(B, CM, KH, OO, LS) do { bf16x8 pA_, pB_; \
        at_half<OFF_K + (B) * AT_SHM_K + (KH) * 4096, CM, SHIFT>(ldsl, ksw, qsw, C, nsh, LS, pA_, pB_); \
        const int vb_ = vb0 + (B) * AT_SHM_V; \
        pv_half4<KH>(OO, vb_, pA_, pB_); } while (0)
#define AT_TILE(B, NEXT_K0, HAS_NEXT) do { \
        if (HAS_NEXT) DMA_KV((B) ^ 1, NEXT_K0); \
        AT_MAPHALF(B, 0, 0, o0, lsum0); AT_MAPHALF(B, 0, 1, o0, lsum0); AT_MAPHALF(B, 1, 0, o1, lsum1); AT_MAPHALF(B, 1, 1, o1, lsum1); \
        asm volatile("s_waitcnt vmcnt(0)" ::: "memory"); __builtin_amdgcn_s_barrier();     \
    } while (0)
#pragma unroll 1
    for (int j = 0; j < NT; j += 2) {
        int jj = j; asm volatile("" : "+s"(jj));
        AT_TILE(0, (jj + 1) * 64, true);
        AT_TILE(1, (jj + 2) * 64, j + 2 < NT);
    }
#undef AT_TILE
#undef AT_MAPHALF
#undef DMA_KV
    const int tz = opaque_tid(), wz = tz >> 6, r32 = tz & 31, hi = (tz >> 5) & 1;
    float* li_l = (float*)(F.lds + OFF_L) + wz * 64;
    const int lz = tz & 63;
#define SHX(v, of) __uint_as_float(__builtin_amdgcn_ds_bpermute((lz ^ (of)) << 2, __float_as_uint(v)))
    lsum0 += SHX(lsum0, 32); lsum1 += SHX(lsum1, 32);
    if (hi == 0) { li_l[r32] = lsum0; li_l[32 + r32] = lsum1; }
    asm volatile("s_waitcnt lgkmcnt(0)" ::: "memory");
    float gsub[4];
#pragma unroll
    for (int d0 = 0; d0 < 4; ++d0) gsub[d0] = subg[d0 * 32 + r32] * osc;
#pragma unroll
    for (int r = 0; r < 16; ++r) {
        const float ra = 1.f / li_l[crow(r, hi)], rb = lam / li_l[32 + crow(r, hi)];
        float res[4], ss = 0.f;
#pragma unroll
        for (int d0 = 0; d0 < 4; ++d0) { res[d0] = o0[d0][r] * ra - o1[d0][r] * rb; ss += res[d0] * res[d0]; }
#pragma unroll
        for (int of = 1; of < 32; of <<= 1) ss += SHX(ss, of);
        const float rstd = rsqrtf(ss * (1.f / 128.f) + EPS);
        unsigned short* op = (unsigned short*)AO + (size_t)(qrow0 + wz * 32 + crow(r, hi)) * D + h * 128 + r32;
#pragma unroll
        for (int d0 = 0; d0 < 4; ++d0) op[d0 * 32] = f2bf(res[d0] * rstd * gsub[d0]);
        SBAR();
    }
#undef SHX
}

__device__ __forceinline__ void ph_attention(const Ctx& F, int layer, int s, bool need_ctx, const bf16* QKV, bf16* AO) {
    const float* lamp = F.in[I_DALAM] + s * 256;
    float d01 = 0.f, d23 = 0.f, mq = 0.f, mk = 0.f;
    for (int i = 0; i < 64; ++i) { d01 += lamp[i] * lamp[64 + i]; d23 += lamp[128 + i] * lamp[192 + i];
        mq = fmaxf(mq, fabsf(F.in[I_DAQN][s * 64 + i])); mk = fmaxf(mk, fabsf(F.in[I_DAKN][s * 64 + i])); }
    const float lam_init = 0.8f - 0.6f * expf(-0.3f * (float)layer);
    const float lam = expf(d01) - expf(d23) + lam_init;
    const float Mb = 8.f * mq * mk, shift = fmaxf(0.f, Mb - 30.f);
    const float C = 0.125f * 1.4426950408889634f, nsh = __uint_as_float(__builtin_amdgcn_readfirstlane(__float_as_uint(-shift * 1.4426950408889634f)));
    const float lam_u = __uint_as_float(__builtin_amdgcn_readfirstlane(__float_as_uint(lam))), osc_u = __uint_as_float(__builtin_amdgcn_readfirstlane(__float_as_uint(1.f - lam_init)));
    const float* subg = F.in[I_DASUB] + s * 128;
    const int nlat = NB * 8 * (SEQL / 256), nctx = need_ctx ? NB * 8 : 0;
#define AT_UNITS(SH) for (int u0 = F.bid; u0 < nlat + nctx; u0 += F.G) { \
        int u = u0; \
        if (u0 < nlat && F.G == 256) { const int s_ = (u0 >> 8) * 8 + (F.bid & 7); u = (s_ >> 1) * 64 + (s_ & 1) * 32 + (F.bid >> 3); }     \
        if (u < nlat) { const int qb = u % (SEQL / 256), bh = u / (SEQL / 256), h = bh % 8, b = bh / 8; \
            attn_unit<SH>(F, QKV, AO, b * NTOK + CTX + qb * 256, b * NTOK, NTOK, h, C, nsh, lam_u, osc_u, subg); } \
        else { const int bh = u - nlat, h = bh % 8, b = bh / 8; \
            attn_unit<SH>(F, QKV, AO, b * NTOK, b * NTOK, CTX, h, C, nsh, lam_u, osc_u, subg); } }
    if (nsh == 0.f) { AT_UNITS(false) } else { AT_UNITS(true) }
#undef AT_UNITS
}

__device__ __forceinline__ void cvt_tile_f8(const Ctx& F, const float* __restrict__ src, int ldsrc, unsigned char* __restrict__ dst, int lddst, int k0, int n0, int mode) {
    float* t = (float*)F.lds;
    const int kk = F.tid >> 5, nn = (F.tid & 31) * 4;
    f32x4 v[8];
#pragma unroll
    for (int h = 0; h < 8; ++h) v[h] = *reinterpret_cast<const f32x4*>(src + (size_t)(k0 + kk + 16 * h) * ldsrc + n0 + nn);
    __syncthreads();
#pragma unroll
    for (int h = 0; h < 8; ++h) *reinterpret_cast<f32x4*>(t + (kk + 16 * h) * 132 + nn) = v[h];
    __syncthreads();
#pragma unroll
    for (int h = 0; h < 4; ++h) {
        const int n = (F.tid & 31) + 32 * h, k8 = (F.tid >> 5) * 8;
        const float* p = t + k8 * 132 + n;
        float q[8];
#pragma unroll
        for (int j = 0; j < 8; ++j) q[j] = fminf(fmaxf(p[j * 132] * 32.f, -448.f), 448.f);
        unsigned w0 = 0u, w1 = 0u;
        w0 = __builtin_amdgcn_cvt_pk_fp8_f32(q[0], q[1], w0, false); w0 = __builtin_amdgcn_cvt_pk_fp8_f32(q[2], q[3], w0, true);
        w1 = __builtin_amdgcn_cvt_pk_fp8_f32(q[4], q[5], w1, false); w1 = __builtin_amdgcn_cvt_pk_fp8_f32(q[6], q[7], w1, true);
        const int ng = n0 + n;
        const int row = (mode == 0) ? ng : ((ng >> 7) * 256 + ((ng >> 2) & 1) * 128 + ((ng >> 5) & 3) * 32 + (mode == 2 ? 16 : 0) + ((ng >> 3) & 3) * 4 + (ng & 3));
        u32x2 w = {w0, w1};
        *reinterpret_cast<u32x2*>(dst + (size_t)row * lddst + k0 + k8) = w;
    }
}
__device__ __forceinline__ void cvt_matrix_f8(const Ctx& F, const float* src, int K, int N, unsigned char* dst, int lddst, int mode, int& rot, int lo) {
    const int tk = K / 128, tn = N / 128, ntile = tk * tn, Gs = F.G - lo;
    if (F.bid >= lo) {
        int first = (F.bid - lo - rot) % Gs; if (first < 0) first += Gs;
        for (int i = first; i < ntile; i += Gs) cvt_tile_f8(F, src, N, dst, lddst, (i / tn) * 128, (i % tn) * 128, mode);
    }
    rot = (rot + ntile) % Gs;
}
__device__ __forceinline__ void ph_cvt_experts(const Ctx& F, int layer, unsigned char* EXPW8) {
    int rot = 0;
    for (int e = 0; e < NEXP; ++e) {
        const size_t wo = ((size_t)layer * NEXP + e) * 1024 * 1024;
        unsigned char* dst = EXPW8 + (size_t)e * 3072 * 1024;
        const int lo = (F.G > 128) ? 64 : 0;
        cvt_matrix_f8(F, F.in[I_EW1] + wo, 1024, 1024, dst, 1024, 1, rot, lo);
        cvt_matrix_f8(F, F.in[I_EW3] + wo, 1024, 1024, dst, 1024, 2, rot, lo);
        cvt_matrix_f8(F, F.in[I_EW2] + wo, 1024, 1024, dst + (size_t)2048 * 1024, 1024, 0, rot, lo);
    }
}
__device__ __forceinline__ void ph_ffn_modulate_router(const Ctx& F, int layer, unsigned char* __restrict__ H8, bool need_ctx) {
    float* rw = (float*)F.lds;
    unsigned* __restrict__ H8w = reinterpret_cast<unsigned*>(H8);
    __syncthreads();
    for (int i = F.tid; i < 1024 * 16; i += NTHR) rw[(i & 15) * 1024 + (i >> 4)] = F.in[I_RTW][(size_t)layer * 1024 * 16 + i];
    __syncthreads();
    const float* gn = F.in[I_NFG] + layer * D;
    float* affl = (float*)(F.ws + WS_AFFL); float* affc = (float*)(F.ws + WS_AFFC);
    for (int r = F.bid * 8 + F.wave; r < MALL; r += F.G * 8) {
        const int b = r / NTOK, t = r - b * NTOK;
        if (!need_ctx && t < CTX) continue;
        const float* xp = xrow(F, r);
        const float* mb = (const float*)(F.ws + WS_MODS) + ((size_t)layer * 3 + ((t < CTX) ? 2 : b)) * 6144 + 3072;
        float4 v[4]; float ss = 0.f;
        float4 gA[4], shA[4], scA[4];
#pragma unroll
        for (int i = 0; i < 4; ++i) v[i] = *reinterpret_cast<const float4*>(xp + i * 256 + F.lane * 4);
#pragma unroll
        for (int i = 0; i < 4; ++i) { const int e0 = i * 256 + F.lane * 4; gA[i] = *reinterpret_cast<const float4*>(gn + e0); shA[i] = *reinterpret_cast<const float4*>(mb + e0); scA[i] = *reinterpret_cast<const float4*>(mb + 1024 + e0); }
#pragma unroll
        for (int i = 0; i < 4; ++i) ss += v[i].x * v[i].x + v[i].y * v[i].y + v[i].z * v[i].z + v[i].w * v[i].w;
        ss = wave_sum(ss);
        const float rstd = rsqrtf(ss * (1.f / D) + EPS);
        float lg[16];
#pragma unroll
        for (int e = 0; e < 16; ++e) lg[e] = 0.f;
#pragma unroll
        for (int i = 0; i < 4; ++i) {
            const int e0 = i * 256 + F.lane * 4;
            const float4 g = gA[i], sh = shA[i], sc = scA[i];
            float hv[4];
            hv[0] = v[i].x * rstd * g.x * (1.f + sc.x) + sh.x; hv[1] = v[i].y * rstd * g.y * (1.f + sc.y) + sh.y;
            hv[2] = v[i].z * rstd * g.z * (1.f + sc.z) + sh.z; hv[3] = v[i].w * rstd * g.w * (1.f + sc.w) + sh.w;
            { unsigned w = 0u; w = __builtin_amdgcn_cvt_pk_fp8_f32(__builtin_amdgcn_fmed3f(hv[0], -448.f, 448.f), __builtin_amdgcn_fmed3f(hv[1], -448.f, 448.f), w, false);
              w = __builtin_amdgcn_cvt_pk_fp8_f32(__builtin_amdgcn_fmed3f(hv[2], -448.f, 448.f), __builtin_amdgcn_fmed3f(hv[3], -448.f, 448.f), w, true);
              H8w[((size_t)r * D + e0) >> 2] = w; }
#pragma unroll
            for (int e = 0; e < 16; ++e) { const float4 w4 = *reinterpret_cast<const float4*>(rw + e * 1024 + e0); lg[e] += hv[0] * w4.x + hv[1] * w4.y + hv[2] * w4.z + hv[3] * w4.w; }
            __builtin_amdgcn_sched_barrier(0);
        }
        float r8[8], r4[4], r2[2], r1;
        { const bool up = (F.lane & 32) != 0;
#pragma unroll
          for (int i = 0; i < 8; ++i) { const float keep = up ? lg[8 + i] : lg[i], give = up ? lg[i] : lg[8 + i]; r8[i] = keep + __shfl_xor(give, 32, 64); } }
        { const bool up = (F.lane & 16) != 0;
#pragma unroll
          for (int i = 0; i < 4; ++i) { const float keep = up ? r8[4 + i] : r8[i], give = up ? r8[i] : r8[4 + i]; r4[i] = keep + __shfl_xor(give, 16, 64); } }
        { const bool up = (F.lane & 8) != 0;
#pragma unroll
          for (int i = 0; i < 2; ++i) { const float keep = up ? r4[2 + i] : r4[i], give = up ? r4[i] : r4[2 + i]; r2[i] = keep + __shfl_xor(give, 8, 64); } }
        { const bool up = (F.lane & 4) != 0; const float keep = up ? r2[1] : r2[0], give = up ? r2[0] : r2[1]; r1 = keep + __shfl_xor(give, 4, 64); }
        r1 += __shfl_xor(r1, 1, 64); r1 += __shfl_xor(r1, 2, 64);
        float mx = r1;
#pragma unroll
        for (int o = 4; o < 64; o <<= 1) mx = fmaxf(mx, __shfl_xor(mx, o, 64));
        const float pe = expf(r1 - mx);
        float se = pe;
#pragma unroll
        for (int o = 4; o < 64; o <<= 1) se += __shfl_xor(se, o, 64);
        if ((F.lane & 3) == 0) {
            const int e = ((F.lane >> 5) & 1) * 8 + ((F.lane >> 4) & 1) * 4 + ((F.lane >> 3) & 1) * 2 + ((F.lane >> 2) & 1);
            const float a = pe / se;
            if (t < CTX) affc[((size_t)(b * NEXP + e)) * CTX + t] = a; else affl[((size_t)(b * NEXP + e)) * SEQL + (t - CTX)] = a;
        }
    }
}
__device__ __forceinline__ int block_exscan(int v, int* tmp, int& total) {
    const int tid_ = TIDX, lane = tid_ & 63, w = tid_ >> 6;
    int inc = v;
#pragma unroll
    for (int o = 1; o < 64; o <<= 1) { const int t = __shfl_up(inc, o, 64); if (lane >= o) inc += t; }
    __syncthreads();
    if (lane == 63) tmp[w] = inc;
    __syncthreads();
    int base = 0, tot = 0;
#pragma unroll
    for (int i = 0; i < 8; ++i) { const int x = tmp[i]; if (i < w) base += x; tot += x; }
    total = tot;
    return base + inc - v;
}
__device__ __forceinline__ void topk_select(const Ctx& F, const float* __restrict__ aff, int n, int cap, int* __restrict__ rows_out, float* __restrict__ gate_out,
                                            int* __restrict__ slot_out, int rowbase, int padTo) {
    int* hist = (int*)F.lds; int* sh = hist + 4096; int* tmp = sh + 8;
    unsigned key[32];
#pragma unroll
    for (int q = 0; q < 8; ++q) {
        const int i = F.tid * 32 + q * 4;
        u32x4 v = {0u, 0u, 0u, 0u};
        if (i < n) v = *reinterpret_cast<const u32x4*>(aff + i);
        key[q * 4 + 0] = v[0]; key[q * 4 + 1] = v[1]; key[q * 4 + 2] = v[2]; key[q * 4 + 3] = v[3];
    }
    unsigned prefix = 0u; int k = cap;
#pragma unroll 1
    for (int pass = 0; pass < 3; ++pass) {
        const int shift = (pass == 0) ? 20 : (pass == 1 ? 10 : 0), nb = (pass == 0) ? 4096 : 1024, pb = nb >> 9;
        __syncthreads();
        for (int b = F.tid; b < nb; b += NTHR) hist[b] = 0;
        __syncthreads();
#pragma unroll
        for (int j = 0; j < 32; ++j) { const bool in = (pass == 0) || ((key[j] >> (shift + 10)) == prefix); if (in) atomicAdd(&hist[(key[j] >> shift) & (unsigned)(nb - 1)], 1); }
        __syncthreads();
        int mysum = 0;
        for (int b = 0; b < pb; ++b) mysum += hist[F.tid * pb + b];
        int total; const int below = block_exscan(mysum, tmp, total);
        const int above0 = total - below - mysum;
        if (above0 < k && k <= above0 + mysum) {
            int above = above0, d = F.tid * pb + pb - 1;
            for (; d > F.tid * pb; --d) { const int c = hist[d]; if (above + c >= k) break; above += c; }
            sh[0] = d; sh[1] = k - above;
        }
        __syncthreads();
        prefix = (prefix << ((pass == 0) ? 12 : 10)) | (unsigned)sh[0]; k = sh[1];
    }
    const unsigned T = prefix;
    int cgt = 0, ceq = 0;
#pragma unroll
    for (int j = 0; j < 32; ++j) { cgt += (key[j] > T) ? 1 : 0; ceq += (key[j] == T) ? 1 : 0; }
    int tot; const int eq_before = block_exscan(ceq, tmp, tot);
    int take = k - eq_before; take = take < 0 ? 0 : (take > ceq ? ceq : take);
    int slot = block_exscan(cgt + take, tmp, tot);
#pragma unroll
    for (int j = 0; j < 32; ++j) {
        const int i = F.tid * 32 + j;
        bool sel = key[j] > T;
        if (key[j] == T && take > 0) { sel = true; --take; }
        if (i < n) {
            if (sel) { rows_out[slot] = rowbase + i; gate_out[slot] = __uint_as_float(key[j]); slot_out[i] = slot; ++slot; }
            else slot_out[i] = -1;
        }
    }
    for (int s2 = cap + F.tid; s2 < padTo; s2 += NTHR) { rows_out[s2] = rowbase; gate_out[s2] = 0.f; }
}
__device__ __forceinline__ void ph_topk(const Ctx& F, bool need_ctx) {
    int* rows = (int*)(F.ws + WS_ROWS); float* gv = (float*)(F.ws + WS_GATEV);
    const int nprob = NB * NEXP * (need_ctx ? 2 : 1);
    for (int p = F.bid; p < nprob; p += F.G) {
        if (p < NB * NEXP) { const int b = p / NEXP;
            topk_select(F, (const float*)(F.ws + WS_AFFL) + (size_t)p * SEQL, SEQL, CAPL, rows + p * CAPL, gv + p * CAPL, (int*)(F.ws + WS_SLOTL) + (size_t)p * SEQL, b * NTOK + CTX, CAPL);
        } else { const int q = p - NB * NEXP, b = q / NEXP;
            topk_select(F, (const float*)(F.ws + WS_AFFC) + (size_t)q * CTX, CTX, CAPC, rows + NB * NEXP * CAPL + q * 256, gv + NB * NEXP * CAPL + q * 256, (int*)(F.ws + WS_SLOTC) + (size_t)q * CTX, b * NTOK, 256);
        }
    }
}
__device__ __forceinline__ void ph_gather(const Ctx& F, const bf16* __restrict__ H, bf16* __restrict__ XG, int nflat) {
    const int* rows = (const int*)(F.ws + WS_ROWS);
    for (int f = F.bid * 8 + F.wave; f < nflat; f += F.G * 8) {
        const u32x4* s = reinterpret_cast<const u32x4*>(H + (size_t)rows[f] * D);
        u32x4* d = reinterpret_cast<u32x4*>(XG + (size_t)f * D);
        d[F.lane] = s[F.lane]; d[64 + F.lane] = s[64 + F.lane];
    }
}
__device__ __forceinline__ bool moe_unit(int bid, int G, int i, int nN, int nrt, int& rt, int& pn) {
    if ((G & 7) != 0 || (nN & 3) != 0) { const int t = bid + i * G; if (t >= nrt * nN) return false; rt = t / nN; pn = t - rt * nN; return true; }
    const int x = bid & 7, lb = bid >> 3, W = G >> 3, v = lb + i * W;
    const int per_g = 8 * nN, nlat = 4 * per_g;
    if (v < nlat) { const int gl = v / per_g, rem = v - gl * per_g, pnb = rem >> 5, r2 = rem & 31; rt = (x + 8 * gl) * 8 + (r2 >> 2); pn = pnb * 4 + (r2 & 3); return true; }
    const int w = v - nlat, nct = (nrt > 256) ? 4 : 0;
    if (w >= nct * nN) return false;
    const int c = w / nN; rt = 256 + x + 8 * c; pn = w - c * nN; return true;
}
struct MoeSched {
    const char* A; const char* W; size_t wsub; int nN, nrt, bid, G; size_t rowb;
    __device__ __forceinline__ bool get(int i, GUnit& u) const {
        int rt, pn; if (!moe_unit(bid, G, i, nN, nrt, rt, pn)) return false;
        const int e = (rt < 256) ? ((rt >> 3) & 15) : ((rt - 256) & 15);
        u.a = A + (size_t)rt * 256 * rowb; u.b = W + (size_t)e * 3072 * rowb + wsub + (size_t)pn * 256 * rowb; u.id = rt * nN + pn; return true; }
};
struct EpiMoeUp { unsigned char* HID;
    __device__ __forceinline__ bool operator()(Acc& acc, int t) const {
        const int brow = (t / 8) * 256, bcol = (t % 8) * 256;
        const int _t = opaque_tid(), _w = _t >> 6, _l = _t & 63, _wr = _w >> 2, _wc = _w & 3, _fr = _l & 15, _fq = _l >> 4;
#pragma unroll
        for (int ai = 0; ai < 2; ++ai)
#pragma unroll
            for (int m = 0; m < 4; ++m) {
                const int row = brow + ai * 128 + _wr * 64 + m * 16 + _fr, f = bcol / 2 + _wc * 32 + _fq * 8;
                unsigned w2[2];
#pragma unroll
                for (int bj = 0; bj < 2; ++bj) {
                    const f32x4 a = acc[ai][bj][m][0] * 0.03125f, g = acc[ai][bj][m][1] * 0.03125f;
                    float h[4];
#pragma unroll
                    for (int j = 0; j < 4; ++j) h[j] = __builtin_amdgcn_fmed3f(silu_fast(a[j]) * g[j], -448.f, 448.f);
                    unsigned w = 0u; w = __builtin_amdgcn_cvt_pk_fp8_f32(h[0], h[1], w, false); w = __builtin_amdgcn_cvt_pk_fp8_f32(h[2], h[3], w, true);
                    w2[bj] = w;
                }
                const u32x2 ww = {w2[0], w2[1]};
                *reinterpret_cast<u32x2*>(HID + (size_t)row * D + f) = ww;
            }
        return true; } };
struct EpiMoeDown { bf16* Y; const float* gate;
    __device__ __forceinline__ bool operator()(Acc& acc, int t) const {
        const int brow = (t / 4) * 256, bcol = (t % 4) * 256;
        const int _t = opaque_tid(), _w = _t >> 6, _l = _t & 63, _wr = _w >> 2, _wc = _w & 3, _fr = _l & 15, _fq = _l >> 4;
        const float* gp = gate + brow + _wr * 64 + _fr;
        float g8[2][4];
#pragma unroll
        for (int ai = 0; ai < 2; ++ai)
#pragma unroll
            for (int m = 0; m < 4; ++m) g8[ai][m] = gp[ai * 128 + m * 16] * 0.03125f;
        bf16* dst = Y + (size_t)(brow + _wr * 64) * D + bcol + _wc * 64;
#pragma unroll
        for (int ai = 0; ai < 2; ++ai)
#pragma unroll
            for (int m = 0; m < 4; ++m) {
                const float g = g8[ai][m];
                store_rows_bf16(dst + (size_t)(ai * 128 + m * 16) * D, D, _fr, _fq, acc[ai][0][m][0] * g, acc[ai][0][m][1] * g, acc[ai][1][m][0] * g, acc[ai][1][m][1] * g);
                __builtin_amdgcn_sched_barrier(0);
            }
        return true; } };
struct MoeGSched {
    const char* A; const char* W; const int* rowidx; int nN, nrt, bid, G; size_t rowb;
    __device__ __forceinline__ bool get(int i, GUnit& u) const {
        int rt, pn; if (!moe_unit(bid, G, i, nN, nrt, rt, pn)) return false;
        const int e = (rt < 256) ? ((rt >> 3) & 15) : ((rt - 256) & 15);
        u.a = A; u.b = W + (size_t)e * 3072 * rowb + (size_t)pn * 256 * rowb; u.id = rt * nN + pn; return true; }
    __device__ __forceinline__ const int* rows(const GUnit& u) const { return rowidx + (u.id / nN) * 256; }
};
__device__ __forceinline__ void ph_moe_up(const Ctx& F, const unsigned char* H8, const unsigned char* EXPW8, unsigned char* HID8, int nrt) {
    MoeGSched S; S.A = (const char*)H8; S.W = (const char*)EXPW8; S.rowidx = (const int*)(F.ws + WS_ROWS); S.nN = 8; S.nrt = nrt; S.bid = F.bid; S.G = F.G; S.rowb = 1024;
    const EpiMoeUp E{HID8};
    gemm_phase<true, MoeGSched, EpiMoeUp, true, true>(F.lds, 512, 512, 512, S, E);
}
__device__ __forceinline__ void ph_moe_down(const Ctx& F, const unsigned char* HID8, const unsigned char* EXPW8, bf16* Y, int nrt) {
    MoeSched S; S.A = (const char*)HID8; S.W = (const char*)EXPW8; S.wsub = (size_t)2048 * 1024; S.nN = 4; S.nrt = nrt; S.bid = F.bid; S.G = F.G; S.rowb = 1024;
    const EpiMoeDown E{Y, (const float*)(F.ws + WS_GATEV)};
    gemm_phase<true, MoeSched, EpiMoeDown, false, true, true>(F.lds, 512, 512, 512, S, E);
}
__device__ __forceinline__ void ph_moe_combine(const Ctx& F, int layer, const bf16* __restrict__ Y, bool need_ctx, int next_layer, bf16* __restrict__ H) {
    const int* slotl = (const int*)(F.ws + WS_SLOTL); const int* slotc = (const int*)(F.ws + WS_SLOTC);
    for (int r = F.bid * 8 + F.wave; r < MALL; r += F.G * 8) {
        const int b = r / NTOK, t = r - b * NTOK;
        if (!need_ctx && t < CTX) continue;
        float acc[16];
#pragma unroll
        for (int i = 0; i < 16; ++i) acc[i] = 0.f;
        int flatv = -1;
        if (F.lane < NEXP) {
            if (t < CTX) { const int s = slotc[(size_t)(b * NEXP + F.lane) * CTX + t]; flatv = (s < 0) ? -1 : NB * NEXP * CAPL + (b * NEXP + F.lane) * 256 + s; }
            else { const int s = slotl[(size_t)(b * NEXP + F.lane) * SEQL + (t - CTX)]; flatv = (s < 0) ? -1 : (b * NEXP + F.lane) * CAPL + s; }
        }
        float* xp = xrow(F, r) + F.lane * 4;
        float4 xv[4];
#pragma unroll
        for (int i = 0; i < 4; ++i) xv[i] = *reinterpret_cast<const float4*>(xp + i * 256);
        const int ms = (t < CTX) ? 2 : b;
        const float* g2 = (const float*)(F.ws + WS_MODS) + ((size_t)layer * 3 + ms) * 6144 + 5120 + F.lane * 4;
        float4 g2v[4], gnv[4], shv[4], scv[4];
#pragma unroll
        for (int i = 0; i < 4; ++i) g2v[i] = *reinterpret_cast<const float4*>(g2 + i * 256);
        if (next_layer >= 0) {
            const float* gn = F.in[I_NMG] + next_layer * D + F.lane * 4;
            const float* mb = (const float*)(F.ws + WS_MODS) + ((size_t)next_layer * 3 + ms) * 6144 + F.lane * 4;
#pragma unroll
            for (int i = 0; i < 4; ++i) { gnv[i] = *reinterpret_cast<const float4*>(gn + i * 256); shv[i] = *reinterpret_cast<const float4*>(mb + i * 256); scv[i] = *reinterpret_cast<const float4*>(mb + 1024 + i * 256); }
        }
        unsigned long long mask = __ballot(flatv >= 0);
        while (mask) {
            const int e0 = __builtin_ctzll(mask); mask &= mask - 1;
            const bool two = mask != 0ull;
            const int e1 = two ? __builtin_ctzll(mask) : e0; if (two) mask &= mask - 1;
            const int f0 = __shfl(flatv, e0, 64), f1 = __shfl(flatv, e1, 64);
            const u32x2* yp0 = reinterpret_cast<const u32x2*>(Y + (size_t)f0 * D + F.lane * 4);
            const u32x2* yp1 = reinterpret_cast<const u32x2*>(Y + (size_t)f1 * D + F.lane * 4);
            u32x2 a[4], c[4];
#pragma unroll
            for (int i = 0; i < 4; ++i) { a[i] = yp0[i * 64]; c[i] = yp1[i * 64]; }
            const float w1 = two ? 1.f : 0.f;
#pragma unroll
            for (int i = 0; i < 4; ++i) {
                acc[i * 4 + 0] += __uint_as_float(a[i][0] << 16) + w1 * __uint_as_float(c[i][0] << 16); acc[i * 4 + 1] += __uint_as_float(a[i][0] & 0xffff0000u) + w1 * __uint_as_float(c[i][0] & 0xffff0000u);
                acc[i * 4 + 2] += __uint_as_float(a[i][1] << 16) + w1 * __uint_as_float(c[i][1] << 16); acc[i * 4 + 3] += __uint_as_float(a[i][1] & 0xffff0000u) + w1 * __uint_as_float(c[i][1] & 0xffff0000u);
            }
        }
        float ss = 0.f;
#pragma unroll
        for (int i = 0; i < 4; ++i) {
            float4 x = xv[i]; const float4 g = g2v[i];
            x.x += g.x * acc[i * 4 + 0]; x.y += g.y * acc[i * 4 + 1]; x.z += g.z * acc[i * 4 + 2]; x.w += g.w * acc[i * 4 + 3];
            *reinterpret_cast<float4*>(xp + i * 256) = x;
            xv[i] = x;
            ss += x.x * x.x + x.y * x.y + x.z * x.z + x.w * x.w;
        }
        if (next_layer >= 0) {
            ss = wave_sum(ss);
            const float rstd = rsqrtf(ss * (1.f / D) + EPS);
            bf16* hp = H + (size_t)r * D + F.lane * 4;
#pragma unroll
            for (int i = 0; i < 4; ++i) {
                const float4 g = gnv[i], sh = shv[i], sc = scv[i];
                const float4 x = xv[i];
                u32x2 w = {cvtpk(x.x * rstd * g.x * (1.f + sc.x) + sh.x, x.y * rstd * g.y * (1.f + sc.y) + sh.y), cvtpk(x.z * rstd * g.z * (1.f + sc.z) + sh.z, x.w * rstd * g.w * (1.f + sc.w) + sh.w)};
                *reinterpret_cast<u32x2*>(hp + i * 256) = w;
            }
        }
    }
}

struct RetC { const float* tab;
    __device__ __forceinline__ float lg2(int dir, int h) const { return tab[dir * 4 + h]; } };
__device__ __forceinline__ RetC ret_consts(const Ctx& F) { RetC c; c.tab = (const float*)(F.ws + WS_RETC); return c; }
struct EpiRetIn { bf16 *Q, *KR, *KFT, *KBT, *VT, *SG; RetC rc; const float* rope;
    __device__ __forceinline__ bool operator()(Acc& acc, int t) const {
        const int pm = t / 24, pn = t - pm * 24, brow = pm * 256;
        const int b = brow / NTOK, tt0 = brow - b * NTOK;
        const int _t = opaque_tid(), _w = _t >> 6, _l = _t & 63, _wr = _w >> 2, _wc = _w & 3, _fr = _l & 15, _fq = _l >> 4;
        if (pn < 8) {
            const bool isk = pn >= 4; const int h = pn & 3;
            if (isk) {
#pragma unroll
                for (int ai = 0; ai < 2; ++ai) for (int bj = 0; bj < 2; ++bj) for (int m = 0; m < 4; ++m) for (int n = 0; n < 2; ++n) acc[ai][bj][m][n] *= 0.0625f;
            }
            if (tt0 >= CTX) {
                const float* rbase = rope + ((size_t)(tt0 - CTX + _wr * 64 + _fr) * 128 + _wc * 32 + 4 * _fq) * 2;
                f32x4 rc_[4], rn_[4] = {};
                { const f32x4* tp = reinterpret_cast<const f32x4*>(rbase); rc_[0] = tp[0]; rc_[1] = tp[1]; rc_[2] = tp[8]; rc_[3] = tp[9]; }
#pragma unroll
                for (int ai = 0; ai < 2; ++ai)
#pragma unroll
                    for (int m = 0; m < 4; ++m) {
                        if ((ai * 4 + m) < 7) { const int kn = ai * 4 + m + 1;
                            const f32x4* tp = reinterpret_cast<const f32x4*>(rbase + (size_t)((kn >> 2) * 128 + (kn & 3) * 16) * 256); rn_[0] = tp[0]; rn_[1] = tp[1]; rn_[2] = tp[8]; rn_[3] = tp[9]; }
#pragma unroll
                        for (int n = 0; n < 2; ++n) {
                            const f32x4 c01 = rc_[n * 2], c23 = rc_[n * 2 + 1];
                            const float cs[4] = {c01[0], c01[2], c23[0], c23[2]}, sn[4] = {c01[1], c01[3], c23[1], c23[3]};
#pragma unroll
                            for (int j = 0; j < 4; ++j) {
                                const float x1 = acc[ai][0][m][n][j], x2 = acc[ai][1][m][n][j];
                                acc[ai][0][m][n][j] = x1 * cs[j] - x2 * sn[j]; acc[ai][1][m][n][j] = x2 * cs[j] + x1 * sn[j];
                            }
                        }
#pragma unroll
                        for (int q = 0; q < 4; ++q) rc_[q] = rn_[q];
                        __builtin_amdgcn_sched_barrier(0);
                    }
            }
            bf16* dst = isk ? KR : Q;
            acc_foreach<true>(acc, [&](int row, int col4, f32x4 v) {
                u32x2 w = {cvtpk(v[0], v[1]), cvtpk(v[2], v[3])};
                *reinterpret_cast<u32x2*>(dst + (size_t)(brow + row) * D + h * 256 + col4) = w; });
            if (isk) {
                const float lf = rc.lg2(0, h), lb = rc.lg2(1, h);
                unsigned short* kft = (unsigned short*)KFT + (size_t)((b * 4 + h) * 256) * NTOK + tt0;
                unsigned short* kbt = (unsigned short*)KBT + (size_t)((b * 4 + h) * 256) * NTOK + tt0;
                acc_foreach<true>(acc, [&](int row, int col4, f32x4 v) {
                    const float wf = __builtin_amdgcn_exp2f((float)(RCH - 1 - row) * lf), wb = __builtin_amdgcn_exp2f((float)row * lb);
#pragma unroll
                    for (int j = 0; j < 4; ++j) { kft[(size_t)(col4 + j) * NTOK + row] = f2bf(v[j] * wf); kbt[(size_t)(col4 + j) * NTOK + row] = f2bf(v[j] * wb); } });
            }
        } else if (pn < 16) {
            const int h = (pn - 8) >> 1, e0 = ((pn - 8) & 1) * 256;
            unsigned short* vt = (unsigned short*)VT + (size_t)((b * 4 + h) * 512 + e0) * NTOK + tt0;
            acc_foreach<true>(acc, [&](int row, int col4, f32x4 v) {
#pragma unroll
                for (int j = 0; j < 4; ++j) vt[(size_t)(col4 + j) * NTOK + row] = f2bf(v[j]); });
        } else {
            const int c0 = (pn - 16) * 256;
            bf16* dst = SG + (size_t)(brow + _wr * 64) * 2048 + c0 + _wc * 64;
#pragma unroll
            for (int ai = 0; ai < 2; ++ai)
#pragma unroll
                for (int m = 0; m < 4; ++m) {
                    f32x4 s[2][2];
#pragma unroll
                    for (int bj = 0; bj < 2; ++bj)
#pragma unroll
                        for (int n = 0; n < 2; ++n)
#pragma unroll
                            for (int j = 0; j < 4; ++j) s[bj][n][j] = silu_fast(acc[ai][bj][m][n][j]);
                    store_rows_bf16(dst + (size_t)(ai * 128 + m * 16) * 2048, 2048, _fr, _fq, s[0][0], s[0][1], s[1][0], s[1][1]);
                    __builtin_amdgcn_sched_barrier(0);
                }
        }
        return true; } };
struct RetPSched { const char* Q; const char* K; int bid, G;
    __device__ __forceinline__ bool get(int i, GUnit& u) const {
        const int t = bid + i * G; if (t >= 8 * RNC) return false;
        const int bh = t / RNC, cc = t - bh * RNC, b = bh >> 2, h = bh & 3;
        const size_t off = ((size_t)(b * NTOK + cc * RCH) * D + h * 256) * 2;
        u.a = Q + off; u.b = K + off; u.id = t; return true; } };
struct EpiRetP { bf16* P; RetC rc;
    __device__ __forceinline__ bool operator()(Acc& acc, int t) const {
        const int bh = t / RNC, cc = t - bh * RNC, b = bh >> 2, h = bh & 3;
        const float lf = rc.lg2(0, h), lb = rc.lg2(1, h);
        const int _t = opaque_tid(), _w = _t >> 6, _l = _t & 63, _wr = _w >> 2, _wc = _w & 3, _fr = _l & 15, _fq = _l >> 4;
        bf16* dst = P + (size_t)(b * NTOK + cc * RCH + _wr * 64) * D + h * 256 + _wc * 64;
#pragma unroll
        for (int ai = 0; ai < 2; ++ai)
#pragma unroll
            for (int m = 0; m < 4; ++m) {
                const int row = ai * 128 + _wr * 64 + m * 16 + _fr;
                f32x4 o[2][2];
#pragma unroll
                for (int bj = 0; bj < 2; ++bj)
#pragma unroll
                    for (int n = 0; n < 2; ++n) {
                        const f32x4 v = acc[ai][bj][m][n];
#pragma unroll
                        for (int j = 0; j < 4; ++j) { const int d = row - (_wc * 64 + _fq * 16 + bj * 8 + n * 4 + j); o[bj][n][j] = v[j] * __builtin_amdgcn_exp2f(d >= 0 ? (float)d * lf : (float)(-d) * lb); }
                    }
                store_rows_bf16(dst + (size_t)(ai * 128 + m * 16) * D, D, _fr, _fq, o[0][0], o[0][1], o[1][0], o[1][1]);
                __builtin_amdgcn_sched_barrier(0);
            }
        return true; } };
struct RetSSched { const char* VT; const char* KFT; const char* KBT; int bid, G;
    __device__ __forceinline__ bool get(int i, GUnit& u) const {
        const int t = bid + i * G; if (t >= 2 * 8 * RNC * 2) return false;
        const int eh = t & 1, r = t >> 1, cc = r % RNC, q = r / RNC, bh = q & 7, dir = q >> 3;
        u.a = VT + ((size_t)(bh * 512 + eh * 256) * NTOK + cc * RCH) * 2;
        u.b = (dir ? KBT : KFT) + ((size_t)(bh * 256) * NTOK + cc * RCH) * 2; u.id = t; return true; } };
struct EpiRetS { bf16* ST;
    __device__ __forceinline__ bool operator()(Acc& acc, int t) const {
        const int eh = t & 1, r = t >> 1, cc = r % RNC, q = r / RNC;
        const int _t = opaque_tid(), _w = _t >> 6, _l = _t & 63, _wr = _w >> 2, _wc = _w & 3, _fr = _l & 15, _fq = _l >> 4;
        bf16* dst = ST + ((size_t)(q * 512 + eh * 256 + _wr * 64)) * NTOK + cc * RCH + _wc * 64;
#pragma unroll
        for (int ai = 0; ai < 2; ++ai)
#pragma unroll
            for (int m = 0; m < 4; ++m) {
                store_rows_bf16(dst + (size_t)(ai * 128 + m * 16) * NTOK, NTOK, _fr, _fq, acc[ai][0][m][0], acc[ai][0][m][1], acc[ai][1][m][0], acc[ai][1][m][1]);
                __builtin_amdgcn_sched_barrier(0);
            }
        return true; } };
__device__ __forceinline__ void ph_ret_scan(const Ctx& F, bf16* ST, const RetC& rc) {
    const int nel = 2 * 8 * 512 * 256;
    for (int x = F.bid * NTHR + F.tid; x < nel; x += F.G * NTHR) {
        const int d = x & 255, e = (x >> 8) & 511, q = x >> 17, dir = q >> 3, h = q & 3;
        unsigned short* p = (unsigned short*)ST + ((size_t)(q * 512 + e)) * NTOK + d;
        const float Dk = __builtin_amdgcn_exp2f((float)RCH * rc.lg2(dir, h));
        unsigned short v[RNC];
#pragma unroll
        for (int cc = 0; cc < RNC; ++cc) v[cc] = p[cc * RCH];
        if (dir == 0) {
            float st = 0.f;
#pragma unroll
            for (int cc = 0; cc < RNC; ++cc) { const float s = bf2f(v[cc]); p[cc * RCH] = f2bf(st); st = Dk * st + s; }
        } else {
            float st = bf2f(v[0]); p[0] = 0;
#pragma unroll
            for (int cc = RNC - 1; cc >= 1; --cc) { const float s = bf2f(v[cc]); p[cc * RCH] = f2bf(st); st = Dk * st + s; }
        }
    }
}
struct RetOSched { const char* Q; const char* P; const char* ST; const char* VT; int bid, G, cnt;
    __device__ __forceinline__ bool get(int i, GUnit& u) const {
        const int ti = i / 3, s = i - ti * 3; const int t = bid + ti * G; if (t >= 8 * RNC * 2) return false;
        const int eh = t & 1, r = t >> 1, cc = r % RNC, bh = r / RNC, b = bh >> 2, h = bh & 3;
        const size_t qoff = ((size_t)(b * NTOK + cc * RCH) * D + h * 256) * 2;
        if (s < 2) { u.a = Q + qoff; u.b = ST + ((size_t)((s * 8 + bh) * 512 + eh * 256) * NTOK + cc * RCH) * 2; }
        else { u.a = P + qoff; u.b = VT + ((size_t)(bh * 512 + eh * 256) * NTOK + cc * RCH) * 2; }
        u.id = t * 3 + s; return true; } };
struct EpiRetO { bf16* O; RetC rc;
    __device__ __forceinline__ bool operator()(Acc& acc, int id) const {
        const int t = id / 3, s = id - t * 3;
        const int eh = t & 1, r = t >> 1, cc = r % RNC, bh = r / RNC, b = bh >> 2, h = bh & 3;
        const float lf = rc.lg2(0, h), lb = rc.lg2(1, h);
        const int _t = opaque_tid(), _w = _t >> 6, _l = _t & 63, _wr = _w >> 2, _fr = _l & 15;
#pragma unroll
        for (int ai = 0; ai < 2; ++ai)
#pragma unroll
            for (int m = 0; m < 4; ++m) {
                const int il = ai * 128 + _wr * 64 + m * 16 + _fr;
                const float xf = (float)(il + 1) * lf, xb = (float)(RCH - il) * lb;
                const float sc = __builtin_amdgcn_exp2f(s == 0 ? xf - xb : (s == 1 ? xb : 0.f));
#pragma unroll
                for (int bj = 0; bj < 2; ++bj)
#pragma unroll
                    for (int n = 0; n < 2; ++n) acc[ai][bj][m][n] *= sc;
            }
        if (s < 2) return false;
        const int _wc = _w & 3, _fq = _l >> 4;
        bf16* dst = O + (size_t)(b * NTOK + cc * RCH + _wr * 64) * 2048 + h * 512 + eh * 256 + _wc * 64;
#pragma unroll
        for (int ai = 0; ai < 2; ++ai)
#pragma unroll
            for (int m = 0; m < 4; ++m) {
                store_rows_bf16(dst + (size_t)(ai * 128 + m * 16) * 2048, 2048, _fr, _fq, acc[ai][0][m][0], acc[ai][0][m][1], acc[ai][1][m][0], acc[ai][1][m][1]);
                __builtin_amdgcn_sched_barrier(0);
            }
        return true; } };
__device__ __forceinline__ void ph_ret_gate(const Ctx& F, bf16* __restrict__ O, const bf16* __restrict__ SG) {
    const float* gng = F.in[I_RGN] + F.lane * 8;
    const f32x4 ga = *reinterpret_cast<const f32x4*>(gng), gb = *reinterpret_cast<const f32x4*>(gng + 4);
    const float gn[8] = {ga[0], ga[1], ga[2], ga[3], gb[0], gb[1], gb[2], gb[3]};
    for (int r = F.bid * 8 + F.wave; r < MALL; r += F.G * 8) {
        u32x4* op = reinterpret_cast<u32x4*>(O + (size_t)r * 2048 + F.lane * 8);
        const u32x4* gp = reinterpret_cast<const u32x4*>(SG + (size_t)r * 2048 + F.lane * 8);
        u32x4 ov[4], gv[4];
#pragma unroll
        for (int h = 0; h < 4; ++h) { ov[h] = op[h * 64]; gv[h] = gp[h * 64]; }
#pragma unroll
        for (int h = 0; h < 4; ++h) {
            float x[8]; float ss = 0.f;
#pragma unroll
            for (int q = 0; q < 4; ++q) { x[2 * q] = __uint_as_float(ov[h][q] << 16); x[2 * q + 1] = __uint_as_float(ov[h][q] & 0xffff0000u); ss += x[2 * q] * x[2 * q] + x[2 * q + 1] * x[2 * q + 1]; }
            ss = wave_sum(ss);
            const float rstd = rsqrtf(ss * (1.f / 512.f) + EPS);
            u32x4 w;
#pragma unroll
            for (int q = 0; q < 4; ++q) w[q] = cvtpk(x[2 * q] * rstd * gn[2 * q] * __uint_as_float(gv[h][q] << 16), x[2 * q + 1] * rstd * gn[2 * q + 1] * __uint_as_float(gv[h][q] & 0xffff0000u));
            op[h * 64] = w;
        }
    }
}

__device__ __forceinline__ void hy_features(const Ctx& F, int n, bf16* A2P, float* A2C) {
    const float* w1 = F.in[I_HW1]; const float* b1 = F.in[I_HB1]; const float* w2 = F.in[I_HW2]; const float* b2 = F.in[I_HB2]; const float* fr = F.in[I_HFREQ];
    const int j = F.lane;
    for (int t = F.bid * 8 + F.wave; t < n; t += F.G * 8) {
        const float tn = (float)t / (float)(n - 1), w = 6.283185307179586f * (float)t / (float)n;
        float s = tn * w1[j] + b1[j];
        const float fl = 1e-4f + (float)(j & 15) * ((15.f - 1e-4f) / 15.f);
        const float csv = (j & 16) ? sinf(fl * w) : cosf(fl * w);
#pragma unroll
        for (int k = 0; k < 16; ++k) s += __shfl(csv, k, 64) * w1[(1 + k) * 64 + j] - __shfl(csv, 16 + k, 64) * w1[(17 + k) * 64 + j];
        const float a1 = sinf(fr[j] * s);
        float s2 = b2[j];
        for (int i = 0; i < 64; ++i) s2 += __shfl(a1, i, 64) * w2[i * 64 + j];
        const float a2 = sinf(fr[64 + j] * s2);
        if (A2C) A2C[t * 64 + j] = a2;
        else { const unsigned short hi = f2bf(a2), lo = f2bf(a2 - bf2f(hi)); unsigned short* p = (unsigned short*)A2P + (size_t)t * 256;
            p[j] = hi; p[64 + j] = lo; p[128 + j] = hi; p[192 + j] = 0; }
    }
}
__device__ __forceinline__ void hy_prologue(const Ctx& F) {
    hy_features(F, FN, (bf16*)(F.ws + WS_A2P), nullptr);
    hy_features(F, CTX, nullptr, (float*)(F.ws + WS_A2C));
    unsigned short* w3p = (unsigned short*)(F.ws + WS_W3P);
    for (int i = F.bid * NTHR + F.tid; i < 4096 * 64; i += F.G * NTHR) {
        const int k = i >> 12, col = i & 4095; const float w = F.in[I_HW3][i];
        const unsigned short hi = f2bf(w), lo = f2bf(w - bf2f(hi)); unsigned short* p = w3p + (size_t)col * 256;
        p[k] = hi; p[64 + k] = hi; p[128 + k] = lo; p[192 + k] = 0; }
}
struct EpiHyIn { bf16* PT; const float* bin;
    __device__ __forceinline__ bool operator()(Acc& acc, int t) const {
        const int brow = (t / 12) * 256, bcol = (t % 12) * 256;
        acc_foreach<false>(acc, [&](int row4, int col, f32x4 v) {
            const float bs = bin[bcol + col];
            u32x2 w = {cvtpk(v[0] + bs, v[1] + bs), cvtpk(v[2] + bs, v[3] + bs)};
            *reinterpret_cast<u32x2*>(PT + (size_t)(bcol + col) * MALL + brow + row4) = w; });
        return true; } };
struct EpiHyTaps { bf16* HT;
    __device__ __forceinline__ bool operator()(Acc& acc, int t) const {
        const int brow = (t / 64) * 256, bcol = (t % 64) * 256;
        const int _t = opaque_tid(), _w = _t >> 6, _l = _t & 63, _wr = _w >> 2, _wc = _w & 3, _fr = _l & 15, _fq = _l >> 4;
        bf16* dst = HT + (size_t)(brow + _wr * 64) * FN + bcol + _wc * 64;
#pragma unroll
        for (int ai = 0; ai < 2; ++ai)
#pragma unroll
            for (int m = 0; m < 4; ++m) {
                const int c = (brow + ai * 128 + _wr * 64 + m * 16 + _fr) & 1023;
                const float delta = fabsf(-3.0701134573253944f + (-15.350567286626972f + 3.0701134573253944f) * ((float)c * (1.f / 1023.f)));
                f32x4 o[2][2];
#pragma unroll
                for (int bj = 0; bj < 2; ++bj)
#pragma unroll
                    for (int n = 0; n < 2; ++n)
#pragma unroll
                        for (int j = 0; j < 4; ++j) o[bj][n][j] = acc[ai][bj][m][n][j] * __expf(-(float)(bcol + _wc * 64 + _fq * 16 + bj * 8 + n * 4 + j) * (1.f / (float)(FN - 1)) * delta);
                store_rows_bf16(dst + (size_t)(ai * 128 + m * 16) * FN, FN, _fr, _fq, o[0][0], o[0][1], o[1][0], o[1][1]);
                __builtin_amdgcn_sched_barrier(0);
            }
        return true; } };

__device__ __forceinline__ int fphys(int i) { return i + ((i >> 5) << 1); }
constexpr int FFT_LDS = (FN + 2 * (FN / 32)) * 8;
__device__ __forceinline__ float2 cmul(float2 a, float2 b) { return make_float2(a.x * b.x - a.y * b.y, a.x * b.y + a.y * b.x); }
__device__ __forceinline__ float2 cmulc(float2 a, float2 b) { return make_float2(a.x * b.x + a.y * b.y, a.y * b.x - a.x * b.y); }
__device__ __forceinline__ float2 unitrev(float x) { return make_float2(__builtin_amdgcn_cosf(x), __builtin_amdgcn_sinf(x)); }
template <int L, bool INV> __device__ __forceinline__ void bfly(float2 (&x)[1 << L]) {
    constexpr int n = 1 << L;
    constexpr float C32[16] = {1.000000000e+00f, 9.807852804e-01f, 9.238795325e-01f, 8.314696123e-01f, 7.071067812e-01f, 5.555702330e-01f, 3.826834324e-01f, 1.950903220e-01f, 6.123233996e-17f, -1.950903220e-01f, -3.826834324e-01f, -5.555702330e-01f, -7.071067812e-01f, -8.314696123e-01f, -9.238795325e-01f, -9.807852804e-01f};
    constexpr float S32[16] = {0.000000000e+00f, 1.950903220e-01f, 3.826834324e-01f, 5.555702330e-01f, 7.071067812e-01f, 8.314696123e-01f, 9.238795325e-01f, 9.807852804e-01f, 1.000000000e+00f, 9.807852804e-01f, 9.238795325e-01f, 8.314696123e-01f, 7.071067812e-01f, 5.555702330e-01f, 3.826834324e-01f, 1.950903220e-01f};
    if (!INV) {
#pragma unroll
        for (int j = L - 1; j >= 0; --j) {
#pragma unroll
            for (int k = 0; k < n; ++k) if (!(k & (1 << j))) {
                const int e = ((k & ((1 << j) - 1)) << (L - 1 - j)) * (32 / n);
                const float2 a = x[k], b = x[k + (1 << j)];
                x[k] = make_float2(a.x + b.x, a.y + b.y);
                const float2 d = make_float2(a.x - b.x, a.y - b.y);
                if (e == 0) x[k + (1 << j)] = d;
                else if (e == 8) x[k + (1 << j)] = make_float2(d.y, -d.x);
                else x[k + (1 << j)] = make_float2(d.x * C32[e] + d.y * S32[e], d.y * C32[e] - d.x * S32[e]);
            }
        }
    } else {
#pragma unroll
        for (int j = 0; j < L; ++j) {
#pragma unroll
            for (int k = 0; k < n; ++k) if (!(k & (1 << j))) {
                const int e = ((k & ((1 << j) - 1)) << (L - 1 - j)) * (32 / n);
                const float2 a = x[k], b = x[k + (1 << j)];
                float2 t;
                if (e == 0) t = b;
                else if (e == 8) t = make_float2(-b.y, b.x);
                else t = make_float2(b.x * C32[e] - b.y * S32[e], b.y * C32[e] + b.x * S32[e]);
                x[k] = make_float2(a.x + t.x, a.y + t.y); x[k + (1 << j)] = make_float2(a.x - t.x, a.y - t.y);
            }
        }
    }
}
constexpr int rev_bits(int k, int L) { int r = 0; for (int j = 0; j < L; ++j) if (k & (1 << j)) r |= 1 << (L - 1 - j); return r; }
template <int L, bool INV> __device__ __forceinline__ void apply_tw(float2 (&x)[1 << L], int r, float inv_n) {
    float2 tw[L];
#pragma unroll
    for (int j = 0; j < L; ++j) tw[j] = unitrev((float)(r << j) * inv_n);
#pragma unroll
    for (int k = 1; k < (1 << L); ++k) {
#pragma unroll
        for (int j = 0; j < L; ++j) if ((rev_bits(k, L) >> j) & 1) x[k] = INV ? cmul(x[k], tw[j]) : cmulc(x[k], tw[j]);
    }
}
template <bool INV> __device__ __forceinline__ void fft_pass_a(float2* X, int tid) {
#pragma unroll 1
    for (int g = 0; g < 2; ++g) {
        const int r = tid + 512 * g; float2 x[16];
#pragma unroll
        for (int k = 0; k < 16; ++k) x[k] = X[fphys(r + k * 1024)];
        if (INV) { apply_tw<4, true>(x, r, 1.f / 16384.f); bfly<4, true>(x); }
        else { bfly<4, false>(x); apply_tw<4, false>(x, r, 1.f / 16384.f); }
#pragma unroll
        for (int k = 0; k < 16; ++k) X[fphys(r + k * 1024)] = x[k];
    }
}
template <bool INV> __device__ __forceinline__ void fft_pass_b(float2* X, int tid) {
    const int r = tid & 31, base = (tid >> 5) * 1024 + r; float2 x[32];
#pragma unroll
    for (int k = 0; k < 32; ++k) x[k] = X[fphys(base + k * 32)];
    if (INV) { apply_tw<5, true>(x, r, 1.f / 1024.f); bfly<5, true>(x); }
    else { bfly<5, false>(x); apply_tw<5, false>(x, r, 1.f / 1024.f); }
#pragma unroll
    for (int k = 0; k < 32; ++k) X[fphys(base + k * 32)] = x[k];
}
typedef _Float16 f16x2 __attribute__((ext_vector_type(2)));
__device__ __forceinline__ unsigned pack_h2(float2 v) { f16x2 h = {(_Float16)v.x, (_Float16)v.y}; return *reinterpret_cast<unsigned*>(&h); }
__device__ __forceinline__ float2 unpack_h2(unsigned u) { const f16x2 h = *reinterpret_cast<const f16x2*>(&u); return make_float2((float)h[0], (float)h[1]); }
template <class Gen> __device__ __forceinline__ void fwd_a(float2* X, Gen gen) {
    const int tid = opaque_tid();
#pragma unroll 1
    for (int g = 0; g < 2; ++g) {
        const int r = tid + 512 * g; float2 x[16];
#pragma unroll
        for (int k = 0; k < 16; ++k) x[k] = gen(r + k * 1024);
        bfly<4, false>(x); apply_tw<4, false>(x, r, 1.f / 16384.f);
#pragma unroll
        for (int k = 0; k < 16; ++k) X[fphys(r + k * 1024)] = x[k];
    }
}
template <class Out> __device__ __forceinline__ void inv_a(float2* X, Out out) {
    const int tid = opaque_tid();
#pragma unroll 1
    for (int g = 0; g < 2; ++g) {
        const int r = tid + 512 * g; float2 x[16];
#pragma unroll
        for (int k = 0; k < 16; ++k) x[k] = X[fphys(r + k * 1024)];
        apply_tw<4, true>(x, r, 1.f / 16384.f); bfly<4, true>(x);
        out(r, x);
    }
}
__device__ __forceinline__ void mid_c(float2* X, const unsigned* __restrict__ fs) {
    const int tid = opaque_tid();
    float2 x[32]; f32x4* p = reinterpret_cast<f32x4*>(X + fphys(tid * 32));
    const u32x4* fp = reinterpret_cast<const u32x4*>(fs + tid * 32);
    u32x4 fv[8];
#pragma unroll
    for (int k = 0; k < 8; ++k) fv[k] = fp[k];
#pragma unroll
    for (int k = 0; k < 16; ++k) { const f32x4 v = p[k]; x[2 * k] = make_float2(v[0], v[1]); x[2 * k + 1] = make_float2(v[2], v[3]); }
    bfly<5, false>(x);
#pragma unroll
    for (int k = 0; k < 32; ++k) x[k] = cmul(x[k], unpack_h2(fv[k >> 2][k & 3]));
    bfly<5, true>(x);
#pragma unroll
    for (int k = 0; k < 16; ++k) { f32x4 v = {x[2 * k].x, x[2 * k].y, x[2 * k + 1].x, x[2 * k + 1].y}; p[k] = v; }
}
__device__ __forceinline__ void spec_c(float2* X, unsigned* __restrict__ fs, float scl) {
    const int tid = opaque_tid();
    float2 x[32]; const f32x4* p = reinterpret_cast<const f32x4*>(X + fphys(tid * 32));
#pragma unroll
    for (int k = 0; k < 16; ++k) { const f32x4 v = p[k]; x[2 * k] = make_float2(v[0], v[1]); x[2 * k + 1] = make_float2(v[2], v[3]); }
    bfly<5, false>(x);
    u32x4* fp = reinterpret_cast<u32x4*>(fs + tid * 32);
#pragma unroll
    for (int k = 0; k < 8; ++k) { u32x4 w;
#pragma unroll
        for (int j = 0; j < 4; ++j) w[j] = pack_h2(make_float2(x[4 * k + j].x * scl, x[4 * k + j].y * scl));
        fp[k] = w; }
}
__device__ __forceinline__ void fwd_b(float2* X) { fft_pass_b<false>(X, opaque_tid()); }
__device__ __forceinline__ void inv_b(float2* X) { fft_pass_b<true>(X, opaque_tid()); }

__device__ __forceinline__ float block_sum(float v, float* red) {
    v = wave_sum(v);
    __syncthreads();
    { const int tid_ = TIDX; if ((tid_ & 63) == 0) red[tid_ >> 6] = v; }
    __syncthreads();
    float s = 0.f;
#pragma unroll
    for (int i = 0; i < 8; ++i) s += red[i];
    return s;
}
__device__ __forceinline__ float sconv(const unsigned short* __restrict__ p, int t, int n, float w0, float w1, float w2, float cb) {
    const float a = (t > 0) ? bf2f(p[t - 1]) : 0.f, b = bf2f(p[t]), c = (t < n - 1) ? bf2f(p[t + 1]) : 0.f;
    return a * w0 + b * w1 + c * w2 + cb;
}
__device__ __forceinline__ void hy_stage_conv(const Ctx& F, const bf16* __restrict__ PT, int ch, unsigned* __restrict__ dst) {
    unsigned short* rows = (unsigned short*)F.lds;
    const float w0 = F.in[I_HCW][ch], w1 = F.in[I_HCW][3072 + ch], w2 = F.in[I_HCW][6144 + ch], cb = F.in[I_HCB][ch];
    __syncthreads();
#pragma unroll
    for (int b = 0; b < 2; ++b) {
        const u32x4* s = reinterpret_cast<const u32x4*>(PT + (size_t)ch * MALL + b * NTOK + CTX);
        u32x4* d = reinterpret_cast<u32x4*>(rows + b * (FN + 16) + 8);
#pragma unroll
        for (int k = 0; k < 4; ++k) d[F.tid + 512 * k] = s[F.tid + 512 * k];
        if (F.tid == 0) { rows[b * (FN + 16) + 7] = 0; rows[b * (FN + 16) + 8 + FN] = 0; }
    }
    __syncthreads();
#pragma unroll 4
    for (int k = 0; k < 32; ++k) { const int i = F.tid + 512 * k;
        const unsigned short* r0 = rows + 8 + i; const unsigned short* r1 = r0 + (FN + 16);
        dst[i] = pack_h2(make_float2(bf2f(r0[-1]) * w0 + bf2f(r0[0]) * w1 + bf2f(r0[1]) * w2 + cb, bf2f(r1[-1]) * w0 + bf2f(r1[0]) * w1 + bf2f(r1[1]) * w2 + cb)); }
    __syncthreads();
}
__device__ __forceinline__ void hyena_channel_latent(const Ctx& F, int c, const bf16* __restrict__ PT, const bf16* __restrict__ HT, bf16* __restrict__ ZT, unsigned* __restrict__ WG) {
    float2* X = (float2*)F.lds; float* red = (float*)(F.lds + FFT_LDS);
    unsigned* FS = WG; unsigned* U = WG + 4 * FN; unsigned* G1 = WG + 5 * FN; unsigned* G2 = WG + 6 * FN; unsigned* SC0 = WG + 7 * FN; unsigned* SC1 = WG + 8 * FN;
    hy_stage_conv(F, PT, c, U); hy_stage_conv(F, PT, 1024 + c, G1); hy_stage_conv(F, PT, 2048 + c, G2);
#pragma unroll 1
    for (int o = 0; o < 2; ++o) {
        const unsigned short* hf = (const unsigned short*)HT + (size_t)((o * 2 + 0) * 1024 + c) * FN; const unsigned short* hb = (const unsigned short*)HT + (size_t)((o * 2 + 1) * 1024 + c) * FN;
        float asum = 0.f;
        fwd_a(X, [&](int i) { const float a = bf2f(hf[i]), b = i ? bf2f(hb[FN - i]) : 0.f; asum += fabsf(a) + fabsf(b); return make_float2(a + b, 0.f); });
        const float nrm = block_sum(asum, red), scl = 1.f / (2.f * (float)FN * nrm);
        fwd_b(X); __syncthreads(); spec_c(X, FS + (o * 2 + 0) * FN, scl); __syncthreads();
        fwd_a(X, [&](int i) { const float d = bf2f(hf[i]) - (i ? bf2f(hb[FN - i]) : 0.f); const float2 w = unitrev((float)i * (0.5f / (float)FN)); return make_float2(d * w.x, d * w.y); });
        __syncthreads(); fwd_b(X); __syncthreads(); spec_c(X, FS + (o * 2 + 1) * FN, scl); __syncthreads();
    }
    const float bias0 = F.in[I_HFB][c], bias1 = F.in[I_HFB][1024 + c];
    fwd_a(X, [&](int i) { return unpack_h2(U[i]); });
    __syncthreads(); fwd_b(X); __syncthreads(); mid_c(X, FS + 0 * FN); __syncthreads(); inv_b(X); __syncthreads();
    inv_a(X, [&](int r, float2 (&x)[16]) {
#pragma unroll
        for (int k = 0; k < 16; ++k) SC0[r + k * 1024] = pack_h2(x[k]);
#pragma unroll
        for (int k = 0; k < 16; ++k) x[k] = cmul(unpack_h2(U[r + k * 1024]), unitrev((float)(r + k * 1024) * (0.5f / (float)FN)));
        bfly<4, false>(x); apply_tw<4, false>(x, r, 1.f / 16384.f);
#pragma unroll
        for (int k = 0; k < 16; ++k) X[fphys(r + k * 1024)] = x[k]; });
    __syncthreads(); fwd_b(X); __syncthreads(); mid_c(X, FS + 1 * FN); __syncthreads(); inv_b(X); __syncthreads();
    inv_a(X, [&](int r, float2 (&x)[16]) {
#pragma unroll
        for (int k = 0; k < 16; ++k) { const int i = r + k * 1024;
            const float2 yn = cmulc(x[k], unitrev((float)i * (0.5f / (float)FN))), yc = unpack_h2(SC0[i]), u = unpack_h2(U[i]), g = unpack_h2(G1[i]);
            const float2 z = make_float2(g.x * (yc.x + yn.x + u.x * bias0), g.y * (yc.y + yn.y + u.y * bias0));
            SC1[i] = pack_h2(z); x[k] = z; }
        bfly<4, false>(x); apply_tw<4, false>(x, r, 1.f / 16384.f);
#pragma unroll
        for (int k = 0; k < 16; ++k) X[fphys(r + k * 1024)] = x[k]; });
    __syncthreads(); fwd_b(X); __syncthreads(); mid_c(X, FS + 2 * FN); __syncthreads(); inv_b(X); __syncthreads();
    inv_a(X, [&](int r, float2 (&x)[16]) {
#pragma unroll
        for (int k = 0; k < 16; ++k) SC0[r + k * 1024] = pack_h2(x[k]);
#pragma unroll
        for (int k = 0; k < 16; ++k) x[k] = cmul(unpack_h2(SC1[r + k * 1024]), unitrev((float)(r + k * 1024) * (0.5f / (float)FN)));
        bfly<4, false>(x); apply_tw<4, false>(x, r, 1.f / 16384.f);
#pragma unroll
        for (int k = 0; k < 16; ++k) X[fphys(r + k * 1024)] = x[k]; });
    __syncthreads(); fwd_b(X); __syncthreads(); mid_c(X, FS + 3 * FN); __syncthreads(); inv_b(X); __syncthreads();
    unsigned short* zt = (unsigned short*)ZT + (size_t)c * MALL + CTX;
    inv_a(X, [&](int r, float2 (&x)[16]) {
#pragma unroll
        for (int k = 0; k < 16; ++k) { const int i = r + k * 1024;
            const float2 yn = cmulc(x[k], unitrev((float)i * (0.5f / (float)FN))), yc = unpack_h2(SC0[i]), u = unpack_h2(SC1[i]), g = unpack_h2(G2[i]);
            zt[i] = f2bf(g.x * (yc.x + yn.x + u.x * bias1)); zt[NTOK + i] = f2bf(g.y * (yc.y + yn.y + u.y * bias1)); } });
    __syncthreads();
}
__device__ __forceinline__ void hyena_channel_ctx(const Ctx& F, int c, const bf16* __restrict__ PT, bf16* __restrict__ ZT) {
    float* base = (float*)F.lds; float* filt = base;
    float* uv = base + 1024; float* ux1 = uv + 512; float* ux2 = ux1 + 512; float* zz = ux2 + 512; float* red = zz + 512;
    const int tid = F.tid, b = tid >> 8, t = tid & 255;
    const float* A2C = (const float*)(F.ws + WS_A2C); const float* w3 = F.in[I_HW3];
    const float* cw = F.in[I_HCW]; const float* cbp = F.in[I_HCB];
    __syncthreads();
    {
        const float delta = fabsf(-3.0701134573253944f + (-15.350567286626972f + 3.0701134573253944f) * ((float)c * (1.f / 1023.f)));
        const float win = __expf(-((float)t * (1.f / 255.f)) * delta);
        const int o = b;
        float hf = 0.f, hb = 0.f;
        for (int k = 0; k < 64; ++k) { const float a = A2C[t * 64 + k]; hf += a * w3[k * 4096 + (o * 2 + 0) * 1024 + c]; hb += a * w3[k * 4096 + (o * 2 + 1) * 1024 + c]; }
        filt[(o * 2 + 0) * 256 + t] = hf * win; filt[(o * 2 + 1) * 256 + t] = hb * win;
    }
    {
        const unsigned short* pv = (const unsigned short*)PT + (size_t)c * MALL + b * NTOK;
        uv[tid] = sconv(pv, t, CTX, cw[c], cw[3072 + c], cw[6144 + c], cbp[c]);
        ux1[tid] = sconv(pv + (size_t)1024 * MALL, t, CTX, cw[1024 + c], cw[3072 + 1024 + c], cw[6144 + 1024 + c], cbp[1024 + c]);
        ux2[tid] = sconv(pv + (size_t)2048 * MALL, t, CTX, cw[2048 + c], cw[3072 + 2048 + c], cw[6144 + 2048 + c], cbp[2048 + c]);
    }
    __syncthreads();
    float nrm[2];
#pragma unroll
    for (int o = 0; o < 2; ++o) { const float s = (tid < 256) ? fabsf(filt[(o * 2) * 256 + tid]) + (tid ? fabsf(filt[(o * 2 + 1) * 256 + tid]) : 0.f) : 0.f; nrm[o] = block_sum(s, red); }
    float* src = uv;
#pragma unroll 1
    for (int o = 0; o < 2; ++o) {
        const float* hf = filt + (o * 2) * 256; const float* hb = hf + 256; const float* u = src + b * 256;
        float y = 0.f;
        for (int s = 0; s <= t; ++s) y += u[s] * hf[t - s];
        for (int s = t + 1; s < 256; ++s) y += u[s] * hb[s - t];
        y = y / nrm[o] + u[t] * F.in[I_HFB][o * 1024 + c];
        const float g = (o == 0 ? ux1 : ux2)[tid] * y;
        __syncthreads();
        zz[tid] = g; src = zz;
        __syncthreads();
    }
    ((unsigned short*)ZT)[(size_t)c * MALL + b * NTOK + t] = f2bf(zz[tid]);
    __syncthreads();
}
__device__ __forceinline__ void ph_hyena_core(const Ctx& F, bool need_ctx, const bf16* PT, const bf16* HT, bf16* ZT, unsigned* WGS) {
    for (int c = F.bid; c < 1024; c += F.G) {
        hyena_channel_latent(F, c, PT, HT, ZT, WGS + (size_t)F.bid * 9 * FN);
        if (need_ctx) hyena_channel_ctx(F, c, PT, ZT);
    }
}
__device__ __forceinline__ void ph_transpose_z(const Ctx& F, const bf16* __restrict__ ZT, bf16* __restrict__ Z) {
    unsigned short* t = (unsigned short*)F.lds;
    const int ntile = (1024 / 64) * (MALL / 64);
    for (int i = F.bid; i < ntile; i += F.G) {
        const int c0 = (i % 16) * 64, r0 = (i / 16) * 64;
        __syncthreads();
        { const int cc = F.tid >> 3, r8 = (F.tid & 7) * 8;
          const bf16x8 v = *reinterpret_cast<const bf16x8*>(ZT + (size_t)(c0 + cc) * MALL + r0 + r8);
#pragma unroll
          for (int j = 0; j < 8; ++j) t[(r8 + j) * 66 + cc] = (unsigned short)v[j]; }
        __syncthreads();
        { const int rr = F.tid >> 3, c8 = (F.tid & 7) * 8; bf16x8 v;
#pragma unroll
          for (int j = 0; j < 8; ++j) v[j] = (short)t[rr * 66 + c8 + j];
          *reinterpret_cast<bf16x8*>(Z + (size_t)(r0 + rr) * D + c0 + c8) = v; }
    }
}

__global__ void __launch_bounds__(NTHR, 2) mega_fwd(Args args) {
    {
        const unsigned hw = (unsigned)__builtin_amdgcn_s_getreg((5 << 11) | 4) & 63u;
        if ((threadIdx.x & 63) == 0) *(volatile LAS int*)((LAS unsigned char*)lds_raw + LDS_WTAB + hw * 4) = (int)(threadIdx.x >> 6);
        __syncthreads();
    }
    Ctx F; F.in = args.in; F.out = args.out; F.ws = args.ws; F.lds = (char*)lds_raw;
    F.tid = opaque_tid(); F.lane = F.tid & 63; F.wave = F.tid >> 6; F.G = gridDim.x; F.bid = blockIdx.x;
    volatile LAS unsigned* bst = (volatile LAS unsigned*)(lds_raw + LDS_WTAB + 256);
    if (F.tid == 0) { bst[0] = 0u; bst[1] = 0u; bst[2] = 0u; bst[3] = 0u; }
    __syncthreads();
    XcdBarrier bar = xcd_barrier_post((unsigned*)(args.ws + WS_CTL), bst);
    const int lo = args.ph_lo, hi = args.ph_hi;
    int ph = 0;
#ifndef PH_MASK
#define PH_MASK 0xFFFFFFFFFFFFFFFFull
#endif
    int phc = 0;
#define PHASE(...) do { if (lo <= ph && ph < hi) { if ((PH_MASK >> (__COUNTER__ - CNT0 - 1)) & 1ull) { F.tid = opaque_tid(); F.lane = F.tid & 63; F.wave = F.tid >> 6;   __VA_ARGS__; } if (ph + 1 < hi) xcd_barrier(bar); } ++ph; } while (0)
    constexpr int CNT0 = __COUNTER__;

    PHASE((p0_prologue(F), hy_prologue(F)));
    bf16* const WT = (bf16*)(args.ws + WS_WT);
    bf16* const Hb = (bf16*)(args.ws + S_H);
    {
        bf16* QKV = (bf16*)(args.ws + S_QKV); bf16* AO = (bf16*)(args.ws + S_AO);
        PHASE(ph_modulate(F, 0, 0, Hb, true));
        PHASE(ph_gemm_qkv(F, 0, Hb, WT + WT_DAIN, QKV));
        PHASE(ph_attention(F, 0, 0, true, QKV, AO));
        PHASE(ph_gemm_resid(F, AO, D, WT + WT_DAOUT, D, 0, 2048, nullptr, true));
    }
#define MOE_PHASES(layer, need_ctx) do { \
        unsigned char* EXPW8 = (unsigned char*)(args.ws + S_EXPW); unsigned char* HID8 = (unsigned char*)(args.ws + S_HID); bf16* Yb = (bf16*)(args.ws + S_Y); unsigned char* H8 = (unsigned char*)Hb; \
        const int nrt = (need_ctx) ? 288 : 256; \
        PHASE(ph_ffn_modulate_router(F, layer, H8, need_ctx)); \
        PHASE((ph_topk(F, need_ctx), ph_cvt_experts(F, layer, EXPW8))); \
        PHASE(ph_moe_up(F, H8, EXPW8, HID8, nrt)); \
        PHASE(ph_moe_down(F, HID8, EXPW8, Yb, nrt)); \
        PHASE(ph_moe_combine(F, layer, Yb, need_ctx, (layer) < 3 ? (layer) + 1 : -1, Hb)); } while (0)
    MOE_PHASES(0, true);
    {
        bf16 *RQ = (bf16*)(args.ws + R_Q), *RKR = (bf16*)(args.ws + R_KR), *RKFT = (bf16*)(args.ws + R_KFT), *RKBT = (bf16*)(args.ws + R_KBT), *RVT = (bf16*)(args.ws + R_VT),
             *RSG = (bf16*)(args.ws + R_SG), *RST = (bf16*)(args.ws + R_ST), *RP = (bf16*)(args.ws + R_P), *RO = (bf16*)(args.ws + R_O);
        const RetC rc = ret_consts(F);
        PHASE({ const DenseSched S = dense_sched(F, Hb, D, WT + WT_RIN, D, MALL, 6144); const EpiRetIn E{RQ, RKR, RKFT, RKBT, RVT, RSG, rc, (const float*)(args.ws + WS_RROPE)}; gemm_phase<true>(F.lds, D, D, D, S, E); });
        PHASE({ { const RetPSched S{(const char*)RQ, (const char*)RKR, F.bid, F.G}; const EpiRetP E{RP, rc}; gemm_phase<true, RetPSched, EpiRetP, false, false, true>(F.lds, D, D, RCH, S, E); }
                { const RetSSched S{(const char*)RVT, (const char*)RKFT, (const char*)RKBT, F.bid, F.G}; const EpiRetS E{RST}; gemm_phase<true, RetSSched, EpiRetS, false, false, true>(F.lds, NTOK, NTOK, RCH, S, E); } });
        PHASE(ph_ret_scan(F, RST, rc));
        PHASE({ const RetOSched S{(const char*)RQ, (const char*)RP, (const char*)RST, (const char*)RVT, F.bid, F.G, 0}; const EpiRetO E{RO, rc}; gemm_phase<true, RetOSched, EpiRetO, false, false, true>(F.lds, D, NTOK, RCH, S, E); });
        PHASE(ph_ret_gate(F, RO, RSG));
        PHASE(ph_gemm_resid(F, RO, 2048, WT + WT_ROUT, 2048, 1, 2048, nullptr));
    }
    MOE_PHASES(1, true);
    {
        bf16 *PT = (bf16*)(args.ws + H_PT), *ZT = (bf16*)(args.ws + H_ZT), *Zb = (bf16*)(args.ws + H_Z), *HT = (bf16*)(args.ws + H_HT);
        PHASE({ { const DenseSched S = dense_sched(F, Hb, D, WT + WT_HIN, D, MALL, 3072); const EpiHyIn E{PT, F.in[I_HBIN]}; gemm_phase<false>(F.lds, D, D, D, S, E); }
                { const DenseSched S = dense_sched(F, (const bf16*)(args.ws + WS_W3P), 256, (const bf16*)(args.ws + WS_A2P), 256, 4096, FN); const EpiHyTaps E{HT}; gemm_phase<true, DenseSched, EpiHyTaps, false, false, true>(F.lds, 256, 256, 256, S, E); } });
        PHASE(ph_hyena_core(F, true, PT, HT, ZT, (unsigned*)(args.ws + H_WG)));
        PHASE(ph_transpose_z(F, ZT, Zb));
        PHASE(ph_gemm_resid(F, Zb, D, WT + WT_HOUT, D, 2, 2048, F.in[I_HBOUT]));
    }
    MOE_PHASES(2, true);
    {
        bf16* QKV = (bf16*)(args.ws + S_QKV); bf16* AO = (bf16*)(args.ws + S_AO);
        PHASE(ph_gemm_qkv(F, 1, Hb, WT + WT_DAIN + (size_t)3072 * 1024, QKV));
        PHASE(ph_attention(F, 3, 1, false, QKV, AO));
        PHASE(ph_gemm_resid(F, AO, D, WT + WT_DAOUT + (size_t)1024 * 1024, D, 3, 2048, nullptr, false, true));
    }
    MOE_PHASES(3, false);
}

extern "C" void kernel_launch(void* const* d_in, const int* in_sizes, int n_in, void* d_out, int out_size, void* d_ws, size_t ws_size, hipStream_t stream) {
    static int grid = 0;
    if (grid == 0) {
        if (n_in != N_IN || out_size != NB * SEQL * D || ws_size < WS_NEED) {
            fprintf(stderr, "kernel_launch: unexpected shapes: n_in %d out %d ws %zu (need %zu)\n", n_in, out_size, ws_size, (size_t)WS_NEED); grid = -1; return; }
        int dev = 0, cus = 0, per_cu = 0;
        if (hipGetDevice(&dev) != hipSuccess || hipDeviceGetAttribute(&cus, hipDeviceAttributeMultiprocessorCount, dev) != hipSuccess) { grid = -1; return; }
        if (hipFuncSetAttribute((const void*)mega_fwd, hipFuncAttributeMaxDynamicSharedMemorySize, LDS_BYTES) != hipSuccess) { fprintf(stderr, "kernel_launch: LDS attribute failed\n"); grid = -1; return; }
        if (hipOccupancyMaxActiveBlocksPerMultiprocessor(&per_cu, (const void*)mega_fwd, NTHR, LDS_BYTES) != hipSuccess || per_cu < 1)
            fprintf(stderr, "kernel_launch: occupancy query says %d\n", per_cu);
        (void)hipGetLastError();
        grid = cus;
    }
    if (grid < 0) return;
    (void)hipMemsetAsync((char*)d_ws + WS_CTL, 0, 65536, stream);
    Args a{};
    for (int i = 0; i < N_IN; ++i) a.in[i] = (const float*)d_in[i];
    a.out = (float*)d_out; a.ws = (unsigned char*)d_ws; a.ph_lo = 0; a.ph_hi = 1000;
    hipLaunchKernelGGL(mega_fwd, dim3(grid), dim3(NTHR), LDS_BYTES, stream, a);
    const hipError_t le = hipPeekAtLastError();
    if (le != hipSuccess) fprintf(stderr, "kernel_launch: launch failed: %s\n", hipGetErrorName(le));
}
```

```cpp
#include <hip/hip_runtime.h>
#include <hip/hip_bf16.h>
#include <cstdio>
#include <cstdint>

#define LAS __attribute__((address_space(3)))
typedef __hip_bfloat16 bf16;
typedef __attribute__((ext_vector_type(8))) short bf16x8;
typedef __attribute__((ext_vector_type(4))) short s16x4;
typedef __attribute__((ext_vector_type(4))) float f32x4;
typedef __attribute__((ext_vector_type(16))) float f32x16;
typedef __attribute__((ext_vector_type(4))) unsigned u32x4;
typedef __attribute__((ext_vector_type(2))) unsigned u32x2;

constexpr int NB = 2, SEQL = 16384, CTX = 256, NTOK = SEQL + CTX, D = 1024, MALL = NB * NTOK;
constexpr int NTHR = 512;
constexpr int NEXP = 16, CAPL = 2048, CAPC = 32;
constexpr float EPS = 1e-6f;

enum { I_X = 0, I_C, I_CTX, I_CCTX, I_NMG, I_NFG, I_MODW, I_MODB, I_DAWIN, I_DAQN, I_DAKN, I_DALAM, I_DASUB, I_DAWOUT,
       I_RWIN, I_RLA, I_RGN, I_RWOUT, I_HWIN, I_HBIN, I_HCW, I_HCB, I_HW1, I_HB1, I_HW2, I_HB2, I_HFREQ, I_HW3, I_HFB, I_HWOUT, I_HBOUT,
       I_RTW, I_EW1, I_EW3, I_EW2, N_IN };

constexpr size_t AL(size_t x) { return (x + 255) / 256 * 256; }
constexpr size_t WS_CTL = 0;
constexpr size_t WS_RETC = 32768;
constexpr size_t WS_MODS = 65536;
constexpr size_t WS_CTXX = WS_MODS + AL(4 * 3 * 6144 * 4);
constexpr size_t WS_AFFL = WS_CTXX + AL((size_t)NB * CTX * D * 4);
constexpr size_t WS_AFFC = WS_AFFL + AL((size_t)NB * NEXP * SEQL * 4);
constexpr size_t WS_SLOTL = WS_AFFC + AL((size_t)NB * NEXP * CTX * 4);
constexpr size_t WS_SLOTC = WS_SLOTL + AL((size_t)NB * NEXP * SEQL * 4);
constexpr int NFLAT = NB * NEXP * CAPL + NB * NEXP * 256;
constexpr size_t WS_ROWS = WS_SLOTC + AL((size_t)NB * NEXP * CTX * 4);
constexpr size_t WS_GATEV = WS_ROWS + AL((size_t)NFLAT * 4);
constexpr size_t WS_RROPE = WS_GATEV + AL((size_t)NFLAT * 4);
constexpr size_t WS_AROPE = WS_RROPE + AL((size_t)SEQL * 128 * 8);
constexpr size_t WS_A2P = WS_AROPE + AL((size_t)320 * 16 * 8);
constexpr size_t WS_W3P = WS_A2P + AL((size_t)SEQL * 256 * 2);
constexpr size_t WS_A2C = WS_W3P + AL((size_t)4096 * 256 * 2);
constexpr size_t WS_WT = WS_A2C + AL((size_t)CTX * 64 * 4);
constexpr size_t WT_DAIN = 0, WT_DAOUT = WT_DAIN + 2ull * 3072 * 1024, WT_RIN = WT_DAOUT + 2ull * 1024 * 1024, WT_ROUT = WT_RIN + 6144ull * 1024,
                 WT_HIN = WT_ROUT + 1024ull * 2048, WT_HOUT = WT_HIN + 3072ull * 1024, WT_END = WT_HOUT + 1024ull * 1024;
constexpr size_t WS_SCR = WS_WT + AL(WT_END * 2);
constexpr size_t S_H = WS_SCR;
constexpr size_t S_B1 = S_H + AL((size_t)MALL * D * 2);
constexpr size_t S_QKV = S_B1;
constexpr size_t S_AO = S_QKV + AL((size_t)MALL * 3072 * 2);
constexpr size_t S_EXPW = S_B1;
constexpr size_t S_HID = S_EXPW + AL((size_t)NEXP * 3072 * 1024 * 2);
constexpr size_t S_Y = S_HID + AL((size_t)NFLAT * D * 2);
constexpr int RCH = 256, RNC = NTOK / RCH;
constexpr size_t R_Q = S_B1;
constexpr size_t R_KR = R_Q + AL((size_t)MALL * D * 2);
constexpr size_t R_KFT = R_KR + AL((size_t)MALL * D * 2);
constexpr size_t R_KBT = R_KFT + AL((size_t)8 * 256 * NTOK * 2);
constexpr size_t R_VT = R_KBT + AL((size_t)8 * 256 * NTOK * 2);
constexpr size_t R_SG = R_VT + AL((size_t)8 * 512 * NTOK * 2);
constexpr size_t R_ST = R_SG + AL((size_t)MALL * 2048 * 2);
constexpr size_t R_END = R_ST + AL((size_t)2 * 8 * 512 * NTOK * 2);
constexpr size_t R_P = S_H;
constexpr size_t R_O = R_KFT;
constexpr int FN = SEQL;
constexpr size_t H_PT = S_B1;
constexpr size_t H_HT = H_PT + AL((size_t)3072 * MALL * 2);
constexpr size_t H_ZT = H_HT + AL((size_t)4096 * FN * 2);
constexpr size_t H_Z = H_ZT + AL((size_t)1024 * MALL * 2);
constexpr size_t H_WG = H_Z + AL((size_t)MALL * D * 2);
constexpr size_t H_WG_BYTES = (size_t)9 * FN * 4;
constexpr size_t H_END = H_WG + 256 * H_WG_BYTES;
constexpr size_t WS_NEED_MOE = S_Y + AL((size_t)NFLAT * D * 2);
constexpr size_t WS_NEED = (R_END > WS_NEED_MOE ? R_END : WS_NEED_MOE) > H_END ? (R_END > WS_NEED_MOE ? R_END : WS_NEED_MOE) : H_END;

constexpr int LDS_BYTES = 147456 + 512;
constexpr int LDS_WTAB = 147456;

extern __shared__ __attribute__((aligned(16))) unsigned char lds_raw[];
__device__ __forceinline__ int lane_id_v() { int l; asm volatile("v_mbcnt_lo_u32_b32 %0, -1, 0\n\tv_mbcnt_hi_u32_b32 %0, -1, %0" : "=v"(l)); return l; }
__device__ __forceinline__ int wave_id_u() {
    const unsigned hw = (unsigned)__builtin_amdgcn_s_getreg((5 << 11) | 4) & 63u;
    return __builtin_amdgcn_readfirstlane(*(volatile LAS int*)((LAS unsigned char*)lds_raw + LDS_WTAB + hw * 4));
}
__device__ __forceinline__ int opaque_tid() { return wave_id_u() * 64 + lane_id_v(); }
#define TIDX opaque_tid()

#define XB_TMO      128
#define XB_XCNT(j)  (256  + 64 * (j))
#define XB_XSUB(j)  (1280 + 64 * (j))
#define XB_XGEN(j)  (2304 + 64 * (j))
#define XB_TOP      3328
#define XB_TOPGEN   3392
#define XCD_BAR_WORDS 3456
#define XB_SPIN_CAP (1u << 18)

__device__ __forceinline__ unsigned xb_ld(unsigned* p)              { return __hip_atomic_load(p, __ATOMIC_RELAXED, __HIP_MEMORY_SCOPE_AGENT); }
__device__ __forceinline__ unsigned xb_add(unsigned* p, unsigned v) { return __hip_atomic_fetch_add(p, v, __ATOMIC_RELAXED, __HIP_MEMORY_SCOPE_AGENT); }
__device__ __forceinline__ unsigned xb_xcc_id() { return (unsigned)__builtin_amdgcn_s_getreg((3 << 11) | 20) & 0xFu; }
#define XB_SPIN(cond, bar) do { unsigned _sp = 0; while (cond) { __builtin_amdgcn_s_sleep(1); \
    if ((++_sp & 255u) == 0u) { if (xb_ld(&(bar)[XB_TMO])) break; if (_sp > XB_SPIN_CAP) { atomicAdd(&(bar)[XB_TMO], 1u); break; } } } } while (0)

struct XcdBarrier { unsigned* bar; unsigned x; volatile LAS unsigned* st; };

__device__ __forceinline__ XcdBarrier xcd_barrier_post(unsigned* bar, volatile LAS unsigned* st) {
    XcdBarrier b; b.bar = bar; b.x = xb_xcc_id(); b.st = st;
    if (TIDX == 0) (void)xb_add(&bar[XB_XCNT(b.x)], 1u);
    return b;
}
__device__ __forceinline__ void xcd_barrier_complete(unsigned* bar, unsigned x, unsigned& nloc, unsigned& nx) {
    const unsigned G = gridDim.x * gridDim.y * gridDim.z;
    unsigned sum, cnt, mine, sp = 0u;
    for (;;) {
        sum = 0u; cnt = 0u; mine = 0u;
#pragma unroll
        for (unsigned j = 0; j < 16; ++j) { const unsigned c = xb_ld(&bar[XB_XCNT(j)]); sum += c; cnt += (c > 0u) ? 1u : 0u; mine = (j == x) ? c : mine; }
        if (sum == G) break;
        __builtin_amdgcn_s_sleep(1);
        if ((++sp & 255u) == 0u) { if (xb_ld(&bar[XB_TMO])) break; if (sp > XB_SPIN_CAP) { atomicAdd(&bar[XB_TMO], 1u); break; } }
    }
    nloc = mine > 0u ? mine : 1u; nx = cnt > 0u ? cnt : 1u;
}
__device__ __forceinline__ void xcd_barrier(const XcdBarrier& b) {
    asm volatile("s_waitcnt vmcnt(0)" ::: "memory");
    __syncthreads();
    if (TIDX == 0) {
        unsigned* bar = b.bar;
        __builtin_amdgcn_s_waitcnt(0);
        unsigned nloc = b.st[0], nx = b.st[1];
        if (nloc == 0u) { xcd_barrier_complete(bar, b.x, nloc, nx); b.st[0] = nloc; b.st[1] = nx; }
        const unsigned old = xb_add(&bar[XB_XSUB(b.x)], 1u);
        const unsigned gen = old / nloc;
        if (old + 1u == (gen + 1u) * nloc) {
            __builtin_amdgcn_fence(__ATOMIC_RELEASE, "agent");
            asm volatile("s_waitcnt vmcnt(0)" ::: "memory");
            const unsigned og = xb_add(&bar[XB_TOP], 1u);
            const unsigned tg = og / nx;
            if (og + 1u == (tg + 1u) * nx) xb_add(&bar[XB_TOPGEN], 1u);
            else XB_SPIN(xb_ld(&bar[XB_TOPGEN]) == tg, bar);
            __builtin_amdgcn_fence(__ATOMIC_ACQUIRE, "agent");
            xb_add(&bar[XB_XGEN(b.x)], 1u);
            asm volatile("s_waitcnt vmcnt(0)" ::: "memory");
        } else {
            XB_SPIN(xb_ld(&bar[XB_XGEN(b.x)]) == gen, bar);
            __builtin_amdgcn_fence(__ATOMIC_ACQUIRE, "agent");
            asm volatile("s_waitcnt vmcnt(0)" ::: "memory");
        }
    }
    __syncthreads();
}

__device__ __forceinline__ unsigned cvtpk(float lo, float hi) {
    unsigned r; asm volatile("v_cvt_pk_bf16_f32 %0, %1, %2" : "=v"(r) : "v"(lo), "v"(hi)); return r;
}
__device__ __forceinline__ unsigned short f2bf(float x) { return (unsigned short)(cvtpk(x, 0.f) & 0xffffu); }
__device__ __forceinline__ float bf2f(unsigned short u) { return __uint_as_float(((unsigned)u) << 16); }
__device__ __forceinline__ float wave_sum(float v) {
#pragma unroll
    for (int o = 32; o > 0; o >>= 1) v += __shfl_xor(v, o, 64);
    return v;
}
__device__ __forceinline__ float silu_f(float x) { return x / (1.f + __expf(-x)); }
__device__ __forceinline__ float silu_fast(float x) { return x * __builtin_amdgcn_rcpf(1.f + __expf(-x)); }

struct Args { const float* in[N_IN]; float* out; unsigned char* ws; int ph_lo, ph_hi; };

struct Ctx {
    const float* const* in; float* out; unsigned char* ws; char* lds;
    int tid, lane, wave, G, bid;
};

__device__ __forceinline__ float* xrow(const Ctx& F, int r) {
    const int b = r / NTOK, t = r - b * NTOK;
    return (t < CTX) ? (float*)(F.ws + WS_CTXX) + ((size_t)(b * CTX + t)) * D : F.out + ((size_t)(b * SEQL + (t - CTX))) * D;
}
__device__ __forceinline__ const float* xrow_in(const Ctx& F, int r) {
    const int b = r / NTOK, t = r - b * NTOK;
    return (t < CTX) ? F.in[I_CTX] + ((size_t)(b * CTX + t)) * D : F.in[I_X] + ((size_t)(b * SEQL + (t - CTX))) * D;
}
__device__ __forceinline__ int mod_sel(int r) { const int b = r / NTOK, t = r - b * NTOK; return (t < CTX) ? 2 : b; }

typedef f32x4 Acc[2][2][4][2];
struct GUnit { const char* a; const char* b; int id; };
constexpr int G_BK = 64, G_HALF = 128, G_HTB = G_HALF * G_BK * 2;
constexpr int GEMM_LDS = 8 * G_HTB;

__device__ __forceinline__ int g_lds_byte(int r, int c) {
    int st = (r >> 4) * 2 + (c >> 5), rr = r & 15, cc = c & 31, ob = rr * 64 + cc * 2;
    return st * 1024 + (ob ^ (((ob >> 9) & 1) << 5));
}
__device__ __forceinline__ void g_stage_rc(int b, int& R, int& C) {
    int st = b / 1024, sb = b % 1024, swz = sb ^ (((sb >> 9) & 1) << 5);
    R = (st >> 1) * 16 + swz / 64; C = (st & 1) * 32 + (swz % 64) / 2;
}
__device__ __forceinline__ void acc_zero(Acc& acc) {
#pragma unroll
    for (int ai = 0; ai < 2; ++ai)
#pragma unroll
        for (int bj = 0; bj < 2; ++bj)
#pragma unroll
            for (int m = 0; m < 4; ++m)
#pragma unroll
                for (int n = 0; n < 2; ++n) acc[ai][bj][m][n] = f32x4{0.f, 0.f, 0.f, 0.f};
}
#define WAIT_V(n) asm volatile("s_waitcnt vmcnt(" #n ")" ::: "memory")
#define WAIT_L(n) asm volatile("s_waitcnt lgkmcnt(" #n ")" ::: "memory")

typedef int v8i32 __attribute__((ext_vector_type(8)));
typedef short s16x16_t __attribute__((ext_vector_type(16)));
template <bool SWAP, class Sched, class Epi, bool GATHER = false, bool FP8 = false, bool PERMB = false>
__device__ __forceinline__ void gemm_phase(char* ldsp, const int lda, const int ldb, const int K, const Sched& S, const Epi& E) {
    LAS unsigned char* lds = (LAS unsigned char*)ldsp;
    const int tid = TIDX, wid = __builtin_amdgcn_readfirstlane(tid >> 6), lane = tid & 63, wr = wid >> 2, wc = wid & 3, fr = lane & 15, fq = lane >> 4;
    int nt = K / G_BK; asm volatile("" : "+s"(nt));
    unsigned voffA[2], voffB[2];
#pragma unroll
    for (int i = 0; i < 2; ++i) { int R, C; g_stage_rc(tid * 16 + i * 8192, R, C); voffA[i] = (unsigned)(R * lda + C) * 2u; voffB[i] = (unsigned)(R * ldb + C) * 2u; }
    unsigned voffBp[2][2] = {{0u, 0u}, {0u, 0u}};
    if (PERMB) {
#pragma unroll
        for (int h = 0; h < 2; ++h)
#pragma unroll
            for (int i = 0; i < 2; ++i) { int R, C; g_stage_rc(tid * 16 + i * 8192, R, C);
                const int L = ((R >> 5) & 3) * 64 + ((R >> 2) & 3) * 16 + h * 8 + ((R >> 4) & 1) * 4 + (R & 3); voffBp[h][i] = (unsigned)(L * ldb + C) * 2u; } }
    const size_t kstep = (size_t)(G_BK * 2);
    const size_t hstepA = (size_t)G_HALF * lda * 2, hstepB = (size_t)G_HALF * ldb * 2;
    const unsigned ldsw = (unsigned)wid * 1024u;
    const int aoff = g_lds_byte(wr * 64 + fr, FP8 ? fq * 16 : fq * 8), boff = g_lds_byte(wc * 32 + fr, FP8 ? fq * 16 : fq * 8);
#define PG_SA(b, h) (((b) * 2 + (h)) * G_HTB)
#define PG_STAGEB(bufoff, kp, h) do { if (PERMB) PG_STAGE(bufoff, kp, voffBp[h]); else PG_STAGE(bufoff, (const char*)(kp) + (h) * hstepB, voffB); } while (0)
#define PG_SB(b, h) ((4 + (b) * 2 + (h)) * G_HTB)
#define PG_STAGE(bufoff, gbase, voff) do { _Pragma("unroll") for (int _i = 0; _i < 2; ++_i) \
        __builtin_amdgcn_global_load_lds((const unsigned*)((const char*)(gbase) + (voff)[_i]), (LAS unsigned*)(lds + (bufoff) + ldsw + _i * 8192), 16, 0, 0); } while (0)
    unsigned vgC[4] = {0u, 0u, 0u, 0u}, vgN[4] = {0u, 0u, 0u, 0u};
    int gR[2]; { int C_; g_stage_rc(tid * 16, gR[0], C_); g_stage_rc(tid * 16 + 8192, gR[1], C_); }
#define PG_GLOAD(dst, u_) do { const int* rw_ = S.rows(u_); _Pragma("unroll") for (int h_ = 0; h_ < 2; ++h_) _Pragma("unroll") for (int i_ = 0; i_ < 2; ++i_) \
        dst[h_ * 2 + i_] = (unsigned)rw_[h_ * 128 + gR[i_]] * (unsigned)(lda * 2) + (voffA[i_] - (unsigned)(gR[i_] * lda * 2)); } while (0)
#define PG_STAGEA(bufoff, kp, h, NX) do { if (GATHER) { _Pragma("unroll") for (int _i = 0; _i < 2; ++_i) \
            __builtin_amdgcn_global_load_lds((const unsigned*)((const char*)(kp) + ((NX) ? vgN[(h) * 2 + _i] : vgC[(h) * 2 + _i])), (LAS unsigned*)(lds + (bufoff) + ldsw + _i * 8192), 16, 0, 0); } \
        else PG_STAGE(bufoff, (const char*)(kp) + (h) * hstepA, voffA); } while (0)
#define PG_CAT(P) __builtin_bit_cast(v8i32, (s16x16_t)__builtin_shufflevector(*(const LAS bf16x8*)(P), *(const LAS bf16x8*)((P) + 16), 0, 1, 2, 3, 4, 5, 6, 7, 8, 9, 10, 11, 12, 13, 14, 15))
#define PG_LDA(dst, b, h) do { if (FP8) { _Pragma("unroll") for (int m = 0; m < 4; ++m) dst##8[m] = PG_CAT(lds + PG_SA(b, h) + aoff + m * 2048); } \
        else { _Pragma("unroll") for (int m = 0; m < 4; ++m) _Pragma("unroll") for (int k = 0; k < 2; ++k) dst[m][k] = *(const LAS bf16x8*)(lds + PG_SA(b, h) + aoff + m * 2048 + k * 1024); } } while (0)
#define PG_LDB(dst, b, h) do { if (FP8) { _Pragma("unroll") for (int n = 0; n < 2; ++n) dst##8[n] = PG_CAT(lds + PG_SB(b, h) + boff + n * 2048); } \
        else { _Pragma("unroll") for (int n = 0; n < 2; ++n) _Pragma("unroll") for (int k = 0; k < 2; ++k) dst[n][k] = *(const LAS bf16x8*)(lds + PG_SB(b, h) + boff + n * 2048 + k * 1024); } } while (0)
#define PG_MMA(ai, bj, At, Bt) do { __builtin_amdgcn_s_setprio(1); _Pragma("unroll") for (int m = 0; m < 4; ++m) _Pragma("unroll") for (int n = 0; n < 2; ++n) { \
        if (FP8) {     \
            if (SWAP) asm volatile("v_mfma_scale_f32_16x16x128_f8f6f4 %0, %1, %2, %0, %3, %3 op_sel_hi:[0,0,0]" : "+v"(acc[ai][bj][m][n]) : "v"(Bt##8[n]), "v"(At##8[m]), "v"(one_e8m0)); \
            else      asm volatile("v_mfma_scale_f32_16x16x128_f8f6f4 %0, %1, %2, %0, %3, %3 op_sel_hi:[0,0,0]" : "+v"(acc[ai][bj][m][n]) : "v"(At##8[m]), "v"(Bt##8[n]), "v"(one_e8m0)); } \
        else { _Pragma("unroll") for (int k = 0; k < 2; ++k) \
            acc[ai][bj][m][n] = SWAP ? __builtin_amdgcn_mfma_f32_16x16x32_bf16(Bt[n][k], At[m][k], acc[ai][bj][m][n], 0, 0, 0) \
                                     : __builtin_amdgcn_mfma_f32_16x16x32_bf16(At[m][k], Bt[n][k], acc[ai][bj][m][n], 0, 0, 0); } } __builtin_amdgcn_s_setprio(0); } while (0)
#define PG_BAR __builtin_amdgcn_s_barrier()
#define PG_SCHED __builtin_amdgcn_sched_barrier(0)
    GUnit cur, nxt; int ui = 0;
    __syncthreads();
    if (!S.get(0, cur)) return;
    Acc acc; acc_zero(acc);
    bf16x8 At[4][2], B0[2][2], B1[2][2];
    v8i32 At8[4], B08[2], B18[2];
    int one_e8m0 = 127; asm volatile("" : "+v"(one_e8m0));
    const char* cA = cur.a; const char* cB = cur.b;
    if constexpr (GATHER) { PG_GLOAD(vgC, cur); asm volatile("s_waitcnt vmcnt(0)" ::: "memory"); }
    PG_STAGEB(PG_SB(0, 0), cB, 0); PG_STAGEA(PG_SA(0, 0), cA, 0, false); PG_STAGEB(PG_SB(0, 1), cB, 1); PG_STAGEA(PG_SA(0, 1), cA, 1, false);
    if (wr == 1) PG_BAR;
    WAIT_V(4); PG_BAR;
    PG_STAGEB(PG_SB(1, 0), cB + kstep, 0); PG_STAGEA(PG_SA(1, 0), cA + kstep, 0, false); PG_STAGEB(PG_SB(1, 1), cB + kstep, 1);
    WAIT_V(6); PG_BAR;
    for (;;) {
        const bool has_next = S.get(ui + 1, nxt);
        const char* nA = has_next ? nxt.a : cA; const char* nB = has_next ? nxt.b : cB;
        if constexpr (GATHER) { if (has_next) PG_GLOAD(vgN, nxt); else { _Pragma("unroll") for (int q_ = 0; q_ < 4; ++q_) vgN[q_] = vgC[q_]; } }
#pragma unroll 1
        for (int t = 0; t < nt; t += 2) {
            const bool last = (t == nt - 2);
            const char* a1 = cA + (size_t)(t + 1) * kstep;
            const char* a2 = last ? nA : cA + (size_t)(t + 2) * kstep; const char* b2 = last ? nB : cB + (size_t)(t + 2) * kstep;
            const char* a3 = a2 + kstep; const char* b3 = b2 + kstep;
            PG_LDB(B0, 0, 0); PG_SCHED; PG_LDA(At, 0, 0); PG_STAGEA(PG_SA(1, 1), a1, 1, false);
            WAIT_L(8); PG_BAR; WAIT_L(0); PG_MMA(0, 0, At, B0); PG_BAR; PG_SCHED;
            PG_LDB(B1, 0, 1); PG_STAGEB(PG_SB(0, 0), b2, 0);
            PG_BAR; WAIT_L(0); PG_MMA(0, 1, At, B1); PG_BAR;
            PG_LDA(At, 0, 1); PG_STAGEA(PG_SA(0, 0), a2, 0, last);
            PG_BAR; WAIT_L(0); PG_MMA(1, 0, At, B0); PG_BAR; PG_SCHED;
            PG_STAGEB(PG_SB(0, 1), b2, 1);
            WAIT_V(6); PG_BAR; PG_MMA(1, 1, At, B1); PG_BAR;
            PG_LDB(B0, 1, 0); PG_SCHED; PG_LDA(At, 1, 0); PG_STAGEA(PG_SA(0, 1), a2, 1, last);
            WAIT_L(8); PG_BAR; WAIT_L(0); PG_MMA(0, 0, At, B0); PG_BAR; PG_SCHED;
            PG_LDB(B1, 1, 1); PG_STAGEB(PG_SB(1, 0), b3, 0);
            PG_BAR; WAIT_L(0); PG_MMA(0, 1, At, B1); PG_BAR;
            PG_LDA(At, 1, 1); PG_STAGEA(PG_SA(1, 0), a3, 0, last);
            PG_BAR; WAIT_L(0); PG_MMA(1, 0, At, B0); PG_BAR; PG_SCHED;
            PG_STAGEB(PG_SB(1, 1), b3, 1);
            WAIT_V(6); PG_BAR; PG_MMA(1, 1, At, B1); PG_BAR;
        }
        if (FP8) asm volatile("s_nop 15\n\ts_nop 7" ::: "memory");
        const bool z = E(acc, cur.id);
        if (!has_next) break;
        if (z) acc_zero(acc);
        cur = nxt; cA = nA; cB = nB; ++ui;
        if (GATHER) { _Pragma("unroll") for (int q_ = 0; q_ < 4; ++q_) vgC[q_] = vgN[q_]; }
    }
    WAIT_V(0);
    if (wr == 0) PG_BAR;
    PG_BAR;
#undef PG_SA
#undef PG_STAGEB
#undef PG_SB
#undef PG_STAGE
#undef PG_STAGEA
#undef PG_GLOAD
#undef PG_LDA
#undef PG_CAT
#undef PG_LDB
#undef PG_MMA
#undef PG_BAR
#undef PG_SCHED
}
__device__ __forceinline__ void store_rows_bf16(bf16* base, size_t ld, int fr, int fq, const f32x4 x00, const f32x4 x01, const f32x4 x10, const f32x4 x11) {
    const bool hi = (fr & 8) != 0;
    const u32x4 h0 = {cvtpk(x00[0], x00[1]), cvtpk(x00[2], x00[3]), cvtpk(x01[0], x01[1]), cvtpk(x01[2], x01[3])};
    const u32x4 h1 = {cvtpk(x10[0], x10[1]), cvtpk(x10[2], x10[3]), cvtpk(x11[0], x11[1]), cvtpk(x11[2], x11[3])};
    const u32x4 send = hi ? h0 : h1; u32x4 recv;
#pragma unroll
    for (int i = 0; i < 4; ++i) recv[i] = (unsigned)__builtin_amdgcn_update_dpp(0, (int)send[i], 0x128, 0xf, 0xf, false);
    const u32x4 d0 = hi ? recv : h0, d1 = hi ? h1 : recv;
    bf16* p = base + (size_t)(fr & 7) * ld + fq * 16 + (hi ? 8 : 0);
    *reinterpret_cast<u32x4*>(p) = d0;
    *reinterpret_cast<u32x4*>(p + 8 * ld) = d1;
}
template <bool SWAP, class Fn> __device__ __forceinline__ void acc_foreach(const Acc& acc, Fn fn) {
    const int _t = opaque_tid(), _w = _t >> 6, _l = _t & 63, _wr = _w >> 2, _wc = _w & 3, _fr = _l & 15, _fq = _l >> 4;
#pragma unroll
    for (int ai = 0; ai < 2; ++ai)
#pragma unroll
        for (int bj = 0; bj < 2; ++bj)
#pragma unroll
            for (int m = 0; m < 4; ++m)
#pragma unroll
                for (int n = 0; n < 2; ++n) {
                    if (SWAP) fn(ai * 128 + _wr * 64 + m * 16 + _fr, bj * 128 + _wc * 32 + n * 16 + 4 * _fq, acc[ai][bj][m][n]);
                    else      fn(ai * 128 + _wr * 64 + m * 16 + 4 * _fq, bj * 128 + _wc * 32 + n * 16 + _fr, acc[ai][bj][m][n]);
                    __builtin_amdgcn_sched_barrier(0);
                }
}
struct DenseSched {
    const char* A; const char* B; size_t tstepA, tstepB; int nN, nM, bid, G; bool latent_only;
    __device__ __forceinline__ bool get(int i, GUnit& u) const {
        int pm, pn;
        if ((G & 7) == 0) {
            const int x = bid & 7, lb = bid >> 3, W = G >> 3, v = lb + i * W;
            const int own = (nM - x + 7) >> 3;
            if (v >= own * nN) return false;
            const int q = v / nN; pm = x + 8 * q; pn = v - q * nN;
        } else {
            const int t = bid + i * G; if (t >= nM * nN) return false;
            pm = t / nN; pn = t - pm * nN;
        }
        if (latent_only) pm += 1 + (pm >= 64 ? 1 : 0);
        u.a = A + (size_t)pm * tstepA; u.b = B + (size_t)pn * tstepB; u.id = pm * nN + pn; return true; }
};
__device__ __forceinline__ DenseSched dense_sched(const Ctx& F, const bf16* A, int lda, const bf16* Bt, int ldb, int M, int N) {
    DenseSched s; s.A = (const char*)A; s.B = (const char*)Bt; s.tstepA = (size_t)256 * lda * 2; s.tstepB = (size_t)256 * ldb * 2; s.nN = N / 256; s.nM = M / 256; s.bid = F.bid; s.G = F.G; s.latent_only = false; return s;
}

__device__ __forceinline__ void cvt_tile(const Ctx& F, const float* __restrict__ src, int ldsrc, bf16* __restrict__ dst, int lddst, int k0, int n0, int mode) {
    float* t = (float*)F.lds;
    const int kk = F.tid >> 5, nn = (F.tid & 31) * 4;
    f32x4 v[8];
#pragma unroll
    for (int h = 0; h < 8; ++h) v[h] = *reinterpret_cast<const f32x4*>(src + (size_t)(k0 + kk + 16 * h) * ldsrc + n0 + nn);
    __syncthreads();
#pragma unroll
    for (int h = 0; h < 8; ++h) *reinterpret_cast<f32x4*>(t + (kk + 16 * h) * 132 + nn) = v[h];
    __syncthreads();
#pragma unroll
    for (int h = 0; h < 4; ++h) {
        const int n = (F.tid & 31) + 32 * h, k8 = (F.tid >> 5) * 8;
        const float* p = t + k8 * 132 + n;
        u32x4 w = {cvtpk(p[0], p[132]), cvtpk(p[2 * 132], p[3 * 132]), cvtpk(p[4 * 132], p[5 * 132]), cvtpk(p[6 * 132], p[7 * 132])};
        const int ng = n0 + n;
        const int p3 = (ng & ~255) | (((ng >> 5) & 1) << 7) | (((ng >> 6) & 3) << 5) | (ng & 31);
        const int p4 = (ng & ~255) | (((ng >> 3) & 1) << 7) | (((ng >> 6) & 3) << 5) | (((ng >> 2) & 1) << 4) | (((ng >> 4) & 3) << 2) | (ng & 3);
        const int row = (mode == 0) ? ng : (mode == 5) ? (ng < 2048 ? p3 : p4)
                                         : (mode == 6) ? (ng < 4096 ? ng : p4)
                                         : ((ng >> 4) * 32 + (ng & 15) + (mode == 2 ? 16 : 0));
        *reinterpret_cast<u32x4*>(dst + (size_t)row * lddst + k0 + k8) = w;
    }
}
__device__ __forceinline__ void cvt_matrix(const Ctx& F, const float* src, int K, int N, bf16* dst, int lddst, int mode, int& rot, int lo = 0) {
    const int tk = K / 128, tn = N / 128, ntile = tk * tn, Gs = F.G - lo;
    if (F.bid >= lo) {
        int first = (F.bid - lo - rot) % Gs; if (first < 0) first += Gs;
        for (int i = first; i < ntile; i += Gs) cvt_tile(F, src, N, dst, lddst, (i / tn) * 128, (i % tn) * 128, mode);
    }
    rot = (rot + ntile) % Gs;
}

__device__ __forceinline__ void p0_prologue(const Ctx& F) {
    {
        float* sv = (float*)F.lds;
        float* red = sv + 3 * 1024;
        for (int i = F.tid; i < 3 * 1024; i += NTHR) sv[i] = silu_f(i < 2048 ? F.in[I_C][i] : F.in[I_CCTX][i - 2048]);
        __syncthreads();
        const int col = F.tid & 63, kg = F.tid >> 6;
        for (int it = F.bid; it < 4 * 96; it += F.G) {
            const int layer = it / 96, n0 = (it % 96) * 64;
            const float* W = F.in[I_MODW] + (size_t)layer * D * 6144 + n0 + col;
            float a0 = 0.f, a1 = 0.f, a2 = 0.f;
#pragma unroll 32
            for (int k = kg * 128; k < kg * 128 + 128; ++k) {
                const float w = W[(size_t)k * 6144];
                a0 += sv[k] * w; a1 += sv[1024 + k] * w; a2 += sv[2048 + k] * w;
            }
            __syncthreads();
            red[(kg * 3 + 0) * 64 + col] = a0; red[(kg * 3 + 1) * 64 + col] = a1; red[(kg * 3 + 2) * 64 + col] = a2;
            __syncthreads();
            if (F.tid < 192) {
                const int s = F.tid >> 6; float v = 0.f;
                for (int g = 0; g < 8; ++g) v += red[(g * 3 + s) * 64 + col];
                ((float*)(F.ws + WS_MODS))[((size_t)layer * 3 + s) * 6144 + n0 + col] = v + F.in[I_MODB][layer * 6144 + n0 + col];
            }
        }
        __syncthreads();
    }
    {
        float2* rr = (float2*)(F.ws + WS_RROPE);
        const float invf = 1.f / powf(10000.f, (float)(F.tid & 127) * (1.f / 127.f));
        for (int i = F.bid * NTHR + F.tid; i < SEQL * 128; i += F.G * NTHR) {
            const int pos = i >> 7; const float ang = (float)pos * invf;
            rr[i] = make_float2(cosf(ang), sinf(ang)); }
        float2* ar = (float2*)(F.ws + WS_AROPE);
        for (int i = F.bid * NTHR + F.tid; i < 320 * 16; i += F.G * NTHR) {
            const int p = i >> 4, f = i & 15; const float ang = (float)(p < 256 ? p : p - 256) * (1.f / powf(10000.f, (float)f * (1.f / 16.f)));
            ar[i] = make_float2(cosf(ang), sinf(ang)); }
    }
    if (F.bid == 0 && F.tid < 8) ((float*)(F.ws + WS_RETC))[F.tid] = log1pf(-expf(F.in[I_RLA][F.tid])) * 1.4426950408889634f;
    {
        bf16* wt = (bf16*)(F.ws + WS_WT); int rot = 0;
        for (int s = 0; s < 2; ++s) {
            cvt_matrix(F, F.in[I_DAWIN] + (size_t)s * 1024 * 3072, 1024, 3072, wt + WT_DAIN + (size_t)s * 3072 * 1024, 1024, 5, rot);
            cvt_matrix(F, F.in[I_DAWOUT] + (size_t)s * 1024 * 1024, 1024, 1024, wt + WT_DAOUT + (size_t)s * 1024 * 1024, 1024, 0, rot);
        }
        cvt_matrix(F, F.in[I_RWIN], 1024, 6144, wt + WT_RIN, 1024, 6, rot);
        cvt_matrix(F, F.in[I_RWOUT], 2048, 1024, wt + WT_ROUT, 2048, 0, rot);
        cvt_matrix(F, F.in[I_HWIN], 1024, 3072, wt + WT_HIN, 1024, 0, rot);
        cvt_matrix(F, F.in[I_HWOUT], 1024, 1024, wt + WT_HOUT, 1024, 0, rot);
    }
}

__device__ __forceinline__ void ph_modulate(const Ctx& F, int layer, int which, bf16* __restrict__ H, bool from_input = false) {
    const float* gn = F.in[which ? I_NFG : I_NMG] + layer * D;
    for (int r = F.bid * 8 + F.wave; r < MALL; r += F.G * 8) {
        const float* xp = from_input ? xrow_in(F, r) : xrow(F, r);
        const float* mb = (const float*)(F.ws + WS_MODS) + ((size_t)layer * 3 + mod_sel(r)) * 6144 + which * 3072;
        float4 v[4]; float ss = 0.f;
#pragma unroll
        for (int i = 0; i < 4; ++i) { v[i] = *reinterpret_cast<const float4*>(xp + i * 256 + F.lane * 4); ss += v[i].x * v[i].x + v[i].y * v[i].y + v[i].z * v[i].z + v[i].w * v[i].w; }
        ss = wave_sum(ss);
        const float rstd = rsqrtf(ss * (1.f / D) + EPS);
#pragma unroll
        for (int i = 0; i < 4; ++i) {
            const int e = i * 256 + F.lane * 4;
            const float4 g = *reinterpret_cast<const float4*>(gn + e), sh = *reinterpret_cast<const float4*>(mb + e), sc = *reinterpret_cast<const float4*>(mb + 1024 + e);
            const float a = v[i].x * rstd * g.x * (1.f + sc.x) + sh.x, b = v[i].y * rstd * g.y * (1.f + sc.y) + sh.y;
            const float c = v[i].z * rstd * g.z * (1.f + sc.z) + sh.z, d = v[i].w * rstd * g.w * (1.f + sc.w) + sh.w;
            u32x2 w = {cvtpk(a, b), cvtpk(c, d)};
            *reinterpret_cast<u32x2*>(H + (size_t)r * D + e) = w;
        }
    }
}

struct EpiBf16 { bf16* C; int ldc, nN;
    __device__ __forceinline__ bool operator()(Acc& acc, int t) const {
        const int brow = (t / nN) * 256, bcol = (t % nN) * 256;
        acc_foreach<true>(acc, [&](int row, int col4, f32x4 v) {
            u32x2 w = {cvtpk(v[0], v[1]), cvtpk(v[2], v[3])};
            *reinterpret_cast<u32x2*>(C + (size_t)(brow + row) * ldc + bcol + col4) = w; });
        return true; } };
__device__ __forceinline__ void ph_gemm_bf16(const Ctx& F, const bf16* A, int lda, const bf16* Bt, int ldb, int M, int N, int K, bf16* C, int ldc) {
    const DenseSched S = dense_sched(F, A, lda, Bt, ldb, M, N);
    const EpiBf16 E{C, ldc, N / 256};
    gemm_phase<true>(F.lds, lda, ldb, K, S, E);
}
struct EpiResid { float* xlat; float* xctx; const float* slat; const float* sctx; const float* mods; const float* bias;
    __device__ __forceinline__ bool operator()(Acc& acc, int t) const {
        const int brow = (t / 4) * 256, bcol = (t % 4) * 256;
        const int b = brow / NTOK, tt = brow - b * NTOK;
        float* xb = (tt < CTX) ? xctx + (size_t)(b * CTX) * D : xlat + (size_t)(b * SEQL + tt - CTX) * D;
        const float* sb = (tt < CTX) ? sctx + (size_t)(b * CTX) * D : slat + (size_t)(b * SEQL + tt - CTX) * D;
        const float* gate = mods + (size_t)((tt < CTX) ? 2 : b) * 6144;
        const int _t = opaque_tid(), _w = _t >> 6, _l = _t & 63, _wr = _w >> 2, _wc = _w & 3, _fr = _l & 15, _fq = _l >> 4;
        const int c0 = bcol + _wc * 32 + 4 * _fq;
        f32x4 g[4], bs[4];
#pragma unroll
        for (int q = 0; q < 4; ++q) { g[q] = *reinterpret_cast<const f32x4*>(gate + c0 + (q >> 1) * 128 + (q & 1) * 16);
            bs[q] = f32x4{0.f, 0.f, 0.f, 0.f}; if (bias) bs[q] = *reinterpret_cast<const f32x4*>(bias + c0 + (q >> 1) * 128 + (q & 1) * 16); }
        const size_t ro = (size_t)(_wr * 64 + _fr) * D + c0;
        const float* sp = sb + ro; float* xp = xb + ro;
        f32x4 cur[4], nxt[4];
#pragma unroll
        for (int q = 0; q < 4; ++q) cur[q] = *reinterpret_cast<const f32x4*>(sp + (q >> 1) * 128 + (q & 1) * 16);
#pragma unroll
        for (int k = 0; k < 8; ++k) {
            const int ai = k >> 2, m = k & 3;
            if (k + 1 < 8) {
                const size_t rn = (size_t)(((k + 1) >> 2) * 128 + ((k + 1) & 3) * 16) * D;
#pragma unroll
                for (int q = 0; q < 4; ++q) nxt[q] = *reinterpret_cast<const f32x4*>(sp + rn + (q >> 1) * 128 + (q & 1) * 16);
            }
            const size_t rk = (size_t)(ai * 128 + m * 16) * D;
#pragma unroll
            for (int q = 0; q < 4; ++q) *reinterpret_cast<f32x4*>(xp + rk + (q >> 1) * 128 + (q & 1) * 16) = cur[q] + g[q] * (acc[ai][q >> 1][m][q & 1] + bs[q]);
#pragma unroll
            for (int q = 0; q < 4; ++q) cur[q] = nxt[q];
            __builtin_amdgcn_sched_barrier(0);
        }
        return true; } };
__device__ __forceinline__ void ph_gemm_resid(const Ctx& F, const bf16* A, int lda, const bf16* Bt, int K, int layer, int gate_off, const float* bias, bool from_input = false, bool latent_only = false) {
    DenseSched S = dense_sched(F, A, lda, Bt, K, MALL, D);
    if (latent_only) { S.nM = 128; S.latent_only = true; }
    const EpiResid E{F.out, (float*)(F.ws + WS_CTXX), from_input ? F.in[I_X] : F.out, from_input ? F.in[I_CTX] : (const float*)(F.ws + WS_CTXX),
                     (const float*)(F.ws + WS_MODS) + (size_t)layer * 3 * 6144 + gate_off, bias};
    gemm_phase<true>(F.lds, lda, K, K, S, E);
}

struct EpiQKV { bf16* C; const float* gq; const float* gk; const float2* art;
    __device__ __forceinline__ bool operator()(Acc& acc, int t) const {
        const int pm = t / 12, pn = t - pm * 12, brow = pm * 256;
        const int b = brow / NTOK, tt0 = brow - b * NTOK;
        const int _t = opaque_tid(), _w = _t >> 6, _l = _t & 63, _wr = _w >> 2, _wc = _w & 3, _fr = _l & 15, _fq = _l >> 4;
        bf16* dst = C + (size_t)brow * 3072 + pn * 256 + _wc * 64;
        if (pn < 8) {
            const float* gn = (pn < 4 ? gq : gk) + 4 * _fq;
            const float qs = (pn < 4) ? 0.125f * 1.4426950408889634f : 1.f;
            const f32x4 g00 = *reinterpret_cast<const f32x4*>(gn), g01 = *reinterpret_cast<const f32x4*>(gn + 16), g10 = *reinterpret_cast<const f32x4*>(gn + 32), g11 = *reinterpret_cast<const f32x4*>(gn + 48);
            const bool lat = tt0 >= CTX;
            f32x4 rc_[4] = {}, rn_[4] = {};
            const float2* artl = art + 4 * _fq;
            if (lat) { const int pos = tt0 - CTX + _wr * 64 + _fr;
                const f32x4* t0 = reinterpret_cast<const f32x4*>(artl + (pos >> 6) * 16); const f32x4* t1 = reinterpret_cast<const f32x4*>(artl + (256 + (pos & 63)) * 16);
                rc_[0] = t0[0]; rc_[1] = t0[1]; rc_[2] = t1[0]; rc_[3] = t1[1]; }
#pragma unroll
            for (int ai = 0; ai < 2; ++ai)
#pragma unroll
                for (int m = 0; m < 4; ++m) {
                    if (lat && (ai * 4 + m) < 7) { const int kn = ai * 4 + m + 1; const int pos = tt0 - CTX + (kn >> 2) * 128 + _wr * 64 + (kn & 3) * 16 + _fr;
                        const f32x4* t0 = reinterpret_cast<const f32x4*>(artl + (pos >> 6) * 16); const f32x4* t1 = reinterpret_cast<const f32x4*>(artl + (256 + (pos & 63)) * 16);
                        rn_[0] = t0[0]; rn_[1] = t0[1]; rn_[2] = t1[0]; rn_[3] = t1[1]; }
                    f32x4 x00 = acc[ai][0][m][0], x01 = acc[ai][0][m][1], x10 = acc[ai][1][m][0], x11 = acc[ai][1][m][1];
                    const f32x4 sq = x00 * x00 + x01 * x01 + x10 * x10 + x11 * x11;
                    float ss = (sq[0] + sq[1]) + (sq[2] + sq[3]);
                    ss += __shfl_xor(ss, 16, 64); ss += __shfl_xor(ss, 32, 64);
                    const float r = rsqrtf(ss * (1.f / 64.f) + EPS) * qs;
                    x00 = x00 * r * g00; x01 = x01 * r * g01; x10 = x10 * r * g10; x11 = x11 * r * g11;
                    if (lat) {
                        const f32x4 a01 = rc_[0], a23 = rc_[1], b01 = rc_[2], b23 = rc_[3];
                        const float ca[4] = {a01[0], a01[2], a23[0], a23[2]}, sa[4] = {a01[1], a01[3], a23[1], a23[3]};
                        const float cb[4] = {b01[0], b01[2], b23[0], b23[2]}, sb[4] = {b01[1], b01[3], b23[1], b23[3]};
#pragma unroll
                        for (int j = 0; j < 4; ++j) {
                            const float p = x00[j], q = x01[j]; x00[j] = p * ca[j] - q * sa[j]; x01[j] = q * ca[j] + p * sa[j];
                            const float u = x10[j], v = x11[j]; x10[j] = u * cb[j] - v * sb[j]; x11[j] = v * cb[j] + u * sb[j];
                        }
                    }
                    store_rows_bf16(dst + (size_t)(ai * 128 + _wr * 64 + m * 16) * 3072, 3072, _fr, _fq, x00, x01, x10, x11);
#pragma unroll
                    for (int q = 0; q < 4; ++q) rc_[q] = rn_[q];
                    __builtin_amdgcn_sched_barrier(0);
                }
        } else {
#pragma unroll
            for (int ai = 0; ai < 2; ++ai)
#pragma unroll
                for (int m = 0; m < 4; ++m) {
                    store_rows_bf16(dst + (size_t)(ai * 128 + _wr * 64 + m * 16) * 3072, 3072, _fr, _fq, acc[ai][0][m][0], acc[ai][0][m][1], acc[ai][1][m][0], acc[ai][1][m][1]);
                    __builtin_amdgcn_sched_barrier(0);
                }
        }
        return true; } };
__device__ __forceinline__ void ph_gemm_qkv(const Ctx& F, int s, const bf16* A, const bf16* Bt, bf16* QKV) {
    const DenseSched S = dense_sched(F, A, D, Bt, D, MALL, 3072);
    const EpiQKV E{QKV, F.in[I_DAQN] + s * 64, F.in[I_DAKN] + s * 64, (const float2*)(F.ws + WS_AROPE)};
    gemm_phase<true>(F.lds, D, D, D, S, E);
}
__device__ __forceinline__ void ph_qknorm_rope(const Ctx& F, int s, bf16* __restrict__ QKV) {
    const int g = F.lane >> 1, half = F.lane & 1;
    const float* gn = F.in[(g < 16) ? I_DAQN : I_DAKN] + s * 64 + half * 32;
    float gv[32];
#pragma unroll
    for (int i = 0; i < 32; ++i) gv[i] = gn[i];
    const float2* art = (const float2*)(F.ws + WS_AROPE);
    for (int r = F.bid * 8 + F.wave; r < MALL; r += F.G * 8) {
        const int t = r % NTOK;
        bf16x8* p = reinterpret_cast<bf16x8*>(QKV + (size_t)r * 3072 + F.lane * 32);
        bf16x8 raw[4]; float x[32]; float ss = 0.f;
#pragma unroll
        for (int i = 0; i < 4; ++i) raw[i] = p[i];
#pragma unroll
        for (int i = 0; i < 32; ++i) { x[i] = bf2f((unsigned short)raw[i >> 3][i & 7]); ss += x[i] * x[i]; }
        ss += __shfl_xor(ss, 1, 64);
        const float rstd = rsqrtf(ss * (1.f / 64.f) + EPS);
        const float qs = (g < 16) ? 0.125f * 1.4426950408889634f : 1.f;
#pragma unroll
        for (int i = 0; i < 32; ++i) x[i] = x[i] * (rstd * qs) * gv[i];
        if (t >= CTX) {
            const int pos = t - CTX; const float2* tp = art + (half == 0 ? (pos >> 6) : 256 + (pos & 63)) * 16;
#pragma unroll
            for (int f = 0; f < 16; ++f) {
                const float2 csn = tp[f]; const float cs = csn.x, sn = csn.y;
                const float a = x[f], b = x[16 + f];
                x[f] = a * cs - b * sn; x[16 + f] = b * cs + a * sn;
            }
        }
#pragma unroll
        for (int i = 0; i < 4; ++i) { u32x4 w = {cvtpk(x[i * 8 + 0], x[i * 8 + 1]), cvtpk(x[i * 8 + 2], x[i * 8 + 3]), cvtpk(x[i * 8 + 4], x[i * 8 + 5]), cvtpk(x[i * 8 + 6], x[i * 8 + 7])};
            *reinterpret_cast<u32x4*>(&p[i]) = w; }
    }
}

#define KSWZ(row, colB) ((row) * 256 + ((colB) ^ (((row) & 7) << 4)))
#define SBAR() __builtin_amdgcn_sched_barrier(0)
constexpr int AT_SHM_V = 64 * 128 * 2, AT_SHM_K = 64 * 128 * 2;
#ifndef AT_SDEPTH
#define AT_SDEPTH 1
#endif
__device__ __forceinline__ int crow(int r, int hi) { return (r & 3) + 8 * (r >> 2) + 4 * hi; }
__device__ __forceinline__ int v_st(int k, int c) { const int kk = (k & ~0xC) | ((k & 4) << 1) | ((k & 8) >> 1); return ((kk >> 3) * 4 + (c >> 5)) * 512 + ((kk & 7) * 32 + (c & 31)) * 2; }
__device__ __forceinline__ int v_rd_base(int lane) { return ((lane & 3) << 3) | (((lane >> 2) & 3) << 6) | (((lane >> 4) & 1) << 5) | (((lane >> 5) & 1) << 8); }
constexpr int v_rd_off(int d0, int ks, int half) { return d0 * 512 + ks * 4096 + half * 2048; }
template <int OFF> __device__ __forceinline__ s16x4 tr_read(int vb) {
    s16x4 r; asm volatile("ds_read_b64_tr_b16 %0, %1 offset:%2" : "=&v"(r) : "v"(vb), "i"(OFF) : "memory"); return r;
}
template <int D0> __device__ __forceinline__ void pv_one(f32x16& od, int vb, bf16x8 pa0, bf16x8 pa1, bf16x8 pa2, bf16x8 pa3) {
#define PK(L, H) (bf16x8){L[0], L[1], L[2], L[3], H[0], H[1], H[2], H[3]}
    {   const s16x4 l0 = tr_read<v_rd_off(D0, 0, 0)>(vb), h0 = tr_read<v_rd_off(D0, 0, 1)>(vb), l1 = tr_read<v_rd_off(D0, 1, 0)>(vb), h1 = tr_read<v_rd_off(D0, 1, 1)>(vb);
        asm volatile("s_waitcnt lgkmcnt(0)" ::: "memory"); SBAR();
        od = __builtin_amdgcn_mfma_f32_32x32x16_bf16(pa0, PK(l0, h0), od, 0, 0, 0);
        od = __builtin_amdgcn_mfma_f32_32x32x16_bf16(pa1, PK(l1, h1), od, 0, 0, 0);
        asm volatile("" : "+v"(od)); }
    {   const s16x4 l2 = tr_read<v_rd_off(D0, 2, 0)>(vb), h2 = tr_read<v_rd_off(D0, 2, 1)>(vb), l3 = tr_read<v_rd_off(D0, 3, 0)>(vb), h3 = tr_read<v_rd_off(D0, 3, 1)>(vb);
        asm volatile("s_waitcnt lgkmcnt(0)" ::: "memory"); SBAR();
        od = __builtin_amdgcn_mfma_f32_32x32x16_bf16(pa2, PK(l2, h2), od, 0, 0, 0);
        od = __builtin_amdgcn_mfma_f32_32x32x16_bf16(pa3, PK(l3, h3), od, 0, 0, 0);
        asm volatile("" : "+v"(od)); }
#undef PK
}
__device__ __forceinline__ void pv_d0(f32x16* o, int vb, bf16x8 pa0, bf16x8 pa1, bf16x8 pa2, bf16x8 pa3) {
    pv_one<0>(o[0], vb, pa0, pa1, pa2, pa3); pv_one<1>(o[1], vb, pa0, pa1, pa2, pa3); pv_one<2>(o[2], vb, pa0, pa1, pa2, pa3); pv_one<3>(o[3], vb, pa0, pa1, pa2, pa3);
}
template <bool SHIFT> __device__ __forceinline__ void at_exp_half(f32x16& p, float nsh) {
#pragma unroll
    for (int r = 0; r < 16; ++r) p[r] = __builtin_amdgcn_exp2f(SHIFT ? p[r] + nsh : p[r]);
}

template <int D0> __device__ __forceinline__ void pv_two(f32x16& oa, f32x16& ob, int vb, const bf16x8 (&pa)[4], const bf16x8 (&pb)[4]) {
    const s16x4 l0 = tr_read<v_rd_off(D0, 0, 0)>(vb), h0 = tr_read<v_rd_off(D0, 0, 1)>(vb), l1 = tr_read<v_rd_off(D0, 1, 0)>(vb), h1 = tr_read<v_rd_off(D0, 1, 1)>(vb);
    const s16x4 l2 = tr_read<v_rd_off(D0, 2, 0)>(vb), h2 = tr_read<v_rd_off(D0, 2, 1)>(vb), l3 = tr_read<v_rd_off(D0, 3, 0)>(vb), h3 = tr_read<v_rd_off(D0, 3, 1)>(vb);
    asm volatile("s_waitcnt lgkmcnt(0)" ::: "memory"); SBAR();
#define PK(L, H) (bf16x8){L[0], L[1], L[2], L[3], H[0], H[1], H[2], H[3]}
    const bf16x8 v0 = PK(l0, h0), v1 = PK(l1, h1), v2 = PK(l2, h2), v3 = PK(l3, h3);
#undef PK
    oa = __builtin_amdgcn_mfma_f32_32x32x16_bf16(pa[0], v0, oa, 0, 0, 0); ob = __builtin_amdgcn_mfma_f32_32x32x16_bf16(pb[0], v0, ob, 0, 0, 0);
    oa = __builtin_amdgcn_mfma_f32_32x32x16_bf16(pa[1], v1, oa, 0, 0, 0); ob = __builtin_amdgcn_mfma_f32_32x32x16_bf16(pb[1], v1, ob, 0, 0, 0);
    oa = __builtin_amdgcn_mfma_f32_32x32x16_bf16(pa[2], v2, oa, 0, 0, 0); ob = __builtin_amdgcn_mfma_f32_32x32x16_bf16(pb[2], v2, ob, 0, 0, 0);
    oa = __builtin_amdgcn_mfma_f32_32x32x16_bf16(pa[3], v3, oa, 0, 0, 0); ob = __builtin_amdgcn_mfma_f32_32x32x16_bf16(pb[3], v3, ob, 0, 0, 0);
}
#define PK(L, H) (bf16x8){L[0], L[1], L[2], L[3], H[0], H[1], H[2], H[3]}
#define VRD(D0_, L0, H0, L1, H1) const s16x4 L0 = tr_read<v_rd_off(D0_, 2 * KH, 0)>(vb), H0 = tr_read<v_rd_off(D0_, 2 * KH, 1)>(vb), L1 = tr_read<v_rd_off(D0_, 2 * KH + 1, 0)>(vb), H1 = tr_read<v_rd_off(D0_, 2 * KH + 1, 1)>(vb)
#define VMM(OD, L0, H0, L1, H1) do { __builtin_amdgcn_s_setprio(1); OD = __builtin_amdgcn_mfma_f32_32x32x16_bf16(paA, PK(L0, H0), OD, 0, 0, 0); OD = __builtin_amdgcn_mfma_f32_32x32x16_bf16(paB, PK(L1, H1), OD, 0, 0, 0); __builtin_amdgcn_s_setprio(0); asm volatile("" : "+v"(OD)); } while (0)
template <int KH> __device__ __forceinline__ void pv_half4(f32x16 (&o)[4], int vb, bf16x8 paA, bf16x8 paB) {
    VRD(0, a0, a1, a2, a3);
    VRD(1, b0, b1, b2, b3);
    asm volatile("s_waitcnt lgkmcnt(4)" ::: "memory"); SBAR(); VMM(o[0], a0, a1, a2, a3);
    VRD(2, c0, c1, c2, c3);
    asm volatile("s_waitcnt lgkmcnt(4)" ::: "memory"); SBAR(); VMM(o[1], b0, b1, b2, b3);
    VRD(3, d0, d1, d2, d3);
    asm volatile("s_waitcnt lgkmcnt(4)" ::: "memory"); SBAR(); VMM(o[2], c0, c1, c2, c3);
    asm volatile("s_waitcnt lgkmcnt(0)" ::: "memory"); SBAR(); VMM(o[3], d0, d1, d2, d3);
}
#undef VMM
#undef VRD
#undef PK
template <int OFF> __device__ __forceinline__ bf16x8 lds_read128(int addr) {
    bf16x8 r; asm volatile("ds_read_b128 %0, %1 offset:%2" : "=&v"(r) : "v"(addr), "i"(OFF) : "memory"); return r;
}
template <int KOFF, int CMAP, bool SHIFT> __device__ __forceinline__ void at_half(const LAS unsigned char* ldsl, const int (&ksw)[4], const int (&qsw)[4], float C, float nsh, float& lsum, bf16x8& paA, bf16x8& paB) {
    f32x16 p = f32x16{};
    {
        const int lb = 0;
        const bf16x8 k0 = lds_read128<KOFF + CMAP * 8192>(lb + ksw[0]), q0 = lds_read128<CMAP * 32768>(lb + qsw[0]);
        const bf16x8 k1 = lds_read128<KOFF + CMAP * 8192>(lb + ksw[1]), q1 = lds_read128<CMAP * 32768>(lb + qsw[1]);
        const bf16x8 k2 = lds_read128<KOFF + CMAP * 8192>(lb + ksw[2]), q2 = lds_read128<CMAP * 32768>(lb + qsw[2]);
        const bf16x8 k3 = lds_read128<KOFF + CMAP * 8192>(lb + ksw[3]), q3 = lds_read128<CMAP * 32768>(lb + qsw[3]);
        asm volatile("s_waitcnt lgkmcnt(6)" ::: "memory"); SBAR(); p = __builtin_amdgcn_mfma_f32_32x32x16_bf16(k0, q0, p, 0, 0, 0);
        asm volatile("s_waitcnt lgkmcnt(4)" ::: "memory"); SBAR(); p = __builtin_amdgcn_mfma_f32_32x32x16_bf16(k1, q1, p, 0, 0, 0);
        asm volatile("s_waitcnt lgkmcnt(2)" ::: "memory"); SBAR(); p = __builtin_amdgcn_mfma_f32_32x32x16_bf16(k2, q2, p, 0, 0, 0);
        asm volatile("s_waitcnt lgkmcnt(0)" ::: "memory"); SBAR(); p = __builtin_amdgcn_mfma_f32_32x32x16_bf16(k3, q3, p, 0, 0, 0);
    }
    at_exp_half<SHIFT>(p, nsh);
    float ps = 0.f;
#pragma unroll
    for (int r = 0; r < 16; ++r) ps += p[r];
    lsum += ps;
    asm volatile("" : "+v"(lsum));
#define PK4(P, BASE, OUT) do { unsigned a0 = cvtpk(P[BASE + 0], P[BASE + 1]), a1 = cvtpk(P[BASE + 2], P[BASE + 3]);   \
    unsigned b0 = cvtpk(P[BASE + 4], P[BASE + 5]), b1 = cvtpk(P[BASE + 6], P[BASE + 7]);                              \
    auto r0 = __builtin_amdgcn_permlane32_swap(a0, b0, false, false); auto r1 = __builtin_amdgcn_permlane32_swap(a1, b1, false, false); \
    u32x4 w = {r0[0], r1[0], r0[1], r1[1]}; OUT = *reinterpret_cast<bf16x8*>(&w); } while (0)
    PK4(p, 0, paA); PK4(p, 8, paB);
#undef PK4
}
template <bool SHIFT> __device__ __forceinline__ void attn_unit(const Ctx& F, const bf16* __restrict__ QKV, bf16* __restrict__ AO, int qrow0, int krow0, int nkeys, int h,
                                          float C, float nsh, float lam, float osc, const float* __restrict__ subg) {
    LAS unsigned char* ldsl = (LAS unsigned char*)F.lds;
    char* lds = F.lds;
    const int tid = opaque_tid(), wid = __builtin_amdgcn_readfirstlane(tid >> 6), lane = tid & 63, r32a = lane & 31, hia = lane >> 5;
    constexpr int OFF_V = 0, OFF_K = 2 * AT_SHM_V, OFF_Q = 2 * AT_SHM_V + 2 * AT_SHM_K, OFF_L = OFF_Q + 256 * 256;
    const int krow = 8 * wid + (lane >> 3), kcol = ((lane & 7) ^ ((krow >> 1) & 7)) * 8;
    const int vst = 2 * wid + (lane >> 5), vkk = (vst >> 2) * 8 + ((lane & 31) >> 2), vkey = (vkk & ~0xC) | ((vkk & 4) << 1) | ((vkk & 8) >> 1), vcol = (vst & 3) * 32 + (lane & 3) * 8;
    const unsigned koff = (unsigned)(krow * 3072 + kcol) * 2u, voff = (unsigned)(vkey * 3072 + vcol) * 2u;
    const char* Kh = (const char*)(QKV + (size_t)krow0 * 3072 + 1024 + h * 128);
    const char* Vh = (const char*)(QKV + (size_t)krow0 * 3072 + 2048 + h * 128);
    const char* Qh = (const char*)(QKV + (size_t)qrow0 * 3072 + h * 128);
    const unsigned ldsw = (unsigned)wid * 1024u;
#define DMA_KV(buf, k0) do { _Pragma("unroll") for (int m_ = 0; m_ < 2; ++m_) { \
        __builtin_amdgcn_global_load_lds((const unsigned*)(Kh + (size_t)(k0) * 6144 + m_ * 128 + koff), (LAS unsigned*)(ldsl + OFF_K + (buf) * AT_SHM_K + ldsw + m_ * 8192), 16, 0, 0); \
        __builtin_amdgcn_global_load_lds((const unsigned*)(Vh + (size_t)((k0) + 32 * m_) * 6144 + voff), (LAS unsigned*)(ldsl + OFF_V + (buf) * AT_SHM_V + ldsw + m_ * 8192), 16, 0, 0); } } while (0)
    const int NT = nkeys / 64;
    __syncthreads();
#pragma unroll
    for (int m_ = 0; m_ < 8; ++m_) __builtin_amdgcn_global_load_lds((const unsigned*)(Qh + (size_t)(64 * (m_ & 3)) * 6144 + (m_ >> 2) * 128 + koff), (LAS unsigned*)(ldsl + OFF_Q + ldsw + m_ * 8192), 16, 0, 0);
    DMA_KV(0, 0);
    float lsum0 = 0.f, lsum1 = 0.f; f32x16 o0[4] = {}, o1[4] = {};
    const int vb0 = (int)(uintptr_t)(lds + OFF_V) + v_rd_base(lane);
    int ksw[4], qsw[4];
#pragma unroll
    for (int d0 = 0; d0 < 4; ++d0) { ksw[d0] = (int)(uintptr_t)lds + r32a * 128 + (((d0 * 2 + hia) ^ ((r32a >> 1) & 7)) << 4); qsw[d0] = ksw[d0] + wid * 4096 + OFF_Q; }
    asm volatile("s_waitcnt vmcnt(0)" ::: "memory"); __builtin_amdgcn_s_barrier();
#define AT_MAPHALF(B, CM, KH, OO, LS) do { bf16x8 pA_, pB_; \
        at_half<OFF_K + (B) * AT_SHM_K + (KH) * 4096, CM, SHIFT>(ldsl, ksw, qsw, C, nsh, LS, pA_, pB_); \
        const int vb_ = vb0 + (B) * AT_SHM_V; \
        pv_half4<KH>(OO, vb_, pA_, pB_); } while (0)
#define AT_TILE(B, NEXT_K0, HAS_NEXT) do { \
        if (HAS_NEXT) DMA_KV((B) ^ 1, NEXT_K0); \
        AT_MAPHALF(B, 0, 0, o0, lsum0); AT_MAPHALF(B, 0, 1, o0, lsum0); AT_MAPHALF(B, 1, 0, o1, lsum1); AT_MAPHALF(B, 1, 1, o1, lsum1); \
        asm volatile("s_waitcnt vmcnt(0)" ::: "memory"); __builtin_amdgcn_s_barrier();     \
    } while (0)
#pragma unroll 1
    for (int j = 0; j < NT; j += 2) {
        int jj = j; asm volatile("" : "+s"(jj));
        AT_TILE(0, (jj + 1) * 64, true);
        AT_TILE(1, (jj + 2) * 64, j + 2 < NT);
    }
#undef AT_TILE
#undef AT_MAPHALF
#undef DMA_KV
    const int tz = opaque_tid(), wz = tz >> 6, r32 = tz & 31, hi = (tz >> 5) & 1;
    float* li_l = (float*)(F.lds + OFF_L) + wz * 64;
    const int lz = tz & 63;
#define SHX(v, of) __uint_as_float(__builtin_amdgcn_ds_bpermute((lz ^ (of)) << 2, __float_as_uint(v)))
    lsum0 += SHX(lsum0, 32); lsum1 += SHX(lsum1, 32);
    if (hi == 0) { li_l[r32] = lsum0; li_l[32 + r32] = lsum1; }
    asm volatile("s_waitcnt lgkmcnt(0)" ::: "memory");
    float gsub[4];
#pragma unroll
    for (int d0 = 0; d0 < 4; ++d0) gsub[d0] = subg[d0 * 32 + r32] * osc;
#pragma unroll
    for (int r = 0; r < 16; ++r) {
        const float ra = 1.f / li_l[crow(r, hi)], rb = lam / li_l[32 + crow(r, hi)];
        float res[4], ss = 0.f;
#pragma unroll
        for (int d0 = 0; d0 < 4; ++d0) { res[d0] = o0[d0][r] * ra - o1[d0][r] * rb; ss += res[d0] * res[d0]; }
#pragma unroll
        for (int of = 1; of < 32; of <<= 1) ss += SHX(ss, of);
        const float rstd = rsqrtf(ss * (1.f / 128.f) + EPS);
        unsigned short* op = (unsigned short*)AO + (size_t)(qrow0 + wz * 32 + crow(r, hi)) * D + h * 128 + r32;
#pragma unroll
        for (int d0 = 0; d0 < 4; ++d0) op[d0 * 32] = f2bf(res[d0] * rstd * gsub[d0]);
        SBAR();
    }
#undef SHX
}

__device__ __forceinline__ void ph_attention(const Ctx& F, int layer, int s, bool need_ctx, const bf16* QKV, bf16* AO) {
    const float* lamp = F.in[I_DALAM] + s * 256;
    float d01 = 0.f, d23 = 0.f, mq = 0.f, mk = 0.f;
    for (int i = 0; i < 64; ++i) { d01 += lamp[i] * lamp[64 + i]; d23 += lamp[128 + i] * lamp[192 + i];
        mq = fmaxf(mq, fabsf(F.in[I_DAQN][s * 64 + i])); mk = fmaxf(mk, fabsf(F.in[I_DAKN][s * 64 + i])); }
    const float lam_init = 0.8f - 0.6f * expf(-0.3f * (float)layer);
    const float lam = expf(d01) - expf(d23) + lam_init;
    const float Mb = 8.f * mq * mk, shift = fmaxf(0.f, Mb - 30.f);
    const float C = 0.125f * 1.4426950408889634f, nsh = __uint_as_float(__builtin_amdgcn_readfirstlane(__float_as_uint(-shift * 1.4426950408889634f)));
    const float lam_u = __uint_as_float(__builtin_amdgcn_readfirstlane(__float_as_uint(lam))), osc_u = __uint_as_float(__builtin_amdgcn_readfirstlane(__float_as_uint(1.f - lam_init)));
    const float* subg = F.in[I_DASUB] + s * 128;
    const int nlat = NB * 8 * (SEQL / 256), nctx = need_ctx ? NB * 8 : 0;
#define AT_UNITS(SH) for (int u0 = F.bid; u0 < nlat + nctx; u0 += F.G) { \
        int u = u0; \
        if (u0 < nlat && F.G == 256) { const int s_ = (u0 >> 8) * 8 + (F.bid & 7); u = (s_ >> 1) * 64 + (s_ & 1) * 32 + (F.bid >> 3); }     \
        if (u < nlat) { const int qb = u % (SEQL / 256), bh = u / (SEQL / 256), h = bh % 8, b = bh / 8; \
            attn_unit<SH>(F, QKV, AO, b * NTOK + CTX + qb * 256, b * NTOK, NTOK, h, C, nsh, lam_u, osc_u, subg); } \
        else { const int bh = u - nlat, h = bh % 8, b = bh / 8; \
            attn_unit<SH>(F, QKV, AO, b * NTOK, b * NTOK, CTX, h, C, nsh, lam_u, osc_u, subg); } }
    if (nsh == 0.f) { AT_UNITS(false) } else { AT_UNITS(true) }
#undef AT_UNITS
}

__device__ __forceinline__ void cvt_tile_f8(const Ctx& F, const float* __restrict__ src, int ldsrc, unsigned char* __restrict__ dst, int lddst, int k0, int n0, int mode) {
    float* t = (float*)F.lds;
    const int kk = F.tid >> 5, nn = (F.tid & 31) * 4;
    f32x4 v[8];
#pragma unroll
    for (int h = 0; h < 8; ++h) v[h] = *reinterpret_cast<const f32x4*>(src + (size_t)(k0 + kk + 16 * h) * ldsrc + n0 + nn);
    __syncthreads();
#pragma unroll
    for (int h = 0; h < 8; ++h) *reinterpret_cast<f32x4*>(t + (kk + 16 * h) * 132 + nn) = v[h];
    __syncthreads();
#pragma unroll
    for (int h = 0; h < 4; ++h) {
        const int n = (F.tid & 31) + 32 * h, k8 = (F.tid >> 5) * 8;
        const float* p = t + k8 * 132 + n;
        float q[8];
#pragma unroll
        for (int j = 0; j < 8; ++j) q[j] = fminf(fmaxf(p[j * 132] * 32.f, -448.f), 448.f);
        unsigned w0 = 0u, w1 = 0u;
        w0 = __builtin_amdgcn_cvt_pk_fp8_f32(q[0], q[1], w0, false); w0 = __builtin_amdgcn_cvt_pk_fp8_f32(q[2], q[3], w0, true);
        w1 = __builtin_amdgcn_cvt_pk_fp8_f32(q[4], q[5], w1, false); w1 = __builtin_amdgcn_cvt_pk_fp8_f32(q[6], q[7], w1, true);
        const int ng = n0 + n;
        const int row = (mode == 0) ? ng : ((ng >> 7) * 256 + ((ng >> 2) & 1) * 128 + ((ng >> 5) & 3) * 32 + (mode == 2 ? 16 : 0) + ((ng >> 3) & 3) * 4 + (ng & 3));
        u32x2 w = {w0, w1};
        *reinterpret_cast<u32x2*>(dst + (size_t)row * lddst + k0 + k8) = w;
    }
}
__device__ __forceinline__ void cvt_matrix_f8(const Ctx& F, const float* src, int K, int N, unsigned char* dst, int lddst, int mode, int& rot, int lo) {
    const int tk = K / 128, tn = N / 128, ntile = tk * tn, Gs = F.G - lo;
    if (F.bid >= lo) {
        int first = (F.bid - lo - rot) % Gs; if (first < 0) first += Gs;
        for (int i = first; i < ntile; i += Gs) cvt_tile_f8(F, src, N, dst, lddst, (i / tn) * 128, (i % tn) * 128, mode);
    }
    rot = (rot + ntile) % Gs;
}
__device__ __forceinline__ void ph_cvt_experts(const Ctx& F, int layer, unsigned char* EXPW8) {
    int rot = 0;
    for (int e = 0; e < NEXP; ++e) {
        const size_t wo = ((size_t)layer * NEXP + e) * 1024 * 1024;
        unsigned char* dst = EXPW8 + (size_t)e * 3072 * 1024;
        const int lo = (F.G > 128) ? 64 : 0;
        cvt_matrix_f8(F, F.in[I_EW1] + wo, 1024, 1024, dst, 1024, 1, rot, lo);
        cvt_matrix_f8(F, F.in[I_EW3] + wo, 1024, 1024, dst, 1024, 2, rot, lo);
        cvt_matrix_f8(F, F.in[I_EW2] + wo, 1024, 1024, dst + (size_t)2048 * 1024, 1024, 0, rot, lo);
    }
}
__device__ __forceinline__ void ph_ffn_modulate_router(const Ctx& F, int layer, unsigned char* __restrict__ H8, bool need_ctx) {
    float* rw = (float*)F.lds;
    unsigned* __restrict__ H8w = reinterpret_cast<unsigned*>(H8);
    __syncthreads();
    for (int i = F.tid; i < 1024 * 16; i += NTHR) rw[(i & 15) * 1024 + (i >> 4)] = F.in[I_RTW][(size_t)layer * 1024 * 16 + i];
    __syncthreads();
    const float* gn = F.in[I_NFG] + layer * D;
    float* affl = (float*)(F.ws + WS_AFFL); float* affc = (float*)(F.ws + WS_AFFC);
    for (int r = F.bid * 8 + F.wave; r < MALL; r += F.G * 8) {
        const int b = r / NTOK, t = r - b * NTOK;
        if (!need_ctx && t < CTX) continue;
        const float* xp = xrow(F, r);
        const float* mb = (const float*)(F.ws + WS_MODS) + ((size_t)layer * 3 + ((t < CTX) ? 2 : b)) * 6144 + 3072;
        float4 v[4]; float ss = 0.f;
        float4 gA[4], shA[4], scA[4];
#pragma unroll
        for (int i = 0; i < 4; ++i) v[i] = *reinterpret_cast<const float4*>(xp + i * 256 + F.lane * 4);
#pragma unroll
        for (int i = 0; i < 4; ++i) { const int e0 = i * 256 + F.lane * 4; gA[i] = *reinterpret_cast<const float4*>(gn + e0); shA[i] = *reinterpret_cast<const float4*>(mb + e0); scA[i] = *reinterpret_cast<const float4*>(mb + 1024 + e0); }
#pragma unroll
        for (int i = 0; i < 4; ++i) ss += v[i].x * v[i].x + v[i].y * v[i].y + v[i].z * v[i].z + v[i].w * v[i].w;
        ss = wave_sum(ss);
        const float rstd = rsqrtf(ss * (1.f / D) + EPS);
        float lg[16];
#pragma unroll
        for (int e = 0; e < 16; ++e) lg[e] = 0.f;
#pragma unroll
        for (int i = 0; i < 4; ++i) {
            const int e0 = i * 256 + F.lane * 4;
            const float4 g = gA[i], sh = shA[i], sc = scA[i];
            float hv[4];
            hv[0] = v[i].x * rstd * g.x * (1.f + sc.x) + sh.x; hv[1] = v[i].y * rstd * g.y * (1.f + sc.y) + sh.y;
            hv[2] = v[i].z * rstd * g.z * (1.f + sc.z) + sh.z; hv[3] = v[i].w * rstd * g.w * (1.f + sc.w) + sh.w;
            { unsigned w = 0u; w = __builtin_amdgcn_cvt_pk_fp8_f32(__builtin_amdgcn_fmed3f(hv[0], -448.f, 448.f), __builtin_amdgcn_fmed3f(hv[1], -448.f, 448.f), w, false);
              w = __builtin_amdgcn_cvt_pk_fp8_f32(__builtin_amdgcn_fmed3f(hv[2], -448.f, 448.f), __builtin_amdgcn_fmed3f(hv[3], -448.f, 448.f), w, true);
              H8w[((size_t)r * D + e0) >> 2] = w; }
#pragma unroll
            for (int e = 0; e < 16; ++e) { const float4 w4 = *reinterpret_cast<const float4*>(rw + e * 1024 + e0); lg[e] += hv[0] * w4.x + hv[1] * w4.y + hv[2] * w4.z + hv[3] * w4.w; }
            __builtin_amdgcn_sched_barrier(0);
        }
        float r8[8], r4[4], r2[2], r1;
        { const bool up = (F.lane & 32) != 0;
#pragma unroll
          for (int i = 0; i < 8; ++i) { const float keep = up ? lg[8 + i] : lg[i], give = up ? lg[i] : lg[8 + i]; r8[i] = keep + __shfl_xor(give, 32, 64); } }
        { const bool up = (F.lane & 16) != 0;
#pragma unroll
          for (int i = 0; i < 4; ++i) { const float keep = up ? r8[4 + i] : r8[i], give = up ? r8[i] : r8[4 + i]; r4[i] = keep + __shfl_xor(give, 16, 64); } }
        { const bool up = (F.lane & 8) != 0;
#pragma unroll
          for (int i = 0; i < 2; ++i) { const float keep = up ? r4[2 + i] : r4[i], give = up ? r4[i] : r4[2 + i]; r2[i] = keep + __shfl_xor(give, 8, 64); } }
        { const bool up = (F.lane & 4) != 0; const float keep = up ? r2[1] : r2[0], give = up ? r2[0] : r2[1]; r1 = keep + __shfl_xor(give, 4, 64); }
        r1 += __shfl_xor(r1, 1, 64); r1 += __shfl_xor(r1, 2, 64);
        float mx = r1;
#pragma unroll
        for (int o = 4; o < 64; o <<= 1) mx = fmaxf(mx, __shfl_xor(mx, o, 64));
        const float pe = expf(r1 - mx);
        float se = pe;
#pragma unroll
        for (int o = 4; o < 64; o <<= 1) se += __shfl_xor(se, o, 64);
        if ((F.lane & 3) == 0) {
            const int e = ((F.lane >> 5) & 1) * 8 + ((F.lane >> 4) & 1) * 4 + ((F.lane >> 3) & 1) * 2 + ((F.lane >> 2) & 1);
            const float a = pe / se;
            if (t < CTX) affc[((size_t)(b * NEXP + e)) * CTX + t] = a; else affl[((size_t)(b * NEXP + e)) * SEQL + (t - CTX)] = a;
        }
    }
}
__device__ __forceinline__ int block_exscan(int v, int* tmp, int& total) {
    const int tid_ = TIDX, lane = tid_ & 63, w = tid_ >> 6;
    int inc = v;
#pragma unroll
    for (int o = 1; o < 64; o <<= 1) { const int t = __shfl_up(inc, o, 64); if (lane >= o) inc += t; }
    __syncthreads();
    if (lane == 63) tmp[w] = inc;
    __syncthreads();
    int base = 0, tot = 0;
#pragma unroll
    for (int i = 0; i < 8; ++i) { const int x = tmp[i]; if (i < w) base += x; tot += x; }
    total = tot;
    return base + inc - v;
}
__device__ __forceinline__ void topk_select(const Ctx& F, const float* __restrict__ aff, int n, int cap, int* __restrict__ rows_out, float* __restrict__ gate_out,
                                            int* __restrict__ slot_out, int rowbase, int padTo) {
    int* hist = (int*)F.lds; int* sh = hist + 4096; int* tmp = sh + 8;
    unsigned key[32];
#pragma unroll
    for (int q = 0; q < 8; ++q) {
        const int i = F.tid * 32 + q * 4;
        u32x4 v = {0u, 0u, 0u, 0u};
        if (i < n) v = *reinterpret_cast<const u32x4*>(aff + i);
        key[q * 4 + 0] = v[0]; key[q * 4 + 1] = v[1]; key[q * 4 + 2] = v[2]; key[q * 4 + 3] = v[3];
    }
    unsigned prefix = 0u; int k = cap;
#pragma unroll 1
    for (int pass = 0; pass < 3; ++pass) {
        const int shift = (pass == 0) ? 20 : (pass == 1 ? 10 : 0), nb = (pass == 0) ? 4096 : 1024, pb = nb >> 9;
        __syncthreads();
        for (int b = F.tid; b < nb; b += NTHR) hist[b] = 0;
        __syncthreads();
#pragma unroll
        for (int j = 0; j < 32; ++j) { const bool in = (pass == 0) || ((key[j] >> (shift + 10)) == prefix); if (in) atomicAdd(&hist[(key[j] >> shift) & (unsigned)(nb - 1)], 1); }
        __syncthreads();
        int mysum = 0;
        for (int b = 0; b < pb; ++b) mysum += hist[F.tid * pb + b];
        int total; const int below = block_exscan(mysum, tmp, total);
        const int above0 = total - below - mysum;
        if (above0 < k && k <= above0 + mysum) {
            int above = above0, d = F.tid * pb + pb - 1;
            for (; d > F.tid * pb; --d) { const int c = hist[d]; if (above + c >= k) break; above += c; }
            sh[0] = d; sh[1] = k - above;
        }
        __syncthreads();
        prefix = (prefix << ((pass == 0) ? 12 : 10)) | (unsigned)sh[0]; k = sh[1];
    }
    const unsigned T = prefix;
    int cgt = 0, ceq = 0;
#pragma unroll
    for (int j = 0; j < 32; ++j) { cgt += (key[j] > T) ? 1 : 0; ceq += (key[j] == T) ? 1 : 0; }
    int tot; const int eq_before = block_exscan(ceq, tmp, tot);
    int take = k - eq_before; take = take < 0 ? 0 : (take > ceq ? ceq : take);
    int slot = block_exscan(cgt + take, tmp, tot);
#pragma unroll
    for (int j = 0; j < 32; ++j) {
        const int i = F.tid * 32 + j;
        bool sel = key[j] > T;
        if (key[j] == T && take > 0) { sel = true; --take; }
        if (i < n) {
            if (sel) { rows_out[slot] = rowbase + i; gate_out[slot] = __uint_as_float(key[j]); slot_out[i] = slot; ++slot; }
            else slot_out[i] = -1;
        }
    }
    for (int s2 = cap + F.tid; s2 < padTo; s2 += NTHR) { rows_out[s2] = rowbase; gate_out[s2] = 0.f; }
}
__device__ __forceinline__ void ph_topk(const Ctx& F, bool need_ctx) {
    int* rows = (int*)(F.ws + WS_ROWS); float* gv = (float*)(F.ws + WS_GATEV);
    const int nprob = NB * NEXP * (need_ctx ? 2 : 1);
    for (int p = F.bid; p < nprob; p += F.G) {
        if (p < NB * NEXP) { const int b = p / NEXP;
            topk_select(F, (const float*)(F.ws + WS_AFFL) + (size_t)p * SEQL, SEQL, CAPL, rows + p * CAPL, gv + p * CAPL, (int*)(F.ws + WS_SLOTL) + (size_t)p * SEQL, b * NTOK + CTX, CAPL);
        } else { const int q = p - NB * NEXP, b = q / NEXP;
            topk_select(F, (const float*)(F.ws + WS_AFFC) + (size_t)q * CTX, CTX, CAPC, rows + NB * NEXP * CAPL + q * 256, gv + NB * NEXP * CAPL + q * 256, (int*)(F.ws + WS_SLOTC) + (size_t)q * CTX, b * NTOK, 256);
        }
    }
}
__device__ __forceinline__ void ph_gather(const Ctx& F, const bf16* __restrict__ H, bf16* __restrict__ XG, int nflat) {
    const int* rows = (const int*)(F.ws + WS_ROWS);
    for (int f = F.bid * 8 + F.wave; f < nflat; f += F.G * 8) {
        const u32x4* s = reinterpret_cast<const u32x4*>(H + (size_t)rows[f] * D);
        u32x4* d = reinterpret_cast<u32x4*>(XG + (size_t)f * D);
        d[F.lane] = s[F.lane]; d[64 + F.lane] = s[64 + F.lane];
    }
}
__device__ __forceinline__ bool moe_unit(int bid, int G, int i, int nN, int nrt, int& rt, int& pn) {
    if ((G & 7) != 0 || (nN & 3) != 0) { const int t = bid + i * G; if (t >= nrt * nN) return false; rt = t / nN; pn = t - rt * nN; return true; }
    const int x = bid & 7, lb = bid >> 3, W = G >> 3, v = lb + i * W;
    const int per_g = 8 * nN, nlat = 4 * per_g;
    if (v < nlat) { const int gl = v / per_g, rem = v - gl * per_g, pnb = rem >> 5, r2 = rem & 31; rt = (x + 8 * gl) * 8 + (r2 >> 2); pn = pnb * 4 + (r2 & 3); return true; }
    const int w = v - nlat, nct = (nrt > 256) ? 4 : 0;
    if (w >= nct * nN) return false;
    const int c = w / nN; rt = 256 + x + 8 * c; pn = w - c * nN; return true;
}
struct MoeSched {
    const char* A; const char* W; size_t wsub; int nN, nrt, bid, G; size_t rowb;
    __device__ __forceinline__ bool get(int i, GUnit& u) const {
        int rt, pn; if (!moe_unit(bid, G, i, nN, nrt, rt, pn)) return false;
        const int e = (rt < 256) ? ((rt >> 3) & 15) : ((rt - 256) & 15);
        u.a = A + (size_t)rt * 256 * rowb; u.b = W + (size_t)e * 3072 * rowb + wsub + (size_t)pn * 256 * rowb; u.id = rt * nN + pn; return true; }
};
struct EpiMoeUp { unsigned char* HID;
    __device__ __forceinline__ bool operator()(Acc& acc, int t) const {
        const int brow = (t / 8) * 256, bcol = (t % 8) * 256;
        const int _t = opaque_tid(), _w = _t >> 6, _l = _t & 63, _wr = _w >> 2, _wc = _w & 3, _fr = _l & 15, _fq = _l >> 4;
#pragma unroll
        for (int ai = 0; ai < 2; ++ai)
#pragma unroll
            for (int m = 0; m < 4; ++m) {
                const int row = brow + ai * 128 + _wr * 64 + m * 16 + _fr, f = bcol / 2 + _wc * 32 + _fq * 8;
                unsigned w2[2];
#pragma unroll
                for (int bj = 0; bj < 2; ++bj) {
                    const f32x4 a = acc[ai][bj][m][0] * 0.03125f, g = acc[ai][bj][m][1] * 0.03125f;
                    float h[4];
#pragma unroll
                    for (int j = 0; j < 4; ++j) h[j] = __builtin_amdgcn_fmed3f(silu_fast(a[j]) * g[j], -448.f, 448.f);
                    unsigned w = 0u; w = __builtin_amdgcn_cvt_pk_fp8_f32(h[0], h[1], w, false); w = __builtin_amdgcn_cvt_pk_fp8_f32(h[2], h[3], w, true);
                    w2[bj] = w;
                }
                const u32x2 ww = {w2[0], w2[1]};
                *reinterpret_cast<u32x2*>(HID + (size_t)row * D + f) = ww;
            }
        return true; } };
struct EpiMoeDown { bf16* Y; const float* gate;
    __device__ __forceinline__ bool operator()(Acc& acc, int t) const {
        const int brow = (t / 4) * 256, bcol = (t % 4) * 256;
        const int _t = opaque_tid(), _w = _t >> 6, _l = _t & 63, _wr = _w >> 2, _wc = _w & 3, _fr = _l & 15, _fq = _l >> 4;
        const float* gp = gate + brow + _wr * 64 + _fr;
        float g8[2][4];
#pragma unroll
        for (int ai = 0; ai < 2; ++ai)
#pragma unroll
            for (int m = 0; m < 4; ++m) g8[ai][m] = gp[ai * 128 + m * 16] * 0.03125f;
        bf16* dst = Y + (size_t)(brow + _wr * 64) * D + bcol + _wc * 64;
#pragma unroll
        for (int ai = 0; ai < 2; ++ai)
#pragma unroll
            for (int m = 0; m < 4; ++m) {
                const float g = g8[ai][m];
                store_rows_bf16(dst + (size_t)(ai * 128 + m * 16) * D, D, _fr, _fq, acc[ai][0][m][0] * g, acc[ai][0][m][1] * g, acc[ai][1][m][0] * g, acc[ai][1][m][1] * g);
                __builtin_amdgcn_sched_barrier(0);
            }
        return true; } };
struct MoeGSched {
    const char* A; const char* W; const int* rowidx; int nN, nrt, bid, G; size_t rowb;
    __device__ __forceinline__ bool get(int i, GUnit& u) const {
        int rt, pn; if (!moe_unit(bid, G, i, nN, nrt, rt, pn)) return false;
        const int e = (rt < 256) ? ((rt >> 3) & 15) : ((rt - 256) & 15);
        u.a = A; u.b = W + (size_t)e * 3072 * rowb + (size_t)pn * 256 * rowb; u.id = rt * nN + pn; return true; }
    __device__ __forceinline__ const int* rows(const GUnit& u) const { return rowidx + (u.id / nN) * 256; }
};
__device__ __forceinline__ void ph_moe_up(const Ctx& F, const unsigned char* H8, const unsigned char* EXPW8, unsigned char* HID8, int nrt) {
    MoeGSched S; S.A = (const char*)H8; S.W = (const char*)EXPW8; S.rowidx = (const int*)(F.ws + WS_ROWS); S.nN = 8; S.nrt = nrt; S.bid = F.bid; S.G = F.G; S.rowb = 1024;
    const EpiMoeUp E{HID8};
    gemm_phase<true, MoeGSched, EpiMoeUp, true, true>(F.lds, 512, 512, 512, S, E);
}
__device__ __forceinline__ void ph_moe_down(const Ctx& F, const unsigned char* HID8, const unsigned char* EXPW8, bf16* Y, int nrt) {
    MoeSched S; S.A = (const char*)HID8; S.W = (const char*)EXPW8; S.wsub = (size_t)2048 * 1024; S.nN = 4; S.nrt = nrt; S.bid = F.bid; S.G = F.G; S.rowb = 1024;
    const EpiMoeDown E{Y, (const float*)(F.ws + WS_GATEV)};
    gemm_phase<true, MoeSched, EpiMoeDown, false, true, true>(F.lds, 512, 512, 512, S, E);
}
__device__ __forceinline__ void ph_moe_combine(const Ctx& F, int layer, const bf16* __restrict__ Y, bool need_ctx, int next_layer, bf16* __restrict__ H) {
    const int* slotl = (const int*)(F.ws + WS_SLOTL); const int* slotc = (const int*)(F.ws + WS_SLOTC);
    for (int r = F.bid * 8 + F.wave; r < MALL; r += F.G * 8) {
        const int b = r / NTOK, t = r - b * NTOK;
        if (!need_ctx && t < CTX) continue;
        float acc[16];
#pragma unroll
        for (int i = 0; i < 16; ++i) acc[i] = 0.f;
        int flatv = -1;
        if (F.lane < NEXP) {
            if (t < CTX) { const int s = slotc[(size_t)(b * NEXP + F.lane) * CTX + t]; flatv = (s < 0) ? -1 : NB * NEXP * CAPL + (b * NEXP + F.lane) * 256 + s; }
            else { const int s = slotl[(size_t)(b * NEXP + F.lane) * SEQL + (t - CTX)]; flatv = (s < 0) ? -1 : (b * NEXP + F.lane) * CAPL + s; }
        }
        float* xp = xrow(F, r) + F.lane * 4;
        float4 xv[4];
#pragma unroll
        for (int i = 0; i < 4; ++i) xv[i] = *reinterpret_cast<const float4*>(xp + i * 256);
        unsigned long long mask = __ballot(flatv >= 0);
        while (mask) {
            const int e0 = __builtin_ctzll(mask); mask &= mask - 1;
            const bool two = mask != 0ull;
            const int e1 = two ? __builtin_ctzll(mask) : e0; if (two) mask &= mask - 1;
            const int f0 = __shfl(flatv, e0, 64), f1 = __shfl(flatv, e1, 64);
            const u32x2* yp0 = reinterpret_cast<const u32x2*>(Y + (size_t)f0 * D + F.lane * 4);
            const u32x2* yp1 = reinterpret_cast<const u32x2*>(Y + (size_t)f1 * D + F.lane * 4);
            u32x2 a[4], c[4];
#pragma unroll
            for (int i = 0; i < 4; ++i) { a[i] = yp0[i * 64]; c[i] = yp1[i * 64]; }
            const float w1 = two ? 1.f : 0.f;
#pragma unroll
            for (int i = 0; i < 4; ++i) {
                acc[i * 4 + 0] += __uint_as_float(a[i][0] << 16) + w1 * __uint_as_float(c[i][0] << 16); acc[i * 4 + 1] += __uint_as_float(a[i][0] & 0xffff0000u) + w1 * __uint_as_float(c[i][0] & 0xffff0000u);
                acc[i * 4 + 2] += __uint_as_float(a[i][1] << 16) + w1 * __uint_as_float(c[i][1] << 16); acc[i * 4 + 3] += __uint_as_float(a[i][1] & 0xffff0000u) + w1 * __uint_as_float(c[i][1] & 0xffff0000u);
            }
        }
        const int ms = (t < CTX) ? 2 : b;
        const float* g2 = (const float*)(F.ws + WS_MODS) + ((size_t)layer * 3 + ms) * 6144 + 5120 + F.lane * 4;
        float ss = 0.f;
#pragma unroll
        for (int i = 0; i < 4; ++i) {
            float4 x = xv[i]; const float4 g = *reinterpret_cast<const float4*>(g2 + i * 256);
            x.x += g.x * acc[i * 4 + 0]; x.y += g.y * acc[i * 4 + 1]; x.z += g.z * acc[i * 4 + 2]; x.w += g.w * acc[i * 4 + 3];
            *reinterpret_cast<float4*>(xp + i * 256) = x;
            xv[i] = x;
            ss += x.x * x.x + x.y * x.y + x.z * x.z + x.w * x.w;
        }
        if (next_layer >= 0) {
            ss = wave_sum(ss);
            const float rstd = rsqrtf(ss * (1.f / D) + EPS);
            const float* gn = F.in[I_NMG] + next_layer * D + F.lane * 4;
            const float* mb = (const float*)(F.ws + WS_MODS) + ((size_t)next_layer * 3 + ms) * 6144 + F.lane * 4;
            bf16* hp = H + (size_t)r * D + F.lane * 4;
#pragma unroll
            for (int i = 0; i < 4; ++i) {
                const float4 g = *reinterpret_cast<const float4*>(gn + i * 256), sh = *reinterpret_cast<const float4*>(mb + i * 256), sc = *reinterpret_cast<const float4*>(mb + 1024 + i * 256);
                const float4 x = xv[i];
                u32x2 w = {cvtpk(x.x * rstd * g.x * (1.f + sc.x) + sh.x, x.y * rstd * g.y * (1.f + sc.y) + sh.y), cvtpk(x.z * rstd * g.z * (1.f + sc.z) + sh.z, x.w * rstd * g.w * (1.f + sc.w) + sh.w)};
                *reinterpret_cast<u32x2*>(hp + i * 256) = w;
            }
        }
    }
}

struct RetC { const float* tab;
    __device__ __forceinline__ float lg2(int dir, int h) const { return tab[dir * 4 + h]; } };
__device__ __forceinline__ RetC ret_consts(const Ctx& F) { RetC c; c.tab = (const float*)(F.ws + WS_RETC); return c; }
struct EpiRetIn { bf16 *Q, *KR, *KFT, *KBT, *VT, *SG; RetC rc; const float* rope;
    __device__ __forceinline__ bool operator()(Acc& acc, int t) const {
        const int pm = t / 24, pn = t - pm * 24, brow = pm * 256;
        const int b = brow / NTOK, tt0 = brow - b * NTOK;
        const int _t = opaque_tid(), _w = _t >> 6, _l = _t & 63, _wr = _w >> 2, _wc = _w & 3, _fr = _l & 15, _fq = _l >> 4;
        if (pn < 8) {
            const bool isk = pn >= 4; const int h = pn & 3;
            if (isk) {
#pragma unroll
                for (int ai = 0; ai < 2; ++ai) for (int bj = 0; bj < 2; ++bj) for (int m = 0; m < 4; ++m) for (int n = 0; n < 2; ++n) acc[ai][bj][m][n] *= 0.0625f;
            }
            if (tt0 >= CTX) {
                const float* rbase = rope + ((size_t)(tt0 - CTX + _wr * 64 + _fr) * 128 + _wc * 32 + 4 * _fq) * 2;
                f32x4 rc_[4], rn_[4] = {};
                { const f32x4* tp = reinterpret_cast<const f32x4*>(rbase); rc_[0] = tp[0]; rc_[1] = tp[1]; rc_[2] = tp[8]; rc_[3] = tp[9]; }
#pragma unroll
                for (int ai = 0; ai < 2; ++ai)
#pragma unroll
                    for (int m = 0; m < 4; ++m) {
                        if ((ai * 4 + m) < 7) { const int kn = ai * 4 + m + 1;
                            const f32x4* tp = reinterpret_cast<const f32x4*>(rbase + (size_t)((kn >> 2) * 128 + (kn & 3) * 16) * 256); rn_[0] = tp[0]; rn_[1] = tp[1]; rn_[2] = tp[8]; rn_[3] = tp[9]; }
#pragma unroll
                        for (int n = 0; n < 2; ++n) {
                            const f32x4 c01 = rc_[n * 2], c23 = rc_[n * 2 + 1];
                            const float cs[4] = {c01[0], c01[2], c23[0], c23[2]}, sn[4] = {c01[1], c01[3], c23[1], c23[3]};
#pragma unroll
                            for (int j = 0; j < 4; ++j) {
                                const float x1 = acc[ai][0][m][n][j], x2 = acc[ai][1][m][n][j];
                                acc[ai][0][m][n][j] = x1 * cs[j] - x2 * sn[j]; acc[ai][1][m][n][j] = x2 * cs[j] + x1 * sn[j];
                            }
                        }
#pragma unroll
                        for (int q = 0; q < 4; ++q) rc_[q] = rn_[q];
                        __builtin_amdgcn_sched_barrier(0);
                    }
            }
            bf16* dst = isk ? KR : Q;
            acc_foreach<true>(acc, [&](int row, int col4, f32x4 v) {
                u32x2 w = {cvtpk(v[0], v[1]), cvtpk(v[2], v[3])};
                *reinterpret_cast<u32x2*>(dst + (size_t)(brow + row) * D + h * 256 + col4) = w; });
            if (isk) {
                const float lf = rc.lg2(0, h), lb = rc.lg2(1, h);
                unsigned short* kft = (unsigned short*)KFT + (size_t)((b * 4 + h) * 256) * NTOK + tt0;
                unsigned short* kbt = (unsigned short*)KBT + (size_t)((b * 4 + h) * 256) * NTOK + tt0;
                acc_foreach<true>(acc, [&](int row, int col4, f32x4 v) {
                    const float wf = __builtin_amdgcn_exp2f((float)(RCH - 1 - row) * lf), wb = __builtin_amdgcn_exp2f((float)row * lb);
#pragma unroll
                    for (int j = 0; j < 4; ++j) { kft[(size_t)(col4 + j) * NTOK + row] = f2bf(v[j] * wf); kbt[(size_t)(col4 + j) * NTOK + row] = f2bf(v[j] * wb); } });
            }
        } else if (pn < 16) {
            const int h = (pn - 8) >> 1, e0 = ((pn - 8) & 1) * 256;
            unsigned short* vt = (unsigned short*)VT + (size_t)((b * 4 + h) * 512 + e0) * NTOK + tt0;
            acc_foreach<true>(acc, [&](int row, int col4, f32x4 v) {
#pragma unroll
                for (int j = 0; j < 4; ++j) vt[(size_t)(col4 + j) * NTOK + row] = f2bf(v[j]); });
        } else {
            const int c0 = (pn - 16) * 256;
            bf16* dst = SG + (size_t)(brow + _wr * 64) * 2048 + c0 + _wc * 64;
#pragma unroll
            for (int ai = 0; ai < 2; ++ai)
#pragma unroll
                for (int m = 0; m < 4; ++m) {
                    f32x4 s[2][2];
#pragma unroll
                    for (int bj = 0; bj < 2; ++bj)
#pragma unroll
                        for (int n = 0; n < 2; ++n)
#pragma unroll
                            for (int j = 0; j < 4; ++j) s[bj][n][j] = silu_fast(acc[ai][bj][m][n][j]);
                    store_rows_bf16(dst + (size_t)(ai * 128 + m * 16) * 2048, 2048, _fr, _fq, s[0][0], s[0][1], s[1][0], s[1][1]);
                    __builtin_amdgcn_sched_barrier(0);
                }
        }
        return true; } };
struct RetPSched { const char* Q; const char* K; int bid, G;
    __device__ __forceinline__ bool get(int i, GUnit& u) const {
        const int t = bid + i * G; if (t >= 8 * RNC) return false;
        const int bh = t / RNC, cc = t - bh * RNC, b = bh >> 2, h = bh & 3;
        const size_t off = ((size_t)(b * NTOK + cc * RCH) * D + h * 256) * 2;
        u.a = Q + off; u.b = K + off; u.id = t; return true; } };
struct EpiRetP { bf16* P; RetC rc;
    __device__ __forceinline__ bool operator()(Acc& acc, int t) const {
        const int bh = t / RNC, cc = t - bh * RNC, b = bh >> 2, h = bh & 3;
        const float lf = rc.lg2(0, h), lb = rc.lg2(1, h);
        const int _t = opaque_tid(), _w = _t >> 6, _l = _t & 63, _wr = _w >> 2, _wc = _w & 3, _fr = _l & 15, _fq = _l >> 4;
        bf16* dst = P + (size_t)(b * NTOK + cc * RCH + _wr * 64) * D + h * 256 + _wc * 64;
#pragma unroll
        for (int ai = 0; ai < 2; ++ai)
#pragma unroll
            for (int m = 0; m < 4; ++m) {
                const int row = ai * 128 + _wr * 64 + m * 16 + _fr;
                f32x4 o[2][2];
#pragma unroll
                for (int bj = 0; bj < 2; ++bj)
#pragma unroll
                    for (int n = 0; n < 2; ++n) {
                        const f32x4 v = acc[ai][bj][m][n];
#pragma unroll
                        for (int j = 0; j < 4; ++j) { const int d = row - (_wc * 64 + _fq * 16 + bj * 8 + n * 4 + j); o[bj][n][j] = v[j] * __builtin_amdgcn_exp2f(d >= 0 ? (float)d * lf : (float)(-d) * lb); }
                    }
                store_rows_bf16(dst + (size_t)(ai * 128 + m * 16) * D, D, _fr, _fq, o[0][0], o[0][1], o[1][0], o[1][1]);
                __builtin_amdgcn_sched_barrier(0);
            }
        return true; } };
struct RetSSched { const char* VT; const char* KFT; const char* KBT; int bid, G;
    __device__ __forceinline__ bool get(int i, GUnit& u) const {
        const int t = bid + i * G; if (t >= 2 * 8 * RNC * 2) return false;
        const int eh = t & 1, r = t >> 1, cc = r % RNC, q = r / RNC, bh = q & 7, dir = q >> 3;
        u.a = VT + ((size_t)(bh * 512 + eh * 256) * NTOK + cc * RCH) * 2;
        u.b = (dir ? KBT : KFT) + ((size_t)(bh * 256) * NTOK + cc * RCH) * 2; u.id = t; return true; } };
struct EpiRetS { bf16* ST;
    __device__ __forceinline__ bool operator()(Acc& acc, int t) const {
        const int eh = t & 1, r = t >> 1, cc = r % RNC, q = r / RNC;
        const int _t = opaque_tid(), _w = _t >> 6, _l = _t & 63, _wr = _w >> 2, _wc = _w & 3, _fr = _l & 15, _fq = _l >> 4;
        bf16* dst = ST + ((size_t)(q * 512 + eh * 256 + _wr * 64)) * NTOK + cc * RCH + _wc * 64;
#pragma unroll
        for (int ai = 0; ai < 2; ++ai)
#pragma unroll
            for (int m = 0; m < 4; ++m) {
                store_rows_bf16(dst + (size_t)(ai * 128 + m * 16) * NTOK, NTOK, _fr, _fq, acc[ai][0][m][0], acc[ai][0][m][1], acc[ai][1][m][0], acc[ai][1][m][1]);
                __builtin_amdgcn_sched_barrier(0);
            }
        return true; } };
__device__ __forceinline__ void ph_ret_scan(const Ctx& F, bf16* ST, const RetC& rc) {
    const int nel = 2 * 8 * 512 * 256;
    for (int x = F.bid * NTHR + F.tid; x < nel; x += F.G * NTHR) {
        const int d = x & 255, e = (x >> 8) & 511, q = x >> 17, dir = q >> 3, h = q & 3;
        unsigned short* p = (unsigned short*)ST + ((size_t)(q * 512 + e)) * NTOK + d;
        const float Dk = __builtin_amdgcn_exp2f((float)RCH * rc.lg2(dir, h));
        unsigned short v[RNC];
#pragma unroll
        for (int cc = 0; cc < RNC; ++cc) v[cc] = p[cc * RCH];
        if (dir == 0) {
            float st = 0.f;
#pragma unroll
            for (int cc = 0; cc < RNC; ++cc) { const float s = bf2f(v[cc]); p[cc * RCH] = f2bf(st); st = Dk * st + s; }
        } else {
            float st = bf2f(v[0]); p[0] = 0;
#pragma unroll
            for (int cc = RNC - 1; cc >= 1; --cc) { const float s = bf2f(v[cc]); p[cc * RCH] = f2bf(st); st = Dk * st + s; }
        }
    }
}
struct RetOSched { const char* Q; const char* P; const char* ST; const char* VT; int bid, G, cnt;
    __device__ __forceinline__ bool get(int i, GUnit& u) const {
        const int ti = i / 3, s = i - ti * 3; const int t = bid + ti * G; if (t >= 8 * RNC * 2) return false;
        const int eh = t & 1, r = t >> 1, cc = r % RNC, bh = r / RNC, b = bh >> 2, h = bh & 3;
        const size_t qoff = ((size_t)(b * NTOK + cc * RCH) * D + h * 256) * 2;
        if (s < 2) { u.a = Q + qoff; u.b = ST + ((size_t)((s * 8 + bh) * 512 + eh * 256) * NTOK + cc * RCH) * 2; }
        else { u.a = P + qoff; u.b = VT + ((size_t)(bh * 512 + eh * 256) * NTOK + cc * RCH) * 2; }
        u.id = t * 3 + s; return true; } };
struct EpiRetO { bf16* O; RetC rc;
    __device__ __forceinline__ bool operator()(Acc& acc, int id) const {
        const int t = id / 3, s = id - t * 3;
        const int eh = t & 1, r = t >> 1, cc = r % RNC, bh = r / RNC, b = bh >> 2, h = bh & 3;
        const float lf = rc.lg2(0, h), lb = rc.lg2(1, h);
        const int _t = opaque_tid(), _w = _t >> 6, _l = _t & 63, _wr = _w >> 2, _fr = _l & 15;
#pragma unroll
        for (int ai = 0; ai < 2; ++ai)
#pragma unroll
            for (int m = 0; m < 4; ++m) {
                const int il = ai * 128 + _wr * 64 + m * 16 + _fr;
                const float xf = (float)(il + 1) * lf, xb = (float)(RCH - il) * lb;
                const float sc = __builtin_amdgcn_exp2f(s == 0 ? xf - xb : (s == 1 ? xb : 0.f));
#pragma unroll
                for (int bj = 0; bj < 2; ++bj)
#pragma unroll
                    for (int n = 0; n < 2; ++n) acc[ai][bj][m][n] *= sc;
            }
        if (s < 2) return false;
        const int _wc = _w & 3, _fq = _l >> 4;
        bf16* dst = O + (size_t)(b * NTOK + cc * RCH + _wr * 64) * 2048 + h * 512 + eh * 256 + _wc * 64;
#pragma unroll
        for (int ai = 0; ai < 2; ++ai)
#pragma unroll
            for (int m = 0; m < 4; ++m) {
                store_rows_bf16(dst + (size_t)(ai * 128 + m * 16) * 2048, 2048, _fr, _fq, acc[ai][0][m][0], acc[ai][0][m][1], acc[ai][1][m][0], acc[ai][1][m][1]);
                __builtin_amdgcn_sched_barrier(0);
            }
        return true; } };
__device__ __forceinline__ void ph_ret_gate(const Ctx& F, bf16* __restrict__ O, const bf16* __restrict__ SG) {
    const float* gng = F.in[I_RGN] + F.lane * 8;
    const f32x4 ga = *reinterpret_cast<const f32x4*>(gng), gb = *reinterpret_cast<const f32x4*>(gng + 4);
    const float gn[8] = {ga[0], ga[1], ga[2], ga[3], gb[0], gb[1], gb[2], gb[3]};
    for (int r = F.bid * 8 + F.wave; r < MALL; r += F.G * 8) {
        u32x4* op = reinterpret_cast<u32x4*>(O + (size_t)r * 2048 + F.lane * 8);
        const u32x4* gp = reinterpret_cast<const u32x4*>(SG + (size_t)r * 2048 + F.lane * 8);
        u32x4 ov[4], gv[4];
#pragma unroll
        for (int h = 0; h < 4; ++h) { ov[h] = op[h * 64]; gv[h] = gp[h * 64]; }
#pragma unroll
        for (int h = 0; h < 4; ++h) {
            float x[8]; float ss = 0.f;
#pragma unroll
            for (int q = 0; q < 4; ++q) { x[2 * q] = __uint_as_float(ov[h][q] << 16); x[2 * q + 1] = __uint_as_float(ov[h][q] & 0xffff0000u); ss += x[2 * q] * x[2 * q] + x[2 * q + 1] * x[2 * q + 1]; }
            ss = wave_sum(ss);
            const float rstd = rsqrtf(ss * (1.f / 512.f) + EPS);
            u32x4 w;
#pragma unroll
            for (int q = 0; q < 4; ++q) w[q] = cvtpk(x[2 * q] * rstd * gn[2 * q] * __uint_as_float(gv[h][q] << 16), x[2 * q + 1] * rstd * gn[2 * q + 1] * __uint_as_float(gv[h][q] & 0xffff0000u));
            op[h * 64] = w;
        }
    }
}

__device__ __forceinline__ void hy_features(const Ctx& F, int n, bf16* A2P, float* A2C) {
    const float* w1 = F.in[I_HW1]; const float* b1 = F.in[I_HB1]; const float* w2 = F.in[I_HW2]; const float* b2 = F.in[I_HB2]; const float* fr = F.in[I_HFREQ];
    const int j = F.lane;
    for (int t = F.bid * 8 + F.wave; t < n; t += F.G * 8) {
        const float tn = (float)t / (float)(n - 1), w = 6.283185307179586f * (float)t / (float)n;
        float s = tn * w1[j] + b1[j];
        const float fl = 1e-4f + (float)(j & 15) * ((15.f - 1e-4f) / 15.f);
        const float csv = (j & 16) ? sinf(fl * w) : cosf(fl * w);
#pragma unroll
        for (int k = 0; k < 16; ++k) s += __shfl(csv, k, 64) * w1[(1 + k) * 64 + j] - __shfl(csv, 16 + k, 64) * w1[(17 + k) * 64 + j];
        const float a1 = sinf(fr[j] * s);
        float s2 = b2[j];
        for (int i = 0; i < 64; ++i) s2 += __shfl(a1, i, 64) * w2[i * 64 + j];
        const float a2 = sinf(fr[64 + j] * s2);
        if (A2C) A2C[t * 64 + j] = a2;
        else { const unsigned short hi = f2bf(a2), lo = f2bf(a2 - bf2f(hi)); unsigned short* p = (unsigned short*)A2P + (size_t)t * 256;
            p[j] = hi; p[64 + j] = lo; p[128 + j] = hi; p[192 + j] = 0; }
    }
}
__device__ __forceinline__ void hy_prologue(const Ctx& F) {
    hy_features(F, FN, (bf16*)(F.ws + WS_A2P), nullptr);
    hy_features(F, CTX, nullptr, (float*)(F.ws + WS_A2C));
    unsigned short* w3p = (unsigned short*)(F.ws + WS_W3P);
    for (int i = F.bid * NTHR + F.tid; i < 4096 * 64; i += F.G * NTHR) {
        const int k = i >> 12, col = i & 4095; const float w = F.in[I_HW3][i];
        const unsigned short hi = f2bf(w), lo = f2bf(w - bf2f(hi)); unsigned short* p = w3p + (size_t)col * 256;
        p[k] = hi; p[64 + k] = hi; p[128 + k] = lo; p[192 + k] = 0; }
}
struct EpiHyIn { bf16* PT; const float* bin;
    __device__ __forceinline__ bool operator()(Acc& acc, int t) const {
        const int brow = (t / 12) * 256, bcol = (t % 12) * 256;
        acc_foreach<false>(acc, [&](int row4, int col, f32x4 v) {
            const float bs = bin[bcol + col];
            u32x2 w = {cvtpk(v[0] + bs, v[1] + bs), cvtpk(v[2] + bs, v[3] + bs)};
            *reinterpret_cast<u32x2*>(PT + (size_t)(bcol + col) * MALL + brow + row4) = w; });
        return true; } };
struct EpiHyTaps { bf16* HT;
    __device__ __forceinline__ bool operator()(Acc& acc, int t) const {
        const int brow = (t / 64) * 256, bcol = (t % 64) * 256;
        const int _t = opaque_tid(), _w = _t >> 6, _l = _t & 63, _wr = _w >> 2, _wc = _w & 3, _fr = _l & 15, _fq = _l >> 4;
        bf16* dst = HT + (size_t)(brow + _wr * 64) * FN + bcol + _wc * 64;
#pragma unroll
        for (int ai = 0; ai < 2; ++ai)
#pragma unroll
            for (int m = 0; m < 4; ++m) {
                const int c = (brow + ai * 128 + _wr * 64 + m * 16 + _fr) & 1023;
                const float delta = fabsf(-3.0701134573253944f + (-15.350567286626972f + 3.0701134573253944f) * ((float)c * (1.f / 1023.f)));
                f32x4 o[2][2];
#pragma unroll
                for (int bj = 0; bj < 2; ++bj)
#pragma unroll
                    for (int n = 0; n < 2; ++n)
#pragma unroll
                        for (int j = 0; j < 4; ++j) o[bj][n][j] = acc[ai][bj][m][n][j] * __expf(-(float)(bcol + _wc * 64 + _fq * 16 + bj * 8 + n * 4 + j) * (1.f / (float)(FN - 1)) * delta);
                store_rows_bf16(dst + (size_t)(ai * 128 + m * 16) * FN, FN, _fr, _fq, o[0][0], o[0][1], o[1][0], o[1][1]);
                __builtin_amdgcn_sched_barrier(0);
            }
        return true; } };

__device__ __forceinline__ int fphys(int i) { return i + ((i >> 5) << 1); }
constexpr int FFT_LDS = (FN + 2 * (FN / 32)) * 8;
__device__ __forceinline__ float2 cmul(float2 a, float2 b) { return make_float2(a.x * b.x - a.y * b.y, a.x * b.y + a.y * b.x); }
__device__ __forceinline__ float2 cmulc(float2 a, float2 b) { return make_float2(a.x * b.x + a.y * b.y, a.y * b.x - a.x * b.y); }
__device__ __forceinline__ float2 unitrev(float x) { return make_float2(__builtin_amdgcn_cosf(x), __builtin_amdgcn_sinf(x)); }
template <int L, bool INV> __device__ __forceinline__ void bfly(float2 (&x)[1 << L]) {
    constexpr int n = 1 << L;
    constexpr float C32[16] = {1.000000000e+00f, 9.807852804e-01f, 9.238795325e-01f, 8.314696123e-01f, 7.071067812e-01f, 5.555702330e-01f, 3.826834324e-01f, 1.950903220e-01f, 6.123233996e-17f, -1.950903220e-01f, -3.826834324e-01f, -5.555702330e-01f, -7.071067812e-01f, -8.314696123e-01f, -9.238795325e-01f, -9.807852804e-01f};
    constexpr float S32[16] = {0.000000000e+00f, 1.950903220e-01f, 3.826834324e-01f, 5.555702330e-01f, 7.071067812e-01f, 8.314696123e-01f, 9.238795325e-01f, 9.807852804e-01f, 1.000000000e+00f, 9.807852804e-01f, 9.238795325e-01f, 8.314696123e-01f, 7.071067812e-01f, 5.555702330e-01f, 3.826834324e-01f, 1.950903220e-01f};
    if (!INV) {
#pragma unroll
        for (int j = L - 1; j >= 0; --j) {
#pragma unroll
            for (int k = 0; k < n; ++k) if (!(k & (1 << j))) {
                const int e = ((k & ((1 << j) - 1)) << (L - 1 - j)) * (32 / n);
                const float2 a = x[k], b = x[k + (1 << j)];
                x[k] = make_float2(a.x + b.x, a.y + b.y);
                const float2 d = make_float2(a.x - b.x, a.y - b.y);
                if (e == 0) x[k + (1 << j)] = d;
                else if (e == 8) x[k + (1 << j)] = make_float2(d.y, -d.x);
                else x[k + (1 << j)] = make_float2(d.x * C32[e] + d.y * S32[e], d.y * C32[e] - d.x * S32[e]);
            }
        }
    } else {
#pragma unroll
        for (int j = 0; j < L; ++j) {
#pragma unroll
            for (int k = 0; k < n; ++k) if (!(k & (1 << j))) {
                const int e = ((k & ((1 << j) - 1)) << (L - 1 - j)) * (32 / n);
                const float2 a = x[k], b = x[k + (1 << j)];
                float2 t;
                if (e == 0) t = b;
                else if (e == 8) t = make_float2(-b.y, b.x);
                else t = make_float2(b.x * C32[e] - b.y * S32[e], b.y * C32[e] + b.x * S32[e]);
                x[k] = make_float2(a.x + t.x, a.y + t.y); x[k + (1 << j)] = make_float2(a.x - t.x, a.y - t.y);
            }
        }
    }
}
constexpr int rev_bits(int k, int L) { int r = 0; for (int j = 0; j < L; ++j) if (k & (1 << j)) r |= 1 << (L - 1 - j); return r; }
template <int L, bool INV> __device__ __forceinline__ void apply_tw(float2 (&x)[1 << L], int r, float inv_n) {
    float2 tw[L];
#pragma unroll
    for (int j = 0; j < L; ++j) tw[j] = unitrev((float)(r << j) * inv_n);
#pragma unroll
    for (int k = 1; k < (1 << L); ++k) {
#pragma unroll
        for (int j = 0; j < L; ++j) if ((rev_bits(k, L) >> j) & 1) x[k] = INV ? cmul(x[k], tw[j]) : cmulc(x[k], tw[j]);
    }
}
template <bool INV> __device__ __forceinline__ void fft_pass_a(float2* X, int tid) {
#pragma unroll 1
    for (int g = 0; g < 2; ++g) {
        const int r = tid + 512 * g; float2 x[16];
#pragma unroll
        for (int k = 0; k < 16; ++k) x[k] = X[fphys(r + k * 1024)];
        if (INV) { apply_tw<4, true>(x, r, 1.f / 16384.f); bfly<4, true>(x); }
        else { bfly<4, false>(x); apply_tw<4, false>(x, r, 1.f / 16384.f); }
#pragma unroll
        for (int k = 0; k < 16; ++k) X[fphys(r + k * 1024)] = x[k];
    }
}
template <bool INV> __device__ __forceinline__ void fft_pass_b(float2* X, int tid) {
    const int r = tid & 31, base = (tid >> 5) * 1024 + r; float2 x[32];
#pragma unroll
    for (int k = 0; k < 32; ++k) x[k] = X[fphys(base + k * 32)];
    if (INV) { apply_tw<5, true>(x, r, 1.f / 1024.f); bfly<5, true>(x); }
    else { bfly<5, false>(x); apply_tw<5, false>(x, r, 1.f / 1024.f); }
#pragma unroll
    for (int k = 0; k < 32; ++k) X[fphys(base + k * 32)] = x[k];
}
typedef _Float16 f16x2 __attribute__((ext_vector_type(2)));
__device__ __forceinline__ unsigned pack_h2(float2 v) { f16x2 h = {(_Float16)v.x, (_Float16)v.y}; return *reinterpret_cast<unsigned*>(&h); }
__device__ __forceinline__ float2 unpack_h2(unsigned u) { const f16x2 h = *reinterpret_cast<const f16x2*>(&u); return make_float2((float)h[0], (float)h[1]); }
template <class Gen> __device__ __forceinline__ void fwd_a(float2* X, Gen gen) {
    const int tid = opaque_tid();
#pragma unroll 1
    for (int g = 0; g < 2; ++g) {
        const int r = tid + 512 * g; float2 x[16];
#pragma unroll
        for (int k = 0; k < 16; ++k) x[k] = gen(r + k * 1024);
        bfly<4, false>(x); apply_tw<4, false>(x, r, 1.f / 16384.f);
#pragma unroll
        for (int k = 0; k < 16; ++k) X[fphys(r + k * 1024)] = x[k];
    }
}
template <class Out> __device__ __forceinline__ void inv_a(float2* X, Out out) {
    const int tid = opaque_tid();
#pragma unroll 1
    for (int g = 0; g < 2; ++g) {
        const int r = tid + 512 * g; float2 x[16];
#pragma unroll
        for (int k = 0; k < 16; ++k) x[k] = X[fphys(r + k * 1024)];
        apply_tw<4, true>(x, r, 1.f / 16384.f); bfly<4, true>(x);
        out(r, x);
    }
}
__device__ __forceinline__ void mid_c(float2* X, const unsigned* __restrict__ fs) {
    const int tid = opaque_tid();
    float2 x[32]; f32x4* p = reinterpret_cast<f32x4*>(X + fphys(tid * 32));
    const u32x4* fp = reinterpret_cast<const u32x4*>(fs + tid * 32);
    u32x4 fv[8];
#pragma unroll
    for (int k = 0; k < 8; ++k) fv[k] = fp[k];
#pragma unroll
    for (int k = 0; k < 16; ++k) { const f32x4 v = p[k]; x[2 * k] = make_float2(v[0], v[1]); x[2 * k + 1] = make_float2(v[2], v[3]); }
    bfly<5, false>(x);
#pragma unroll
    for (int k = 0; k < 32; ++k) x[k] = cmul(x[k], unpack_h2(fv[k >> 2][k & 3]));
    bfly<5, true>(x);
#pragma unroll
    for (int k = 0; k < 16; ++k) { f32x4 v = {x[2 * k].x, x[2 * k].y, x[2 * k + 1].x, x[2 * k + 1].y}; p[k] = v; }
}
__device__ __forceinline__ void spec_c(float2* X, unsigned* __restrict__ fs, float scl) {
    const int tid = opaque_tid();
    float2 x[32]; const f32x4* p = reinterpret_cast<const f32x4*>(X + fphys(tid * 32));
#pragma unroll
    for (int k = 0; k < 16; ++k) { const f32x4 v = p[k]; x[2 * k] = make_float2(v[0], v[1]); x[2 * k + 1] = make_float2(v[2], v[3]); }
    bfly<5, false>(x);
    u32x4* fp = reinterpret_cast<u32x4*>(fs + tid * 32);
#pragma unroll
    for (int k = 0; k < 8; ++k) { u32x4 w;
#pragma unroll
        for (int j = 0; j < 4; ++j) w[j] = pack_h2(make_float2(x[4 * k + j].x * scl, x[4 * k + j].y * scl));
        fp[k] = w; }
}
__device__ __forceinline__ void fwd_b(float2* X) { fft_pass_b<false>(X, opaque_tid()); }
__device__ __forceinline__ void inv_b(float2* X) { fft_pass_b<true>(X, opaque_tid()); }

__device__ __forceinline__ float block_sum(float v, float* red) {
    v = wave_sum(v);
    __syncthreads();
    { const int tid_ = TIDX; if ((tid_ & 63) == 0) red[tid_ >> 6] = v; }
    __syncthreads();
    float s = 0.f;
#pragma unroll
    for (int i = 0; i < 8; ++i) s += red[i];
    return s;
}
__device__ __forceinline__ float sconv(const unsigned short* __restrict__ p, int t, int n, float w0, float w1, float w2, float cb) {
    const float a = (t > 0) ? bf2f(p[t - 1]) : 0.f, b = bf2f(p[t]), c = (t < n - 1) ? bf2f(p[t + 1]) : 0.f;
    return a * w0 + b * w1 + c * w2 + cb;
}
__device__ __forceinline__ void hy_stage_conv(const Ctx& F, const bf16* __restrict__ PT, int ch, unsigned* __restrict__ dst) {
    unsigned short* rows = (unsigned short*)F.lds;
    const float w0 = F.in[I_HCW][ch], w1 = F.in[I_HCW][3072 + ch], w2 = F.in[I_HCW][6144 + ch], cb = F.in[I_HCB][ch];
    __syncthreads();
#pragma unroll
    for (int b = 0; b < 2; ++b) {
        const u32x4* s = reinterpret_cast<const u32x4*>(PT + (size_t)ch * MALL + b * NTOK + CTX);
        u32x4* d = reinterpret_cast<u32x4*>(rows + b * (FN + 16) + 8);
#pragma unroll
        for (int k = 0; k < 4; ++k) d[F.tid + 512 * k] = s[F.tid + 512 * k];
        if (F.tid == 0) { rows[b * (FN + 16) + 7] = 0; rows[b * (FN + 16) + 8 + FN] = 0; }
    }
    __syncthreads();
#pragma unroll 4
    for (int k = 0; k < 32; ++k) { const int i = F.tid + 512 * k;
        const unsigned short* r0 = rows + 8 + i; const unsigned short* r1 = r0 + (FN + 16);
        dst[i] = pack_h2(make_float2(bf2f(r0[-1]) * w0 + bf2f(r0[0]) * w1 + bf2f(r0[1]) * w2 + cb, bf2f(r1[-1]) * w0 + bf2f(r1[0]) * w1 + bf2f(r1[1]) * w2 + cb)); }
    __syncthreads();
}
__device__ __forceinline__ void hyena_channel_latent(const Ctx& F, int c, const bf16* __restrict__ PT, const bf16* __restrict__ HT, bf16* __restrict__ ZT, unsigned* __restrict__ WG) {
    float2* X = (float2*)F.lds; float* red = (float*)(F.lds + FFT_LDS);
    unsigned* FS = WG; unsigned* U = WG + 4 * FN; unsigned* G1 = WG + 5 * FN; unsigned* G2 = WG + 6 * FN; unsigned* SC0 = WG + 7 * FN; unsigned* SC1 = WG + 8 * FN;
    hy_stage_conv(F, PT, c, U); hy_stage_conv(F, PT, 1024 + c, G1); hy_stage_conv(F, PT, 2048 + c, G2);
#pragma unroll 1
    for (int o = 0; o < 2; ++o) {
        const unsigned short* hf = (const unsigned short*)HT + (size_t)((o * 2 + 0) * 1024 + c) * FN; const unsigned short* hb = (const unsigned short*)HT + (size_t)((o * 2 + 1) * 1024 + c) * FN;
        float asum = 0.f;
        fwd_a(X, [&](int i) { const float a = bf2f(hf[i]), b = i ? bf2f(hb[FN - i]) : 0.f; asum += fabsf(a) + fabsf(b); return make_float2(a + b, 0.f); });
        const float nrm = block_sum(asum, red), scl = 1.f / (2.f * (float)FN * nrm);
        fwd_b(X); __syncthreads(); spec_c(X, FS + (o * 2 + 0) * FN, scl); __syncthreads();
        fwd_a(X, [&](int i) { const float d = bf2f(hf[i]) - (i ? bf2f(hb[FN - i]) : 0.f); const float2 w = unitrev((float)i * (0.5f / (float)FN)); return make_float2(d * w.x, d * w.y); });
        __syncthreads(); fwd_b(X); __syncthreads(); spec_c(X, FS + (o * 2 + 1) * FN, scl); __syncthreads();
    }
    const float bias0 = F.in[I_HFB][c], bias1 = F.in[I_HFB][1024 + c];
    fwd_a(X, [&](int i) { return unpack_h2(U[i]); });
    __syncthreads(); fwd_b(X); __syncthreads(); mid_c(X, FS + 0 * FN); __syncthreads(); inv_b(X); __syncthreads();
    inv_a(X, [&](int r, float2 (&x)[16]) {
#pragma unroll
        for (int k = 0; k < 16; ++k) SC0[r + k * 1024] = pack_h2(x[k]);
#pragma unroll
        for (int k = 0; k < 16; ++k) x[k] = cmul(unpack_h2(U[r + k * 1024]), unitrev((float)(r + k * 1024) * (0.5f / (float)FN)));
        bfly<4, false>(x); apply_tw<4, false>(x, r, 1.f / 16384.f);
#pragma unroll
        for (int k = 0; k < 16; ++k) X[fphys(r + k * 1024)] = x[k]; });
    __syncthreads(); fwd_b(X); __syncthreads(); mid_c(X, FS + 1 * FN); __syncthreads(); inv_b(X); __syncthreads();
    inv_a(X, [&](int r, float2 (&x)[16]) {
        unsigned ycw[16], uw[16], gw[16];
#pragma unroll
        for (int k = 0; k < 16; ++k) { const int i = r + k * 1024; ycw[k] = SC0[i]; uw[k] = U[i]; gw[k] = G1[i]; }
#pragma unroll
        for (int k = 0; k < 16; ++k) { const int i = r + k * 1024;
            const float2 yn = cmulc(x[k], unitrev((float)i * (0.5f / (float)FN))), yc = unpack_h2(ycw[k]), u = unpack_h2(uw[k]), g = unpack_h2(gw[k]);
            const float2 z = make_float2(g.x * (yc.x + yn.x + u.x * bias0), g.y * (yc.y + yn.y + u.y * bias0));
            SC1[i] = pack_h2(z); x[k] = z; }
        bfly<4, false>(x); apply_tw<4, false>(x, r, 1.f / 16384.f);
#pragma unroll
        for (int k = 0; k < 16; ++k) X[fphys(r + k * 1024)] = x[k]; });
    __syncthreads(); fwd_b(X); __syncthreads(); mid_c(X, FS + 2 * FN); __syncthreads(); inv_b(X); __syncthreads();
    inv_a(X, [&](int r, float2 (&x)[16]) {
#pragma unroll
        for (int k = 0; k < 16; ++k) SC0[r + k * 1024] = pack_h2(x[k]);
#pragma unroll
        for (int k = 0; k < 16; ++k) x[k] = cmul(unpack_h2(SC1[r + k * 1024]), unitrev((float)(r + k * 1024) * (0.5f / (float)FN)));
        bfly<4, false>(x); apply_tw<4, false>(x, r, 1.f / 16384.f);
#pragma unroll
        for (int k = 0; k < 16; ++k) X[fphys(r + k * 1024)] = x[k]; });
    __syncthreads(); fwd_b(X); __syncthreads(); mid_c(X, FS + 3 * FN); __syncthreads(); inv_b(X); __syncthreads();
    unsigned short* zt = (unsigned short*)ZT + (size_t)c * MALL + CTX;
    inv_a(X, [&](int r, float2 (&x)[16]) {
        unsigned ycw[16], uw[16], gw[16];
#pragma unroll
        for (int k = 0; k < 16; ++k) { const int i = r + k * 1024; ycw[k] = SC0[i]; uw[k] = SC1[i]; gw[k] = G2[i]; }
#pragma unroll
        for (int k = 0; k < 16; ++k) { const int i = r + k * 1024;
            const float2 yn = cmulc(x[k], unitrev((float)i * (0.5f / (float)FN))), yc = unpack_h2(ycw[k]), u = unpack_h2(uw[k]), g = unpack_h2(gw[k]);
            zt[i] = f2bf(g.x * (yc.x + yn.x + u.x * bias1)); zt[NTOK + i] = f2bf(g.y * (yc.y + yn.y + u.y * bias1)); } });
    __syncthreads();
}
__device__ __forceinline__ void hyena_channel_ctx(const Ctx& F, int c, const bf16* __restrict__ PT, bf16* __restrict__ ZT) {
    float* base = (float*)F.lds; float* filt = base;
    float* uv = base + 1024; float* ux1 = uv + 512; float* ux2 = ux1 + 512; float* zz = ux2 + 512; float* red = zz + 512;
    const int tid = F.tid, b = tid >> 8, t = tid & 255;
    const float* A2C = (const float*)(F.ws + WS_A2C); const float* w3 = F.in[I_HW3];
    const float* cw = F.in[I_HCW]; const float* cbp = F.in[I_HCB];
    __syncthreads();
    {
        const float delta = fabsf(-3.0701134573253944f + (-15.350567286626972f + 3.0701134573253944f) * ((float)c * (1.f / 1023.f)));
        const float win = __expf(-((float)t * (1.f / 255.f)) * delta);
        const int o = b;
        float hf = 0.f, hb = 0.f;
        for (int k = 0; k < 64; ++k) { const float a = A2C[t * 64 + k]; hf += a * w3[k * 4096 + (o * 2 + 0) * 1024 + c]; hb += a * w3[k * 4096 + (o * 2 + 1) * 1024 + c]; }
        filt[(o * 2 + 0) * 256 + t] = hf * win; filt[(o * 2 + 1) * 256 + t] = hb * win;
    }
    {
        const unsigned short* pv = (const unsigned short*)PT + (size_t)c * MALL + b * NTOK;
        uv[tid] = sconv(pv, t, CTX, cw[c], cw[3072 + c], cw[6144 + c], cbp[c]);
        ux1[tid] = sconv(pv + (size_t)1024 * MALL, t, CTX, cw[1024 + c], cw[3072 + 1024 + c], cw[6144 + 1024 + c], cbp[1024 + c]);
        ux2[tid] = sconv(pv + (size_t)2048 * MALL, t, CTX, cw[2048 + c], cw[3072 + 2048 + c], cw[6144 + 2048 + c], cbp[2048 + c]);
    }
    __syncthreads();
    float nrm[2];
#pragma unroll
    for (int o = 0; o < 2; ++o) { const float s = (tid < 256) ? fabsf(filt[(o * 2) * 256 + tid]) + (tid ? fabsf(filt[(o * 2 + 1) * 256 + tid]) : 0.f) : 0.f; nrm[o] = block_sum(s, red); }
    float* src = uv;
#pragma unroll 1
    for (int o = 0; o < 2; ++o) {
        const float* hf = filt + (o * 2) * 256; const float* hb = hf + 256; const float* u = src + b * 256;
        float y = 0.f;
        for (int s = 0; s <= t; ++s) y += u[s] * hf[t - s];
        for (int s = t + 1; s < 256; ++s) y += u[s] * hb[s - t];
        y = y / nrm[o] + u[t] * F.in[I_HFB][o * 1024 + c];
        const float g = (o == 0 ? ux1 : ux2)[tid] * y;
        __syncthreads();
        zz[tid] = g; src = zz;
        __syncthreads();
    }
    ((unsigned short*)ZT)[(size_t)c * MALL + b * NTOK + t] = f2bf(zz[tid]);
    __syncthreads();
}
__device__ __forceinline__ void ph_hyena_core(const Ctx& F, bool need_ctx, const bf16* PT, const bf16* HT, bf16* ZT, unsigned* WGS) {
    for (int c = F.bid; c < 1024; c += F.G) {
        hyena_channel_latent(F, c, PT, HT, ZT, WGS + (size_t)F.bid * 9 * FN);
        if (need_ctx) hyena_channel_ctx(F, c, PT, ZT);
    }
}
__device__ __forceinline__ void ph_transpose_z(const Ctx& F, const bf16* __restrict__ ZT, bf16* __restrict__ Z) {
    unsigned short* t = (unsigned short*)F.lds;
    const int ntile = (1024 / 64) * (MALL / 64);
    for (int i = F.bid; i < ntile; i += F.G) {
        const int c0 = (i % 16) * 64, r0 = (i / 16) * 64;
        __syncthreads();
        { const int cc = F.tid >> 3, r8 = (F.tid & 7) * 8;
          const bf16x8 v = *reinterpret_cast<const bf16x8*>(ZT + (size_t)(c0 + cc) * MALL + r0 + r8);
#pragma unroll
          for (int j = 0; j < 8; ++j) t[(r8 + j) * 66 + cc] = (unsigned short)v[j]; }
        __syncthreads();
        { const int rr = F.tid >> 3, c8 = (F.tid & 7) * 8; bf16x8 v;
#pragma unroll
          for (int j = 0; j < 8; ++j) v[j] = (short)t[rr * 66 + c8 + j];
          *reinterpret_cast<bf16x8*>(Z + (size_t)(r0 + rr) * D + c0 + c8) = v; }
    }
}

__global__ void __launch_bounds__(NTHR, 2) mega_fwd(Args args) {
    {
        const unsigned hw = (unsigned)__builtin_amdgcn_s_getreg((5 << 11) | 4) & 63u;
        if ((threadIdx.x & 63) == 0) *(volatile LAS int*)((LAS unsigned char*)lds_raw + LDS_WTAB + hw * 4) = (int)(threadIdx.x >> 6);
        __syncthreads();
    }
    Ctx F; F.in = args.in; F.out = args.out; F.ws = args.ws; F.lds = (char*)lds_raw;
    F.tid = opaque_tid(); F.lane = F.tid & 63; F.wave = F.tid >> 6; F.G = gridDim.x; F.bid = blockIdx.x;
    volatile LAS unsigned* bst = (volatile LAS unsigned*)(lds_raw + LDS_WTAB + 256);
    if (F.tid == 0) { bst[0] = 0u; bst[1] = 0u; bst[2] = 0u; bst[3] = 0u; }
    __syncthreads();
    XcdBarrier bar = xcd_barrier_post((unsigned*)(args.ws + WS_CTL), bst);
    const int lo = args.ph_lo, hi = args.ph_hi;
    int ph = 0;
#ifndef PH_MASK
#define PH_MASK 0xFFFFFFFFFFFFFFFFull
#endif
    int phc = 0;
#define PHASE(...) do { if (lo <= ph && ph < hi) { if ((PH_MASK >> (__COUNTER__ - CNT0 - 1)) & 1ull) { F.tid = opaque_tid(); F.lane = F.tid & 63; F.wave = F.tid >> 6;   __VA_ARGS__; } if (ph + 1 < hi) xcd_barrier(bar); } ++ph; } while (0)
    constexpr int CNT0 = __COUNTER__;

    PHASE((p0_prologue(F), hy_prologue(F)));
    bf16* const WT = (bf16*)(args.ws + WS_WT);
    bf16* const Hb = (bf16*)(args.ws + S_H);
    {
        bf16* QKV = (bf16*)(args.ws + S_QKV); bf16* AO = (bf16*)(args.ws + S_AO);
        PHASE(ph_modulate(F, 0, 0, Hb, true));
        PHASE(ph_gemm_qkv(F, 0, Hb, WT + WT_DAIN, QKV));
        PHASE(ph_attention(F, 0, 0, true, QKV, AO));
        PHASE(ph_gemm_resid(F, AO, D, WT + WT_DAOUT, D, 0, 2048, nullptr, true));
    }
#define MOE_PHASES(layer, need_ctx) do { \
        unsigned char* EXPW8 = (unsigned char*)(args.ws + S_EXPW); unsigned char* HID8 = (unsigned char*)(args.ws + S_HID); bf16* Yb = (bf16*)(args.ws + S_Y); unsigned char* H8 = (unsigned char*)Hb; \
        const int nrt = (need_ctx) ? 288 : 256; \
        PHASE(ph_ffn_modulate_router(F, layer, H8, need_ctx)); \
        PHASE((ph_topk(F, need_ctx), ph_cvt_experts(F, layer, EXPW8))); \
        PHASE(ph_moe_up(F, H8, EXPW8, HID8, nrt)); \
        PHASE(ph_moe_down(F, HID8, EXPW8, Yb, nrt)); \
        PHASE(ph_moe_combine(F, layer, Yb, need_ctx, (layer) < 3 ? (layer) + 1 : -1, Hb)); } while (0)
    MOE_PHASES(0, true);
    {
        bf16 *RQ = (bf16*)(args.ws + R_Q), *RKR = (bf16*)(args.ws + R_KR), *RKFT = (bf16*)(args.ws + R_KFT), *RKBT = (bf16*)(args.ws + R_KBT), *RVT = (bf16*)(args.ws + R_VT),
             *RSG = (bf16*)(args.ws + R_SG), *RST = (bf16*)(args.ws + R_ST), *RP = (bf16*)(args.ws + R_P), *RO = (bf16*)(args.ws + R_O);
        const RetC rc = ret_consts(F);
        PHASE({ const DenseSched S = dense_sched(F, Hb, D, WT + WT_RIN, D, MALL, 6144); const EpiRetIn E{RQ, RKR, RKFT, RKBT, RVT, RSG, rc, (const float*)(args.ws + WS_RROPE)}; gemm_phase<true>(F.lds, D, D, D, S, E); });
        PHASE({ { const RetPSched S{(const char*)RQ, (const char*)RKR, F.bid, F.G}; const EpiRetP E{RP, rc}; gemm_phase<true, RetPSched, EpiRetP, false, false, true>(F.lds, D, D, RCH, S, E); }
                { const RetSSched S{(const char*)RVT, (const char*)RKFT, (const char*)RKBT, F.bid, F.G}; const EpiRetS E{RST}; gemm_phase<true, RetSSched, EpiRetS, false, false, true>(F.lds, NTOK, NTOK, RCH, S, E); } });
        PHASE(ph_ret_scan(F, RST, rc));
        PHASE({ const RetOSched S{(const char*)RQ, (const char*)RP, (const char*)RST, (const char*)RVT, F.bid, F.G, 0}; const EpiRetO E{RO, rc}; gemm_phase<true, RetOSched, EpiRetO, false, false, true>(F.lds, D, NTOK, RCH, S, E); });
        PHASE(ph_ret_gate(F, RO, RSG));
        PHASE(ph_gemm_resid(F, RO, 2048, WT + WT_ROUT, 2048, 1, 2048, nullptr));
    }
    MOE_PHASES(1, true);
    {
        bf16 *PT = (bf16*)(args.ws + H_PT), *ZT = (bf16*)(args.ws + H_ZT), *Zb = (bf16*)(args.ws + H_Z), *HT = (bf16*)(args.ws + H_HT);
        PHASE({ { const DenseSched S = dense_sched(F, Hb, D, WT + WT_HIN, D, MALL, 3072); const EpiHyIn E{PT, F.in[I_HBIN]}; gemm_phase<false>(F.lds, D, D, D, S, E); }
                { const DenseSched S = dense_sched(F, (const bf16*)(args.ws + WS_W3P), 256, (const bf16*)(args.ws + WS_A2P), 256, 4096, FN); const EpiHyTaps E{HT}; gemm_phase<true, DenseSched, EpiHyTaps, false, false, true>(F.lds, 256, 256, 256, S, E); } });
        PHASE(ph_hyena_core(F, true, PT, HT, ZT, (unsigned*)(args.ws + H_WG)));
        PHASE(ph_transpose_z(F, ZT, Zb));
        PHASE(ph_gemm_resid(F, Zb, D, WT + WT_HOUT, D, 2, 2048, F.in[I_HBOUT]));
    }
    MOE_PHASES(2, true);
    {
        bf16* QKV = (bf16*)(args.ws + S_QKV); bf16* AO = (bf16*)(args.ws + S_AO);
        PHASE(ph_gemm_qkv(F, 1, Hb, WT + WT_DAIN + (size_t)3072 * 1024, QKV));
        PHASE(ph_attention(F, 3, 1, false, QKV, AO));
        PHASE(ph_gemm_resid(F, AO, D, WT + WT_DAOUT + (size_t)1024 * 1024, D, 3, 2048, nullptr, false, true));
    }
    MOE_PHASES(3, false);
}

extern "C" void kernel_launch(void* const* d_in, const int* in_sizes, int n_in, void* d_out, int out_size, void* d_ws, size_t ws_size, hipStream_t stream) {
    static int grid = 0;
    if (grid == 0) {
        if (n_in != N_IN || out_size != NB * SEQL * D || ws_size < WS_NEED) {
            fprintf(stderr, "kernel_launch: unexpected shapes: n_in %d out %d ws %zu (need %zu)\n", n_in, out_size, ws_size, (size_t)WS_NEED); grid = -1; return; }
        int dev = 0, cus = 0, per_cu = 0;
        if (hipGetDevice(&dev) != hipSuccess || hipDeviceGetAttribute(&cus, hipDeviceAttributeMultiprocessorCount, dev) != hipSuccess) { grid = -1; return; }
        if (hipFuncSetAttribute((const void*)mega_fwd, hipFuncAttributeMaxDynamicSharedMemorySize, LDS_BYTES) != hipSuccess) { fprintf(stderr, "kernel_launch: LDS attribute failed\n"); grid = -1; return; }
        if (hipOccupancyMaxActiveBlocksPerMultiprocessor(&per_cu, (const void*)mega_fwd, NTHR, LDS_BYTES) != hipSuccess || per_cu < 1)
            fprintf(stderr, "kernel_launch: occupancy query says %d\n", per_cu);
        (void)hipGetLastError();
        grid = cus;
    }
    if (grid < 0) return;
    (void)hipMemsetAsync((char*)d_ws + WS_CTL, 0, 65536, stream);
    Args a{};
    for (int i = 0; i < N_IN; ++i) a.in[i] = (const float*)d_in[i];
    a.out = (float*)d_out; a.ws = (unsigned char*)d_ws; a.ph_lo = 0; a.ph_hi = 1000;
    hipLaunchKernelGGL(mega_fwd, dim3(grid), dim3(NTHR), LDS_BYTES, stream, a);
    const hipError_t le = hipPeekAtLastError();
    if (le != hipSuccess) fprintf(stderr, "kernel_launch: launch failed: %s\n", hipGetErrorName(le));
}
```

```cpp
#include <hip/hip_runtime.h>
#include <hip/hip_bf16.h>
#include <cstdio>
#include <cstdint>

#define LAS __attribute__((address_space(3)))
typedef __hip_bfloat16 bf16;
typedef __attribute__((ext_vector_type(8))) short bf16x8;
typedef __attribute__((ext_vector_type(4))) short s16x4;
typedef __attribute__((ext_vector_type(4))) float f32x4;
typedef __attribute__((ext_vector_type(16))) float f32x16;
typedef __attribute__((ext_vector_type(4))) unsigned u32x4;
typedef __attribute__((ext_vector_type(2))) unsigned u32x2;

constexpr int NB = 2, SEQL = 16384, CTX = 256, NTOK = SEQL + CTX, D = 1024, MALL = NB * NTOK;
constexpr int NTHR = 512;
constexpr int NEXP = 16, CAPL = 2048, CAPC = 32;
constexpr float EPS = 1e-6f;

enum { I_X = 0, I_C, I_CTX, I_CCTX, I_NMG, I_NFG, I_MODW, I_MODB, I_DAWIN, I_DAQN, I_DAKN, I_DALAM, I_DASUB, I_DAWOUT,
       I_RWIN, I_RLA, I_RGN, I_RWOUT, I_HWIN, I_HBIN, I_HCW, I_HCB, I_HW1, I_HB1, I_HW2, I_HB2, I_HFREQ, I_HW3, I_HFB, I_HWOUT, I_HBOUT,
       I_RTW, I_EW1, I_EW3, I_EW2, N_IN };

constexpr size_t AL(size_t x) { return (x + 255) / 256 * 256; }
constexpr size_t WS_CTL = 0;
constexpr size_t WS_RETC = 32768;
constexpr size_t WS_MODS = 65536;
constexpr size_t WS_CTXX = WS_MODS + AL(4 * 3 * 6144 * 4);
constexpr size_t WS_AFFL = WS_CTXX + AL((size_t)NB * CTX * D * 4);
constexpr size_t WS_AFFC = WS_AFFL + AL((size_t)NB * NEXP * SEQL * 4);
constexpr size_t WS_SLOTL = WS_AFFC + AL((size_t)NB * NEXP * CTX * 4);
constexpr size_t WS_SLOTC = WS_SLOTL + AL((size_t)NB * NEXP * SEQL * 4);
constexpr int NFLAT = NB * NEXP * CAPL + NB * NEXP * 256;
constexpr size_t WS_ROWS = WS_SLOTC + AL((size_t)NB * NEXP * CTX * 4);
constexpr size_t WS_GATEV = WS_ROWS + AL((size_t)NFLAT * 4);
constexpr size_t WS_RROPE = WS_GATEV + AL((size_t)NFLAT * 4);
constexpr size_t WS_AROPE = WS_RROPE + AL((size_t)SEQL * 128 * 8);
constexpr size_t WS_A2P = WS_AROPE + AL((size_t)320 * 16 * 8);
constexpr size_t WS_W3P = WS_A2P + AL((size_t)SEQL * 256 * 2);
constexpr size_t WS_A2C = WS_W3P + AL((size_t)4096 * 256 * 2);
constexpr size_t WS_WT = WS_A2C + AL((size_t)CTX * 64 * 4);
constexpr size_t WT_DAIN = 0, WT_DAOUT = WT_DAIN + 2ull * 3072 * 1024, WT_RIN = WT_DAOUT + 2ull * 1024 * 1024, WT_ROUT = WT_RIN + 6144ull * 1024,
                 WT_HIN = WT_ROUT + 1024ull * 2048, WT_HOUT = WT_HIN + 3072ull * 1024, WT_END = WT_HOUT + 1024ull * 1024;
constexpr size_t WS_SCR = WS_WT + AL(WT_END * 2);
constexpr size_t S_H = WS_SCR;
constexpr size_t S_B1 = S_H + AL((size_t)MALL * D * 2);
constexpr size_t S_QKV = S_B1;
constexpr size_t S_AO = S_QKV + AL((size_t)MALL * 3072 * 2);
constexpr size_t S_EXPW = S_B1;
constexpr size_t S_HID = S_EXPW + AL((size_t)NEXP * 3072 * 1024 * 2);
constexpr size_t S_Y = S_HID + AL((size_t)NFLAT * D * 2);
constexpr int RCH = 256, RNC = NTOK / RCH;
constexpr size_t R_Q = S_B1;
constexpr size_t R_KR = R_Q + AL((size_t)MALL * D * 2);
constexpr size_t R_KFT = R_KR + AL((size_t)MALL * D * 2);
constexpr size_t R_KBT = R_KFT + AL((size_t)8 * 256 * NTOK * 2);
constexpr size_t R_VT = R_KBT + AL((size_t)8 * 256 * NTOK * 2);
constexpr size_t R_SG = R_VT + AL((size_t)8 * 512 * NTOK * 2);
constexpr size_t R_ST = R_SG + AL((size_t)MALL * 2048 * 2);
constexpr size_t R_END = R_ST + AL((size_t)2 * 8 * 512 * NTOK * 2);
constexpr size_t R_P = S_H;
constexpr size_t R_O = R_KFT;
constexpr int FN = SEQL;
constexpr size_t H_PT = S_B1;
constexpr size_t H_HT = H_PT + AL((size_t)3072 * MALL * 2);
constexpr size_t H_ZT = H_HT + AL((size_t)4096 * FN * 2);
constexpr size_t H_Z = H_ZT + AL((size_t)1024 * MALL * 2);
constexpr size_t H_WG = H_Z + AL((size_t)MALL * D * 2);
constexpr size_t H_WG_BYTES = (size_t)9 * FN * 4;
constexpr size_t H_END = H_WG + 256 * H_WG_BYTES;
constexpr size_t WS_NEED_MOE = S_Y + AL((size_t)NFLAT * D * 2);
constexpr size_t WS_NEED = (R_END > WS_NEED_MOE ? R_END : WS_NEED_MOE) > H_END ? (R_END > WS_NEED_MOE ? R_END : WS_NEED_MOE) : H_END;

constexpr int LDS_BYTES = 147456 + 512;
constexpr int LDS_WTAB = 147456;

extern __shared__ __attribute__((aligned(16))) unsigned char lds_raw[];
__device__ __forceinline__ int lane_id_v() { int l; asm volatile("v_mbcnt_lo_u32_b32 %0, -1, 0\n\tv_mbcnt_hi_u32_b32 %0, -1, %0" : "=v"(l)); return l; }
__device__ __forceinline__ int wave_id_u() {
    const unsigned hw = (unsigned)__builtin_amdgcn_s_getreg((5 << 11) | 4) & 63u;
    return __builtin_amdgcn_readfirstlane(*(volatile LAS int*)((LAS unsigned char*)lds_raw + LDS_WTAB + hw * 4));
}
__device__ __forceinline__ int opaque_tid() { return wave_id_u() * 64 + lane_id_v(); }
#define TIDX opaque_tid()

#define XB_TMO      128
#define XB_XCNT(j)  (256  + 64 * (j))
#define XB_XSUB(j)  (1280 + 64 * (j))
#define XB_XGEN(j)  (2304 + 64 * (j))
#define XB_TOP      3328
#define XB_TOPGEN   3392
#define XCD_BAR_WORDS 3456
#define XB_SPIN_CAP (1u << 18)

__device__ __forceinline__ unsigned xb_ld(unsigned* p)              { return __hip_atomic_load(p, __ATOMIC_RELAXED, __HIP_MEMORY_SCOPE_AGENT); }
__device__ __forceinline__ unsigned xb_add(unsigned* p, unsigned v) { return __hip_atomic_fetch_add(p, v, __ATOMIC_RELAXED, __HIP_MEMORY_SCOPE_AGENT); }
__device__ __forceinline__ unsigned xb_xcc_id() { return (unsigned)__builtin_amdgcn_s_getreg((3 << 11) | 20) & 0xFu; }
#define XB_SPIN(cond, bar) do { unsigned _sp = 0; while (cond) { __builtin_amdgcn_s_sleep(1); \
    if ((++_sp & 255u) == 0u) { if (xb_ld(&(bar)[XB_TMO])) break; if (_sp > XB_SPIN_CAP) { atomicAdd(&(bar)[XB_TMO], 1u); break; } } } } while (0)

struct XcdBarrier { unsigned* bar; unsigned x; volatile LAS unsigned* st; };

__device__ __forceinline__ XcdBarrier xcd_barrier_post(unsigned* bar, volatile LAS unsigned* st) {
    XcdBarrier b; b.bar = bar; b.x = xb_xcc_id(); b.st = st;
    if (TIDX == 0) (void)xb_add(&bar[XB_XCNT(b.x)], 1u);
    return b;
}
__device__ __forceinline__ void xcd_barrier_complete(unsigned* bar, unsigned x, unsigned& nloc, unsigned& nx) {
    const unsigned G = gridDim.x * gridDim.y * gridDim.z;
    unsigned sum, cnt, mine, sp = 0u;
    for (;;) {
        sum = 0u; cnt = 0u; mine = 0u;
#pragma unroll
        for (unsigned j = 0; j < 16; ++j) { const unsigned c = xb_ld(&bar[XB_XCNT(j)]); sum += c; cnt += (c > 0u) ? 1u : 0u; mine = (j == x) ? c : mine; }
        if (sum == G) break;
        __builtin_amdgcn_s_sleep(1);
        if ((++sp & 255u) == 0u) { if (xb_ld(&bar[XB_TMO])) break; if (sp > XB_SPIN_CAP) { atomicAdd(&bar[XB_TMO], 1u); break; } }
    }
    nloc = mine > 0u ? mine : 1u; nx = cnt > 0u ? cnt : 1u;
}
__device__ __forceinline__ void xcd_barrier(const XcdBarrier& b) {
    asm volatile("s_waitcnt vmcnt(0)" ::: "memory");
    __syncthreads();
    if (TIDX == 0) {
        unsigned* bar = b.bar;
        __builtin_amdgcn_s_waitcnt(0);
        unsigned nloc = b.st[0], nx = b.st[1];
        if (nloc == 0u) { xcd_barrier_complete(bar, b.x, nloc, nx); b.st[0] = nloc; b.st[1] = nx; }
        const unsigned old = xb_add(&bar[XB_XSUB(b.x)], 1u);
        const unsigned gen = old / nloc;
        if (old + 1u == (gen + 1u) * nloc) {
            __builtin_amdgcn_fence(__ATOMIC_RELEASE, "agent");
            asm volatile("s_waitcnt vmcnt(0)" ::: "memory");
            const unsigned og = xb_add(&bar[XB_TOP], 1u);
            const unsigned tg = og / nx;
            if (og + 1u == (tg + 1u) * nx) xb_add(&bar[XB_TOPGEN], 1u);
            else XB_SPIN(xb_ld(&bar[XB_TOPGEN]) == tg, bar);
            __builtin_amdgcn_fence(__ATOMIC_ACQUIRE, "agent");
            xb_add(&bar[XB_XGEN(b.x)], 1u);
            asm volatile("s_waitcnt vmcnt(0)" ::: "memory");
        } else {
            XB_SPIN(xb_ld(&bar[XB_XGEN(b.x)]) == gen, bar);
            __builtin_amdgcn_fence(__ATOMIC_ACQUIRE, "agent");
            asm volatile("s_waitcnt vmcnt(0)" ::: "memory");
        }
    }
    __syncthreads();
}

__device__ __forceinline__ unsigned cvtpk(float lo, float hi) {
    unsigned r; asm volatile("v_cvt_pk_bf16_f32 %0, %1, %2" : "=v"(r) : "v"(lo), "v"(hi)); return r;
}
__device__ __forceinline__ unsigned short f2bf(float x) { return (unsigned short)(cvtpk(x, 0.f) & 0xffffu); }
__device__ __forceinline__ float bf2f(unsigned short u) { return __uint_as_float(((unsigned)u) << 16); }
__device__ __forceinline__ float wave_sum(float v) {
#pragma unroll
    for (int o = 32; o > 0; o >>= 1) v += __shfl_xor(v, o, 64);
    return v;
}
__device__ __forceinline__ float silu_f(float x) { return x / (1.f + __expf(-x)); }
__device__ __forceinline__ float silu_fast(float x) { return x * __builtin_amdgcn_rcpf(1.f + __expf(-x)); }

struct Args { const float* in[N_IN]; float* out; unsigned char* ws; int ph_lo, ph_hi; };

struct Ctx {
    const float* const* in; float* out; unsigned char* ws; char* lds;
    int tid, lane, wave, G, bid;
};

__device__ __forceinline__ float* xrow(const Ctx& F, int r) {
    const int b = r / NTOK, t = r - b * NTOK;
    return (t < CTX) ? (float*)(F.ws + WS_CTXX) + ((size_t)(b * CTX + t)) * D : F.out + ((size_t)(b * SEQL + (t - CTX))) * D;
}
__device__ __forceinline__ const float* xrow_in(const Ctx& F, int r) {
    const int b = r / NTOK, t = r - b * NTOK;
    return (t < CTX) ? F.in[I_CTX] + ((size_t)(b * CTX + t)) * D : F.in[I_X] + ((size_t)(b * SEQL + (t - CTX))) * D;
}
__device__ __forceinline__ int mod_sel(int r) { const int b = r / NTOK, t = r - b * NTOK; return (t < CTX) ? 2 : b; }

typedef f32x4 Acc[2][2][4][2];
struct GUnit { const char* a; const char* b; int id; };
constexpr int G_BK = 64, G_HALF = 128, G_HTB = G_HALF * G_BK * 2;
constexpr int GEMM_LDS = 8 * G_HTB;

__device__ __forceinline__ int g_lds_byte(int r, int c) {
    int st = (r >> 4) * 2 + (c >> 5), rr = r & 15, cc = c & 31, ob = rr * 64 + cc * 2;
    return st * 1024 + (ob ^ (((ob >> 9) & 1) << 5));
}
__device__ __forceinline__ void g_stage_rc(int b, int& R, int& C) {
    int st = b / 1024, sb = b % 1024, swz = sb ^ (((sb >> 9) & 1) << 5);
    R = (st >> 1) * 16 + swz / 64; C = (st & 1) * 32 + (swz % 64) / 2;
}
__device__ __forceinline__ void acc_zero(Acc& acc) {
#pragma unroll
    for (int ai = 0; ai < 2; ++ai)
#pragma unroll
        for (int bj = 0; bj < 2; ++bj)
#pragma unroll
            for (int m = 0; m < 4; ++m)
#pragma unroll
                for (int n = 0; n < 2; ++n) acc[ai][bj][m][n] = f32x4{0.f, 0.f, 0.f, 0.f};
}
#define WAIT_V(n) asm volatile("s_waitcnt vmcnt(" #n ")" ::: "memory")
#define WAIT_L(n) asm volatile("s_waitcnt lgkmcnt(" #n ")" ::: "memory")

typedef int v8i32 __attribute__((ext_vector_type(8)));
typedef short s16x16_t __attribute__((ext_vector_type(16)));
template <bool SWAP, class Sched, class Epi, bool GATHER = false, bool FP8 = false, bool PERMB = false>
__device__ __forceinline__ void gemm_phase(char* ldsp, const int lda, const int ldb, const int K, const Sched& S, const Epi& E) {
    LAS unsigned char* lds = (LAS unsigned char*)ldsp;
    const int tid = TIDX, wid = __builtin_amdgcn_readfirstlane(tid >> 6), lane = tid & 63, wr = wid >> 2, wc = wid & 3, fr = lane & 15, fq = lane >> 4;
    int nt = K / G_BK; asm volatile("" : "+s"(nt));
    unsigned voffA[2], voffB[2];
#pragma unroll
    for (int i = 0; i < 2; ++i) { int R, C; g_stage_rc(tid * 16 + i * 8192, R, C); voffA[i] = (unsigned)(R * lda + C) * 2u; voffB[i] = (unsigned)(R * ldb + C) * 2u; }
    unsigned voffBp[2][2] = {{0u, 0u}, {0u, 0u}};
    if (PERMB) {
#pragma unroll
        for (int h = 0; h < 2; ++h)
#pragma unroll
            for (int i = 0; i < 2; ++i) { int R, C; g_stage_rc(tid * 16 + i * 8192, R, C);
                const int L = ((R >> 5) & 3) * 64 + ((R >> 2) & 3) * 16 + h * 8 + ((R >> 4) & 1) * 4 + (R & 3); voffBp[h][i] = (unsigned)(L * ldb + C) * 2u; } }
    const size_t kstep = (size_t)(G_BK * 2);
    const size_t hstepA = (size_t)G_HALF * lda * 2, hstepB = (size_t)G_HALF * ldb * 2;
    const unsigned ldsw = (unsigned)wid * 1024u;
    const int aoff = g_lds_byte(wr * 64 + fr, FP8 ? fq * 16 : fq * 8), boff = g_lds_byte(wc * 32 + fr, FP8 ? fq * 16 : fq * 8);
#define PG_SA(b, h) (((b) * 2 + (h)) * G_HTB)
#define PG_STAGEB(bufoff, kp, h) do { if (PERMB) PG_STAGE(bufoff, kp, voffBp[h]); else PG_STAGE(bufoff, (const char*)(kp) + (h) * hstepB, voffB); } while (0)
#define PG_SB(b, h) ((4 + (b) * 2 + (h)) * G_HTB)
#define PG_STAGE(bufoff, gbase, voff) do { _Pragma("unroll") for (int _i = 0; _i < 2; ++_i) \
        __builtin_amdgcn_global_load_lds((const unsigned*)((const char*)(gbase) + (voff)[_i]), (LAS unsigned*)(lds + (bufoff) + ldsw + _i * 8192), 16, 0, 0); } while (0)
    unsigned vgC[4] = {0u, 0u, 0u, 0u}, vgN[4] = {0u, 0u, 0u, 0u};
    int gR[2]; { int C_; g_stage_rc(tid * 16, gR[0], C_); g_stage_rc(tid * 16 + 8192, gR[1], C_); }
#define PG_GLOAD(dst, u_) do { const int* rw_ = S.rows(u_); _Pragma("unroll") for (int h_ = 0; h_ < 2; ++h_) _Pragma("unroll") for (int i_ = 0; i_ < 2; ++i_) \
        dst[h_ * 2 + i_] = (unsigned)rw_[h_ * 128 + gR[i_]] * (unsigned)(lda * 2) + (voffA[i_] - (unsigned)(gR[i_] * lda * 2)); } while (0)
#define PG_STAGEA(bufoff, kp, h, NX) do { if (GATHER) { _Pragma("unroll") for (int _i = 0; _i < 2; ++_i) \
            __builtin_amdgcn_global_load_lds((const unsigned*)((const char*)(kp) + ((NX) ? vgN[(h) * 2 + _i] : vgC[(h) * 2 + _i])), (LAS unsigned*)(lds + (bufoff) + ldsw + _i * 8192), 16, 0, 0); } \
        else PG_STAGE(bufoff, (const char*)(kp) + (h) * hstepA, voffA); } while (0)
#define PG_CAT(P) __builtin_bit_cast(v8i32, (s16x16_t)__builtin_shufflevector(*(const LAS bf16x8*)(P), *(const LAS bf16x8*)((P) + 16), 0, 1, 2, 3, 4, 5, 6, 7, 8, 9, 10, 11, 12, 13, 14, 15))
#define PG_LDA(dst, b, h) do { if (FP8) { _Pragma("unroll") for (int m = 0; m < 4; ++m) dst##8[m] = PG_CAT(lds + PG_SA(b, h) + aoff + m * 2048); } \
        else { _Pragma("unroll") for (int m = 0; m < 4; ++m) _Pragma("unroll") for (int k = 0; k < 2; ++k) dst[m][k] = *(const LAS bf16x8*)(lds + PG_SA(b, h) + aoff + m * 2048 + k * 1024); } } while (0)
#define PG_LDB(dst, b, h) do { if (FP8) { _Pragma("unroll") for (int n = 0; n < 2; ++n) dst##8[n] = PG_CAT(lds + PG_SB(b, h) + boff + n * 2048); } \
        else { _Pragma("unroll") for (int n = 0; n < 2; ++n) _Pragma("unroll") for (int k = 0; k < 2; ++k) dst[n][k] = *(const LAS bf16x8*)(lds + PG_SB(b, h) + boff + n * 2048 + k * 1024); } } while (0)
#define PG_MMA(ai, bj, At, Bt) do { __builtin_amdgcn_s_setprio(1); _Pragma("unroll") for (int m = 0; m < 4; ++m) _Pragma("unroll") for (int n = 0; n < 2; ++n) { \
        if (FP8) {     \
            if (SWAP) asm volatile("v_mfma_scale_f32_16x16x128_f8f6f4 %0, %1, %2, %0, %3, %3 op_sel_hi:[0,0,0]" : "+v"(acc[ai][bj][m][n]) : "v"(Bt##8[n]), "v"(At##8[m]), "v"(one_e8m0)); \
            else      asm volatile("v_mfma_scale_f32_16x16x128_f8f6f4 %0, %1, %2, %0, %3, %3 op_sel_hi:[0,0,0]" : "+v"(acc[ai][bj][m][n]) : "v"(At##8[m]), "v"(Bt##8[n]), "v"(one_e8m0)); } \
        else { _Pragma("unroll") for (int k = 0; k < 2; ++k) \
            acc[ai][bj][m][n] = SWAP ? __builtin_amdgcn_mfma_f32_16x16x32_bf16(Bt[n][k], At[m][k], acc[ai][bj][m][n], 0, 0, 0) \
                                     : __builtin_amdgcn_mfma_f32_16x16x32_bf16(At[m][k], Bt[n][k], acc[ai][bj][m][n], 0, 0, 0); } } __builtin_amdgcn_s_setprio(0); } while (0)
#define PG_BAR __builtin_amdgcn_s_barrier()
#define PG_SCHED __builtin_amdgcn_sched_barrier(0)
    GUnit cur, nxt; int ui = 0;
    __syncthreads();
    if (!S.get(0, cur)) return;
    Acc acc; acc_zero(acc);
    bf16x8 At[4][2], B0[2][2], B1[2][2];
    v8i32 At8[4], B08[2], B18[2];
    int one_e8m0 = 127; asm volatile("" : "+v"(one_e8m0));
    const char* cA = cur.a; const char* cB = cur.b;
    if constexpr (GATHER) { PG_GLOAD(vgC, cur); asm volatile("s_waitcnt vmcnt(0)" ::: "memory"); }
    PG_STAGEB(PG_SB(0, 0), cB, 0); PG_STAGEA(PG_SA(0, 0), cA, 0, false); PG_STAGEB(PG_SB(0, 1), cB, 1); PG_STAGEA(PG_SA(0, 1), cA, 1, false);
    if (wr == 1) PG_BAR;
    WAIT_V(4); PG_BAR;
    PG_STAGEB(PG_SB(1, 0), cB + kstep, 0); PG_STAGEA(PG_SA(1, 0), cA + kstep, 0, false); PG_STAGEB(PG_SB(1, 1), cB + kstep, 1);
    WAIT_V(6); PG_BAR;
    for (;;) {
        const bool has_next = S.get(ui + 1, nxt);
        const char* nA = has_next ? nxt.a : cA; const char* nB = has_next ? nxt.b : cB;
        if constexpr (GATHER) { if (has_next) PG_GLOAD(vgN, nxt); else { _Pragma("unroll") for (int q_ = 0; q_ < 4; ++q_) vgN[q_] = vgC[q_]; } }
#pragma unroll 1
        for (int t = 0; t < nt; t += 2) {
            const bool last = (t == nt - 2);
            const char* a1 = cA + (size_t)(t + 1) * kstep;
            const char* a2 = last ? nA : cA + (size_t)(t + 2) * kstep; const char* b2 = last ? nB : cB + (size_t)(t + 2) * kstep;
            const char* a3 = a2 + kstep; const char* b3 = b2 + kstep;
            PG_LDB(B0, 0, 0); PG_SCHED; PG_LDA(At, 0, 0); PG_STAGEA(PG_SA(1, 1), a1, 1, false);
            WAIT_L(8); PG_BAR; WAIT_L(0); PG_MMA(0, 0, At, B0); PG_BAR; PG_SCHED;
            PG_LDB(B1, 0, 1); PG_STAGEB(PG_SB(0, 0), b2, 0);
            PG_BAR; WAIT_L(0); PG_MMA(0, 1, At, B1); PG_BAR;
            PG_LDA(At, 0, 1); PG_STAGEA(PG_SA(0, 0), a2, 0, last);
            PG_BAR; WAIT_L(0); PG_MMA(1, 0, At, B0); PG_BAR; PG_SCHED;
            PG_STAGEB(PG_SB(0, 1), b2, 1);
            WAIT_V(6); PG_BAR; PG_MMA(1, 1, At, B1); PG_BAR;
            PG_LDB(B0, 1, 0); PG_SCHED; PG_LDA(At, 1, 0); PG_STAGEA(PG_SA(0, 1), a2, 1, last);
            WAIT_L(8); PG_BAR; WAIT_L(0); PG_MMA(0, 0, At, B0); PG_BAR; PG_SCHED;
            PG_LDB(B1, 1, 1); PG_STAGEB(PG_SB(1, 0), b3, 0);
            PG_BAR; WAIT_L(0); PG_MMA(0, 1, At, B1); PG_BAR;
            PG_LDA(At, 1, 1); PG_STAGEA(PG_SA(1, 0), a3, 0, last);
            PG_BAR; WAIT_L(0); PG_MMA(1, 0, At, B0); PG_BAR; PG_SCHED;
            PG_STAGEB(PG_SB(1, 1), b3, 1);
            WAIT_V(6); PG_BAR; PG_MMA(1, 1, At, B1); PG_BAR;
        }
        if (FP8) asm volatile("s_nop 15\n\ts_nop 7" ::: "memory");
        const bool z = E(acc, cur.id);
        if (!has_next) break;
        if (z) acc_zero(acc);
        cur = nxt; cA = nA; cB = nB; ++ui;
        if (GATHER) { _Pragma("unroll") for (int q_ = 0; q_ < 4; ++q_) vgC[q_] = vgN[q_]; }
    }
    WAIT_V(0);
    if (wr == 0) PG_BAR;
    PG_BAR;
#undef PG_SA
#undef PG_STAGEB
#undef PG_SB
#undef PG_STAGE
#undef PG_STAGEA
#undef PG_GLOAD
#undef PG_LDA
#undef PG_CAT
#undef PG_LDB
#undef PG_MMA
#undef PG_BAR
#undef PG_SCHED
}
__device__ __forceinline__ void store_rows_bf16(bf16* base, size_t ld, int fr, int fq, const f32x4 x00, const f32x4 x01, const f32x4 x10, const f32x4 x11) {
    const bool hi = (fr & 8) != 0;
    const u32x4 h0 = {cvtpk(x00[0], x00[1]), cvtpk(x00[2], x00[3]), cvtpk(x01[0], x01[1]), cvtpk(x01[2], x01[3])};
    const u32x4 h1 = {cvtpk(x10[0], x10[1]), cvtpk(x10[2], x10[3]), cvtpk(x11[0], x11[1]), cvtpk(x11[2], x11[3])};
    const u32x4 send = hi ? h0 : h1; u32x4 recv;
#pragma unroll
    for (int i = 0; i < 4; ++i) recv[i] = (unsigned)__builtin_amdgcn_update_dpp(0, (int)send[i], 0x128, 0xf, 0xf, false);
    const u32x4 d0 = hi ? recv : h0, d1 = hi ? h1 : recv;
    bf16* p = base + (size_t)(fr & 7) * ld + fq * 16 + (hi ? 8 : 0);
    *reinterpret_cast<u32x4*>(p) = d0;
    *reinterpret_cast<u32x4*>(p + 8 * ld) = d1;
}
template <bool SWAP, class Fn> __device__ __forceinline__ void acc_foreach(const Acc& acc, Fn fn) {
    const int _t = opaque_tid(), _w = _t >> 6, _l = _t & 63, _wr = _w >> 2, _wc = _w & 3, _fr = _l & 15, _fq = _l >> 4;
#pragma unroll
    for (int ai = 0; ai < 2; ++ai)
#pragma unroll
        for (int bj = 0; bj < 2; ++bj)
#pragma unroll
            for (int m = 0; m < 4; ++m)
#pragma unroll
                for (int n = 0; n < 2; ++n) {
                    if (SWAP) fn(ai * 128 + _wr * 64 + m * 16 + _fr, bj * 128 + _wc * 32 + n * 16 + 4 * _fq, acc[ai][bj][m][n]);
                    else      fn(ai * 128 + _wr * 64 + m * 16 + 4 * _fq, bj * 128 + _wc * 32 + n * 16 + _fr, acc[ai][bj][m][n]);
                    __builtin_amdgcn_sched_barrier(0);
                }
}
struct DenseSched {
    const char* A; const char* B; size_t tstepA, tstepB; int nN, nM, bid, G; bool latent_only;
    __device__ __forceinline__ bool get(int i, GUnit& u) const {
        int pm, pn;
        if ((G & 7) == 0) {
            const int x = bid & 7, lb = bid >> 3, W = G >> 3, v = lb + i * W;
            const int own = (nM - x + 7) >> 3;
            if (v >= own * nN) return false;
            const int q = v / nN; pm = x + 8 * q; pn = v - q * nN;
        } else {
            const int t = bid + i * G; if (t >= nM * nN) return false;
            pm = t / nN; pn = t - pm * nN;
        }
        if (latent_only) pm += 1 + (pm >= 64 ? 1 : 0);
        u.a = A + (size_t)pm * tstepA; u.b = B + (size_t)pn * tstepB; u.id = pm * nN + pn; return true; }
};
__device__ __forceinline__ DenseSched dense_sched(const Ctx& F, const bf16* A, int lda, const bf16* Bt, int ldb, int M, int N) {
    DenseSched s; s.A = (const char*)A; s.B = (const char*)Bt; s.tstepA = (size_t)256 * lda * 2; s.tstepB = (size_t)256 * ldb * 2; s.nN = N / 256; s.nM = M / 256; s.bid = F.bid; s.G = F.G; s.latent_only = false; return s;
}

__device__ __forceinline__ void cvt_tile(const Ctx& F, const float* __restrict__ src, int ldsrc, bf16* __restrict__ dst, int lddst, int k0, int n0, int mode) {
    float* t = (float*)F.lds;
    const int kk = F.tid >> 5, nn = (F.tid & 31) * 4;
    f32x4 v[8];
#pragma unroll
    for (int h = 0; h < 8; ++h) v[h] = *reinterpret_cast<const f32x4*>(src + (size_t)(k0 + kk + 16 * h) * ldsrc + n0 + nn);
    __syncthreads();
#pragma unroll
    for (int h = 0; h < 8; ++h) *reinterpret_cast<f32x4*>(t + (kk + 16 * h) * 132 + nn) = v[h];
    __syncthreads();
#pragma unroll
    for (int h = 0; h < 4; ++h) {
        const int n = (F.tid & 31) + 32 * h, k8 = (F.tid >> 5) * 8;
        const float* p = t + k8 * 132 + n;
        u32x4 w = {cvtpk(p[0], p[132]), cvtpk(p[2 * 132], p[3 * 132]), cvtpk(p[4 * 132], p[5 * 132]), cvtpk(p[6 * 132], p[7 * 132])};
        const int ng = n0 + n;
        const int p3 = (ng & ~255) | (((ng >> 5) & 1) << 7) | (((ng >> 6) & 3) << 5) | (ng & 31);
        const int p4 = (ng & ~255) | (((ng >> 3) & 1) << 7) | (((ng >> 6) & 3) << 5) | (((ng >> 2) & 1) << 4) | (((ng >> 4) & 3) << 2) | (ng & 3);
        const int row = (mode == 0) ? ng : (mode == 5) ? (ng < 2048 ? p3 : p4)
                                         : (mode == 6) ? (ng < 4096 ? ng : p4)
                                         : ((ng >> 4) * 32 + (ng & 15) + (mode == 2 ? 16 : 0));
        *reinterpret_cast<u32x4*>(dst + (size_t)row * lddst + k0 + k8) = w;
    }
}
__device__ __forceinline__ void cvt_matrix(const Ctx& F, const float* src, int K, int N, bf16* dst, int lddst, int mode, int& rot, int lo = 0) {
    const int tk = K / 128, tn = N / 128, ntile = tk * tn, Gs = F.G - lo;
    if (F.bid >= lo) {
        int first = (F.bid - lo - rot) % Gs; if (first < 0) first += Gs;
        for (int i = first; i < ntile; i += Gs) cvt_tile(F, src, N, dst, lddst, (i / tn) * 128, (i % tn) * 128, mode);
    }
    rot = (rot + ntile) % Gs;
}

__device__ __forceinline__ void p0_prologue(const Ctx& F) {
    {
        float* sv = (float*)F.lds;
        float* red = sv + 3 * 1024;
        for (int i = F.tid; i < 3 * 1024; i += NTHR) sv[i] = silu_f(i < 2048 ? F.in[I_C][i] : F.in[I_CCTX][i - 2048]);
        __syncthreads();
        const int col = F.tid & 63, kg = F.tid >> 6;
        for (int it = F.bid; it < 4 * 96; it += F.G) {
            const int layer = it / 96, n0 = (it % 96) * 64;
            const float* W = F.in[I_MODW] + (size_t)layer * D * 6144 + n0 + col;
            float a0 = 0.f, a1 = 0.f, a2 = 0.f;
#pragma unroll 32
            for (int k = kg * 128; k < kg * 128 + 128; ++k) {
                const float w = W[(size_t)k * 6144];
                a0 += sv[k] * w; a1 += sv[1024 + k] * w; a2 += sv[2048 + k] * w;
            }
            __syncthreads();
            red[(kg * 3 + 0) * 64 + col] = a0; red[(kg * 3 + 1) * 64 + col] = a1; red[(kg * 3 + 2) * 64 + col] = a2;
            __syncthreads();
            if (F.tid < 192) {
                const int s = F.tid >> 6; float v = 0.f;
                for (int g = 0; g < 8; ++g) v += red[(g * 3 + s) * 64 + col];
                ((float*)(F.ws + WS_MODS))[((size_t)layer * 3 + s) * 6144 + n0 + col] = v + F.in[I_MODB][layer * 6144 + n0 + col];
            }
        }
        __syncthreads();
    }
    {
        float2* rr = (float2*)(F.ws + WS_RROPE);
        const float invf = 1.f / powf(10000.f, (float)(F.tid & 127) * (1.f / 127.f));
        for (int i = F.bid * NTHR + F.tid; i < SEQL * 128; i += F.G * NTHR) {
            const int pos = i >> 7; const float ang = (float)pos * invf;
            rr[i] = make_float2(cosf(ang), sinf(ang)); }
        float2* ar = (float2*)(F.ws + WS_AROPE);
        for (int i = F.bid * NTHR + F.tid; i < 320 * 16; i += F.G * NTHR) {
            const int p = i >> 4, f = i & 15; const float ang = (float)(p < 256 ? p : p - 256) * (1.f / powf(10000.f, (float)f * (1.f / 16.f)));
            ar[i] = make_float2(cosf(ang), sinf(ang)); }
    }
    if (F.bid == 0 && F.tid < 8) ((float*)(F.ws + WS_RETC))[F.tid] = log1pf(-expf(F.in[I_RLA][F.tid])) * 1.4426950408889634f;
    {
        bf16* wt = (bf16*)(F.ws + WS_WT); int rot = 0;
        for (int s = 0; s < 2; ++s) {
            cvt_matrix(F, F.in[I_DAWIN] + (size_t)s * 1024 * 3072, 1024, 3072, wt + WT_DAIN + (size_t)s * 3072 * 1024, 1024, 5, rot);
            cvt_matrix(F, F.in[I_DAWOUT] + (size_t)s * 1024 * 1024, 1024, 1024, wt + WT_DAOUT + (size_t)s * 1024 * 1024, 1024, 0, rot);
        }
        cvt_matrix(F, F.in[I_RWIN], 1024, 6144, wt + WT_RIN, 1024, 6, rot);
        cvt_matrix(F, F.in[I_RWOUT], 2048, 1024, wt + WT_ROUT, 2048, 0, rot);
        cvt_matrix(F, F.in[I_HWIN], 1024, 3072, wt + WT_HIN, 1024, 0, rot);
        cvt_matrix(F, F.in[I_HWOUT], 1024, 1024, wt + WT_HOUT, 1024, 0, rot);
    }
}

__device__ __forceinline__ void ph_modulate(const Ctx& F, int layer, int which, bf16* __restrict__ H, bool from_input = false) {
    const float* gn = F.in[which ? I_NFG : I_NMG] + layer * D;
    for (int r = F.bid * 8 + F.wave; r < MALL; r += F.G * 8) {
        const float* xp = from_input ? xrow_in(F, r) : xrow(F, r);
        const float* mb = (const float*)(F.ws + WS_MODS) + ((size_t)layer * 3 + mod_sel(r)) * 6144 + which * 3072;
        float4 v[4]; float ss = 0.f;
#pragma unroll
        for (int i = 0; i < 4; ++i) { v[i] = *reinterpret_cast<const float4*>(xp + i * 256 + F.lane * 4); ss += v[i].x * v[i].x + v[i].y * v[i].y + v[i].z * v[i].z + v[i].w * v[i].w; }
        ss = wave_sum(ss);
        const float rstd = rsqrtf(ss * (1.f / D) + EPS);
#pragma unroll
        for (int i = 0; i < 4; ++i) {
            const int e = i * 256 + F.lane * 4;
            const float4 g = *reinterpret_cast<const float4*>(gn + e), sh = *reinterpret_cast<const float4*>(mb + e), sc = *reinterpret_cast<const float4*>(mb + 1024 + e);
            const float a = v[i].x * rstd * g.x * (1.f + sc.x) + sh.x, b = v[i].y * rstd * g.y * (1.f + sc.y) + sh.y;
            const float c = v[i].z * rstd * g.z * (1.f + sc.z) + sh.z, d = v[i].w * rstd * g.w * (1.f + sc.w) + sh.w;
            u32x2 w = {cvtpk(a, b), cvtpk(c, d)};
            *reinterpret_cast<u32x2*>(H + (size_t)r * D + e) = w;
        }
    }
}

struct EpiBf16 { bf16* C; int ldc, nN;
    __device__ __forceinline__ bool operator()(Acc& acc, int t) const {
        const int brow = (t / nN) * 256, bcol = (t % nN) * 256;
        acc_foreach<true>(acc, [&](int row, int col4, f32x4 v) {
            u32x2 w = {cvtpk(v[0], v[1]), cvtpk(v[2], v[3])};
            *reinterpret_cast<u32x2*>(C + (size_t)(brow + row) * ldc + bcol + col4) = w; });
        return true; } };
__device__ __forceinline__ void ph_gemm_bf16(const Ctx& F, const bf16* A, int lda, const bf16* Bt, int ldb, int M, int N, int K, bf16* C, int ldc) {
    const DenseSched S = dense_sched(F, A, lda, Bt, ldb, M, N);
    const EpiBf16 E{C, ldc, N / 256};
    gemm_phase<true>(F.lds, lda, ldb, K, S, E);
}
struct EpiResid { float* xlat; float* xctx; const float* slat; const float* sctx; const float* mods; const float* bias;
    __device__ __forceinline__ bool operator()(Acc& acc, int t) const {
        const int brow = (t / 4) * 256, bcol = (t % 4) * 256;
        const int b = brow / NTOK, tt = brow - b * NTOK;
        float* xb = (tt < CTX) ? xctx + (size_t)(b * CTX) * D : xlat + (size_t)(b * SEQL + tt - CTX) * D;
        const float* sb = (tt < CTX) ? sctx + (size_t)(b * CTX) * D : slat + (size_t)(b * SEQL + tt - CTX) * D;
        const float* gate = mods + (size_t)((tt < CTX) ? 2 : b) * 6144;
        const int _t = opaque_tid(), _w = _t >> 6, _l = _t & 63, _wr = _w >> 2, _wc = _w & 3, _fr = _l & 15, _fq = _l >> 4;
        const int c0 = bcol + _wc * 32 + 4 * _fq;
        f32x4 g[4], bs[4];
#pragma unroll
        for (int q = 0; q < 4; ++q) { g[q] = *reinterpret_cast<const f32x4*>(gate + c0 + (q >> 1) * 128 + (q & 1) * 16);
            bs[q] = f32x4{0.f, 0.f, 0.f, 0.f}; if (bias) bs[q] = *reinterpret_cast<const f32x4*>(bias + c0 + (q >> 1) * 128 + (q & 1) * 16); }
        const size_t ro = (size_t)(_wr * 64 + _fr) * D + c0;
        const float* sp = sb + ro; float* xp = xb + ro;
        f32x4 cur[4], nxt[4];
#pragma unroll
        for (int q = 0; q < 4; ++q) cur[q] = *reinterpret_cast<const f32x4*>(sp + (q >> 1) * 128 + (q & 1) * 16);
#pragma unroll
        for (int k = 0; k < 8; ++k) {
            const int ai = k >> 2, m = k & 3;
            if (k + 1 < 8) {
                const size_t rn = (size_t)(((k + 1) >> 2) * 128 + ((k + 1) & 3) * 16) * D;
#pragma unroll
                for (int q = 0; q < 4; ++q) nxt[q] = *reinterpret_cast<const f32x4*>(sp + rn + (q >> 1) * 128 + (q & 1) * 16);
            }
            const size_t rk = (size_t)(ai * 128 + m * 16) * D;
#pragma unroll
            for (int q = 0; q < 4; ++q) *reinterpret_cast<f32x4*>(xp + rk + (q >> 1) * 128 + (q & 1) * 16) = cur[q] + g[q] * (acc[ai][q >> 1][m][q & 1] + bs[q]);
#pragma unroll
            for (int q = 0; q < 4; ++q) cur[q] = nxt[q];
            __builtin_amdgcn_sched_barrier(0);
        }
        return true; } };
__device__ __forceinline__ void ph_gemm_resid(const Ctx& F, const bf16* A, int lda, const bf16* Bt, int K, int layer, int gate_off, const float* bias, bool from_input = false, bool latent_only = false) {
    DenseSched S = dense_sched(F, A, lda, Bt, K, MALL, D);
    if (latent_only) { S.nM = 128; S.latent_only = true; }
    const EpiResid E{F.out, (float*)(F.ws + WS_CTXX), from_input ? F.in[I_X] : F.out, from_input ? F.in[I_CTX] : (const float*)(F.ws + WS_CTXX),
                     (const float*)(F.ws + WS_MODS) + (size_t)layer * 3 * 6144 + gate_off, bias};
    gemm_phase<true>(F.lds, lda, K, K, S, E);
}

struct EpiQKV { bf16* C; const float* gq; const float* gk; const float2* art;
    __device__ __forceinline__ bool operator()(Acc& acc, int t) const {
        const int pm = t / 12, pn = t - pm * 12, brow = pm * 256;
        const int b = brow / NTOK, tt0 = brow - b * NTOK;
        const int _t = opaque_tid(), _w = _t >> 6, _l = _t & 63, _wr = _w >> 2, _wc = _w & 3, _fr = _l & 15, _fq = _l >> 4;
        bf16* dst = C + (size_t)brow * 3072 + pn * 256 + _wc * 64;
        if (pn < 8) {
            const float* gn = (pn < 4 ? gq : gk) + 4 * _fq;
            const float qs = (pn < 4) ? 0.125f * 1.4426950408889634f : 1.f;
            const f32x4 g00 = *reinterpret_cast<const f32x4*>(gn), g01 = *reinterpret_cast<const f32x4*>(gn + 16), g10 = *reinterpret_cast<const f32x4*>(gn + 32), g11 = *reinterpret_cast<const f32x4*>(gn + 48);
            const bool lat = tt0 >= CTX;
            f32x4 rc_[4] = {}, rn_[4] = {};
            const float2* artl = art + 4 * _fq;
            if (lat) { const int pos = tt0 - CTX + _wr * 64 + _fr;
                const f32x4* t0 = reinterpret_cast<const f32x4*>(artl + (pos >> 6) * 16); const f32x4* t1 = reinterpret_cast<const f32x4*>(artl + (256 + (pos & 63)) * 16);
                rc_[0] = t0[0]; rc_[1] = t0[1]; rc_[2] = t1[0]; rc_[3] = t1[1]; }
#pragma unroll
            for (int ai = 0; ai < 2; ++ai)
#pragma unroll
                for (int m = 0; m < 4; ++m) {
                    if (lat && (ai * 4 + m) < 7) { const int kn = ai * 4 + m + 1; const int pos = tt0 - CTX + (kn >> 2) * 128 + _wr * 64 + (kn & 3) * 16 + _fr;
                        const f32x4* t0 = reinterpret_cast<const f32x4*>(artl + (pos >> 6) * 16); const f32x4* t1 = reinterpret_cast<const f32x4*>(artl + (256 + (pos & 63)) * 16);
                        rn_[0] = t0[0]; rn_[1] = t0[1]; rn_[2] = t1[0]; rn_[3] = t1[1]; }
                    f32x4 x00 = acc[ai][0][m][0], x01 = acc[ai][0][m][1], x10 = acc[ai][1][m][0], x11 = acc[ai][1][m][1];
                    const f32x4 sq = x00 * x00 + x01 * x01 + x10 * x10 + x11 * x11;
                    float ss = (sq[0] + sq[1]) + (sq[2] + sq[3]);
                    ss += __shfl_xor(ss, 16, 64); ss += __shfl_xor(ss, 32, 64);
                    const float r = rsqrtf(ss * (1.f / 64.f) + EPS) * qs;
                    x00 = x00 * r * g00; x01 = x01 * r * g01; x10 = x10 * r * g10; x11 = x11 * r * g11;
                    if (lat) {
                        const f32x4 a01 = rc_[0], a23 = rc_[1], b01 = rc_[2], b23 = rc_[3];
                        const float ca[4] = {a01[0], a01[2], a23[0], a23[2]}, sa[4] = {a01[1], a01[3], a23[1], a23[3]};
                        const float cb[4] = {b01[0], b01[2], b23[0], b23[2]}, sb[4] = {b01[1], b01[3], b23[1], b23[3]};
#pragma unroll
                        for (int j = 0; j < 4; ++j) {
                            const float p = x00[j], q = x01[j]; x00[j] = p * ca[j] - q * sa[j]; x01[j] = q * ca[j] + p * sa[j];
                            const float u = x10[j], v = x11[j]; x10[j] = u * cb[j] - v * sb[j]; x11[j] = v * cb[j] + u * sb[j];
                        }
                    }
                    store_rows_bf16(dst + (size_t)(ai * 128 + _wr * 64 + m * 16) * 3072, 3072, _fr, _fq, x00, x01, x10, x11);
#pragma unroll
                    for (int q = 0; q < 4; ++q) rc_[q] = rn_[q];
                    __builtin_amdgcn_sched_barrier(0);
                }
        } else {
#pragma unroll
            for (int ai = 0; ai < 2; ++ai)
#pragma unroll
                for (int m = 0; m < 4; ++m) {
                    store_rows_bf16(dst + (size_t)(ai * 128 + _wr * 64 + m * 16) * 3072, 3072, _fr, _fq, acc[ai][0][m][0], acc[ai][0][m][1], acc[ai][1][m][0], acc[ai][1][m][1]);
                    __builtin_amdgcn_sched_barrier(0);
                }
        }
        return true; } };
__device__ __forceinline__ void ph_gemm_qkv(const Ctx& F, int s, const bf16* A, const bf16* Bt, bf16* QKV) {
    const DenseSched S = dense_sched(F, A, D, Bt, D, MALL, 3072);
    const EpiQKV E{QKV, F.in[I_DAQN] + s * 64, F.in[I_DAKN] + s * 64, (const float2*)(F.ws + WS_AROPE)};
    gemm_phase<true>(F.lds, D, D, D, S, E);
}
__device__ __forceinline__ void ph_qknorm_rope(const Ctx& F, int s, bf16* __restrict__ QKV) {
    const int g = F.lane >> 1, half = F.lane & 1;
    const float* gn = F.in[(g < 16) ? I_DAQN : I_DAKN] + s * 64 + half * 32;
    float gv[32];
#pragma unroll
    for (int i = 0; i < 32; ++i) gv[i] = gn[i];
    const float2* art = (const float2*)(F.ws + WS_AROPE);
    for (int r = F.bid * 8 + F.wave; r < MALL; r += F.G * 8) {
        const int t = r % NTOK;
        bf16x8* p = reinterpret_cast<bf16x8*>(QKV + (size_t)r * 3072 + F.lane * 32);
        bf16x8 raw[4]; float x[32]; float ss = 0.f;
#pragma unroll
        for (int i = 0; i < 4; ++i) raw[i] = p[i];
#pragma unroll
        for (int i = 0; i < 32; ++i) { x[i] = bf2f((unsigned short)raw[i >> 3][i & 7]); ss += x[i] * x[i]; }
        ss += __shfl_xor(ss, 1, 64);
        const float rstd = rsqrtf(ss * (1.f / 64.f) + EPS);
        const float qs = (g < 16) ? 0.125f * 1.4426950408889634f : 1.f;
#pragma unroll
        for (int i = 0; i < 32; ++i) x[i] = x[i] * (rstd * qs) * gv[i];
        if (t >= CTX) {
            const int pos = t - CTX; const float2* tp = art + (half == 0 ? (pos >> 6) : 256 + (pos & 63)) * 16;
#pragma unroll
            for (int f = 0; f < 16; ++f) {
                const float2 csn = tp[f]; const float cs = csn.x, sn = csn.y;
                const float a = x[f], b = x[16 + f];
                x[f] = a * cs - b * sn; x[16 + f] = b * cs + a * sn;
            }
        }
#pragma unroll
        for (int i = 0; i < 4; ++i) { u32x4 w = {cvtpk(x[i * 8 + 0], x[i * 8 + 1]), cvtpk(x[i * 8 + 2], x[i * 8 + 3]), cvtpk(x[i * 8 + 4], x[i * 8 + 5]), cvtpk(x[i * 8 + 6], x[i * 8 + 7])};
            *reinterpret_cast<u32x4*>(&p[i]) = w; }
    }
}

#define KSWZ(row, colB) ((row) * 256 + ((colB) ^ (((row) & 7) << 4)))
#define SBAR() __builtin_amdgcn_sched_barrier(0)
constexpr int AT_SHM_V = 64 * 128 * 2, AT_SHM_K = 64 * 128 * 2;
#ifndef AT_SDEPTH
#define AT_SDEPTH 1
#endif
__device__ __forceinline__ int crow(int r, int hi) { return (r & 3) + 8 * (r >> 2) + 4 * hi; }
__device__ __forceinline__ int v_st(int k, int c) { const int kk = (k & ~0xC) | ((k & 4) << 1) | ((k & 8) >> 1); return ((kk >> 3) * 4 + (c >> 5)) * 512 + ((kk & 7) * 32 + (c & 31)) * 2; }
__device__ __forceinline__ int v_rd_base(int lane) { return ((lane & 3) << 3) | (((lane >> 2) & 3) << 6) | (((lane >> 4) & 1) << 5) | (((lane >> 5) & 1) << 8); }
constexpr int v_rd_off(int d0, int ks, int half) { return d0 * 512 + ks * 4096 + half * 2048; }
template <int OFF> __device__ __forceinline__ s16x4 tr_read(int vb) {
    s16x4 r; asm volatile("ds_read_b64_tr_b16 %0, %1 offset:%2" : "=&v"(r) : "v"(vb), "i"(OFF) : "memory"); return r;
}
template <int D0> __device__ __forceinline__ void pv_one(f32x16& od, int vb, bf16x8 pa0, bf16x8 pa1, bf16x8 pa2, bf16x8 pa3) {
#define PK(L, H) (bf16x8){L[0], L[1], L[2], L[3], H[0], H[1], H[2], H[3]}
    {   const s16x4 l0 = tr_read<v_rd_off(D0, 0, 0)>(vb), h0 = tr_read<v_rd_off(D0, 0, 1)>(vb), l1 = tr_read<v_rd_off(D0, 1, 0)>(vb), h1 = tr_read<v_rd_off(D0, 1, 1)>(vb);
        asm volatile("s_waitcnt lgkmcnt(0)" ::: "memory"); SBAR();
        od = __builtin_amdgcn_mfma_f32_32x32x16_bf16(pa0, PK(l0, h0), od, 0, 0, 0);
        od = __builtin_amdgcn_mfma_f32_32x32x16_bf16(pa1, PK(l1, h1), od, 0, 0, 0);
        asm volatile("" : "+v"(od)); }
    {   const s16x4 l2 = tr_read<v_rd_off(D0, 2, 0)>(vb), h2 = tr_read<v_rd_off(D0, 2, 1)>(vb), l3 = tr_read<v_rd_off(D0, 3, 0)>(vb), h3 = tr_read<v_rd_off(D0, 3, 1)>(vb);
        asm volatile("s_waitcnt lgkmcnt(0)" ::: "memory"); SBAR();
        od = __builtin_amdgcn_mfma_f32_32x32x16_bf16(pa2, PK(l2, h2), od, 0, 0, 0);
        od = __builtin_amdgcn_mfma_f32_32x32x16_bf16(pa3, PK(l3, h3), od, 0, 0, 0);
        asm volatile("" : "+v"(od)); }
#undef PK
}
__device__ __forceinline__ void pv_d0(f32x16* o, int vb, bf16x8 pa0, bf16x8 pa1, bf16x8 pa2, bf16x8 pa3) {
    pv_one<0>(o[0], vb, pa0, pa1, pa2, pa3); pv_one<1>(o[1], vb, pa0, pa1, pa2, pa3); pv_one<2>(o[2], vb, pa0, pa1, pa2, pa3); pv_one<3>(o[3], vb, pa0, pa1, pa2, pa3);
}
template <bool SHIFT> __device__ __forceinline__ void at_exp_half(f32x16& p, float nsh) {
#pragma unroll
    for (int r = 0; r < 16; ++r) p[r] = __builtin_amdgcn_exp2f(SHIFT ? p[r] + nsh : p[r]);
}

template <int D0> __device__ __forceinline__ void pv_two(f32x16& oa, f32x16& ob, int vb, const bf16x8 (&pa)[4], const bf16x8 (&pb)[4]) {
    const s16x4 l0 = tr_read<v_rd_off(D0, 0, 0)>(vb), h0 = tr_read<v_rd_off(D0, 0, 1)>(vb), l1 = tr_read<v_rd_off(D0, 1, 0)>(vb), h1 = tr_read<v_rd_off(D0, 1, 1)>(vb);
    const s16x4 l2 = tr_read<v_rd_off(D0, 2, 0)>(vb), h2 = tr_read<v_rd_off(D0, 2, 1)>(vb), l3 = tr_read<v_rd_off(D0, 3, 0)>(vb), h3 = tr_read<v_rd_off(D0, 3, 1)>(vb);
    asm volatile("s_waitcnt lgkmcnt(0)" ::: "memory"); SBAR();
#define PK(L, H) (bf16x8){L[0], L[1], L[2], L[3], H[0], H[1], H[2], H[3]}
    const bf16x8 v0 = PK(l0, h0), v1 = PK(l1, h1), v2 = PK(l2, h2), v3 = PK(l3, h3);
#undef PK
    oa = __builtin_amdgcn_mfma_f32_32x32x16_bf16(pa[0], v0, oa, 0, 0, 0); ob = __builtin_amdgcn_mfma_f32_32x32x16_bf16(pb[0], v0, ob, 0, 0, 0);
    oa = __builtin_amdgcn_mfma_f32_32x32x16_bf16(pa[1], v1, oa, 0, 0, 0); ob = __builtin_amdgcn_mfma_f32_32x32x16_bf16(pb[1], v1, ob, 0, 0, 0);
    oa = __builtin_amdgcn_mfma_f32_32x32x16_bf16(pa[2], v2, oa, 0, 0, 0); ob = __builtin_amdgcn_mfma_f32_32x32x16_bf16(pb[2], v2, ob, 0, 0, 0);
    oa = __builtin_amdgcn_mfma_f32_32x32x16_bf16(pa[3], v3, oa, 0, 0, 0); ob = __builtin_amdgcn_mfma_f32_32x32x16_bf16(pb[3], v3, ob, 0, 0, 0);
}
#define PK(L, H) (bf16x8){L[0], L[1], L[2], L[3], H[0], H[1], H[2], H[3]}
#define VRD(D0_, L0, H0, L1, H1) const s16x4 L0 = tr_read<v_rd_off(D0_, 2 * KH, 0)>(vb), H0 = tr_read<v_rd_off(D0_, 2 * KH, 1)>(vb), L1 = tr_read<v_rd_off(D0_, 2 * KH + 1, 0)>(vb), H1 = tr_read<v_rd_off(D0_, 2 * KH + 1, 1)>(vb)
#define VMM(OD, L0, H0, L1, H1) do { __builtin_amdgcn_s_setprio(1); OD = __builtin_amdgcn_mfma_f32_32x32x16_bf16(paA, PK(L0, H0), OD, 0, 0, 0); OD = __builtin_amdgcn_mfma_f32_32x32x16_bf16(paB, PK(L1, H1), OD, 0, 0, 0); __builtin_amdgcn_s_setprio(0); asm volatile("" : "+v"(OD)); } while (0)
template <int KH> __device__ __forceinline__ void pv_half4(f32x16 (&o)[4], int vb, bf16x8 paA, bf16x8 paB) {
    VRD(0, a0, a1, a2, a3);
    VRD(1, b0, b1, b2, b3);
    asm volatile("s_waitcnt lgkmcnt(4)" ::: "memory"); SBAR(); VMM(o[0], a0, a1, a2, a3);
    VRD(2, c0, c1, c2, c3);
    asm volatile("s_waitcnt lgkmcnt(4)" ::: "memory"); SBAR(); VMM(o[1], b0, b1, b2, b3);
    VRD(3, d0, d1, d2, d3);
    asm volatile("s_waitcnt lgkmcnt(4)" ::: "memory"); SBAR(); VMM(o[2], c0, c1, c2, c3);
    asm volatile("s_waitcnt lgkmcnt(0)" ::: "memory"); SBAR(); VMM(o[3], d0, d1, d2, d3);
}
#undef VMM
#undef VRD
#undef PK
template <int OFF> __device__ __forceinline__ bf16x8 lds_read128(int addr) {
    bf16x8 r; asm volatile("ds_read_b128 %0, %1 offset:%2" : "=&v"(r) : "v"(addr), "i"(OFF) : "memory"); return r;
}
template <int KOFF, int CMAP, bool SHIFT> __device__ __forceinline__ void at_half(const LAS unsigned char* ldsl, const int (&ksw)[4], const int (&qsw)[4], float C, float nsh, float& lsum, bf16x8& paA, bf16x8& paB) {
    f32x16 p = f32x16{};
    {
        const int lb = 0;
        const bf16x8 k0 = lds_read128<KOFF + CMAP * 8192>(lb + ksw[0]), q0 = lds_read128<CMAP * 32768>(lb + qsw[0]);
        const bf16x8 k1 = lds_read128<KOFF + CMAP * 8192>(lb + ksw[1]), q1 = lds_read128<CMAP * 32768>(lb + qsw[1]);
        const bf16x8 k2 = lds_read128<KOFF + CMAP * 8192>(lb + ksw[2]), q2 = lds_read128<CMAP * 32768>(lb + qsw[2]);
        const bf16x8 k3 = lds_read128<KOFF + CMAP * 8192>(lb + ksw[3]), q3 = lds_read128<CMAP * 32768>(lb + qsw[3]);
        asm volatile("s_waitcnt lgkmcnt(6)" ::: "memory"); SBAR(); p = __builtin_amdgcn_mfma_f32_32x32x16_bf16(k0, q0, p, 0, 0, 0);
        asm volatile("s_waitcnt lgkmcnt(4)" ::: "memory"); SBAR(); p = __builtin_amdgcn_mfma_f32_32x32x16_bf16(k1, q1, p, 0, 0, 0);
        asm volatile("s_waitcnt lgkmcnt(2)" ::: "memory"); SBAR(); p = __builtin_amdgcn_mfma_f32_32x32x16_bf16(k2, q2, p, 0, 0, 0);
        asm volatile("s_waitcnt lgkmcnt(0)" ::: "memory"); SBAR(); p = __builtin_amdgcn_mfma_f32_32x32x16_bf16(k3, q3, p, 0, 0, 0);
    }
    at_exp_half<SHIFT>(p, nsh);
    float ps = 0.f;
#pragma unroll
    for (int r = 0; r < 16; ++r) ps += p[r];
    lsum += ps;
    asm volatile("" : "+v"(lsum));
#define PK4(P, BASE, OUT) do { unsigned a0 = cvtpk(P[BASE + 0], P[BASE + 1]), a1 = cvtpk(P[BASE + 2], P[BASE + 3]);   \
    unsigned b0 = cvtpk(P[BASE + 4], P[BASE + 5]), b1 = cvtpk(P[BASE + 6], P[BASE + 7]);                              \
    auto r0 = __builtin_amdgcn_permlane32_swap(a0, b0, false, false); auto r1 = __builtin_amdgcn_permlane32_swap(a1, b1, false, false); \
    u32x4 w = {r0[0], r1[0], r0[1], r1[1]}; OUT = *reinterpret_cast<bf16x8*>(&w); } while (0)
    PK4(p, 0, paA); PK4(p, 8, paB);
#undef PK4
}
template <bool SHIFT> __device__ __forceinline__ void attn_unit(const Ctx& F, const bf16* __restrict__ QKV, bf16* __restrict__ AO, int qrow0, int krow0, int nkeys, int h,
                                          float C, float nsh, float lam, float osc, const float* __restrict__ subg) {
    LAS unsigned char* ldsl = (LAS unsigned char*)F.lds;
    char* lds = F.lds;
    const int tid = opaque_tid(), wid = __builtin_amdgcn_readfirstlane(tid >> 6), lane = tid & 63, r32a = lane & 31, hia = lane >> 5;
    constexpr int OFF_V = 0, OFF_K = 2 * AT_SHM_V, OFF_Q = 2 * AT_SHM_V + 2 * AT_SHM_K, OFF_L = OFF_Q + 256 * 256;
    const int krow = 8 * wid + (lane >> 3), kcol = ((lane & 7) ^ ((krow >> 1) & 7)) * 8;
    const int vst = 2 * wid + (lane >> 5), vkk = (vst >> 2) * 8 + ((lane & 31) >> 2), vkey = (vkk & ~0xC) | ((vkk & 4) << 1) | ((vkk & 8) >> 1), vcol = (vst & 3) * 32 + (lane & 3) * 8;
    const unsigned koff = (unsigned)(krow * 3072 + kcol) * 2u, voff = (unsigned)(vkey * 3072 + vcol) * 2u;
    const char* Kh = (const char*)(QKV + (size_t)krow0 * 3072 + 1024 + h * 128);
    const char* Vh = (const char*)(QKV + (size_t)krow0 * 3072 + 2048 + h * 128);
    const char* Qh = (const char*)(QKV + (size_t)qrow0 * 3072 + h * 128);
    const unsigned ldsw = (unsigned)wid * 1024u;
#define DMA_KV(buf, k0) do { _Pragma("unroll") for (int m_ = 0; m_ < 2; ++m_) { \
        __builtin_amdgcn_global_load_lds((const unsigned*)(Kh + (size_t)(k0) * 6144 + m_ * 128 + koff), (LAS unsigned*)(ldsl + OFF_K + (buf) * AT_SHM_K + ldsw + m_ * 8192), 16, 0, 0); \
        __builtin_amdgcn_global_load_lds((const unsigned*)(Vh + (size_t)((k0) + 32 * m_) * 6144 + voff), (LAS unsigned*)(ldsl + OFF_V + (buf) * AT_SHM_V + ldsw + m_ * 8192), 16, 0, 0); } } while (0)
    const int NT = nkeys / 64;
    __syncthreads();
#pragma unroll
    for (int m_ = 0; m_ < 8; ++m_) __builtin_amdgcn_global_load_lds((const unsigned*)(Qh + (size_t)(64 * (m_ & 3)) * 6144 + (m_ >> 2) * 128 + koff), (LAS unsigned*)(ldsl + OFF_Q + ldsw + m_ * 8192), 16, 0, 0);
    DMA_KV(0, 0);
    float lsum0 = 0.f, lsum1 = 0.f; f32x16 o0[4] = {}, o1[4] = {};
    const int vb0 = (int)(uintptr_t)(lds + OFF_V) + v_rd_base(lane);
    int ksw[4], qsw[4];
#pragma unroll
    for (int d0 = 0; d0 < 4; ++d0) { ksw[d0] = (int)(uintptr_t)lds + r32a * 128 + (((d0 * 2 + hia) ^ ((r32a >> 1) & 7)) << 4); qsw[d0] = ksw[d0] + wid * 4096 + OFF_Q; }
    asm volatile("s_waitcnt vmcnt(0)" ::: "memory"); __builtin_amdgcn_s_barrier();
#define AT_MAPHALF(B, CM, KH, OO, LS) do { bf16x8 pA_, pB_; \
        at_half<OFF_K + (B) * AT_SHM_K + (KH) * 4096, CM, SHIFT>(ldsl, ksw, qsw, C, nsh, LS, pA_, pB_); \
        const int vb_ = vb0 + (B) * AT_SHM_V; \
        pv_half4<KH>(OO, vb_, pA_, pB_); } while (0)
#define AT_TILE(B, NEXT_K0, HAS_NEXT) do { \
        if (HAS_NEXT) DMA_KV((B) ^ 1, NEXT_K0); \
        AT_MAPHALF(B, 0, 0, o0, lsum0); AT_MAPHALF(B, 0, 1, o0, lsum0); AT_MAPHALF(B, 1, 0, o1, lsum1); AT_MAPHALF(B, 1, 1, o1, lsum1); \
        asm volatile("s_waitcnt vmcnt(0)" ::: "memory"); __builtin_amdgcn_s_barrier();     \
    } while (0)
#pragma unroll 1
    for (int j = 0; j < NT; j += 2) {
        int jj = j; asm volatile("" : "+s"(jj));
        AT_TILE(0, (jj + 1) * 64, true);
        AT_TILE(1, (jj + 2) * 64, j + 2 < NT);
    }
#undef AT_TILE
#undef AT_MAPHALF
#undef DMA_KV
    const int tz = opaque_tid(), wz = tz >> 6, r32 = tz & 31, hi = (tz >> 5) & 1;
    float* li_l = (float*)(F.lds + OFF_L) + wz * 64;
    const int lz = tz & 63;
#define SHX(v, of) __uint_as_float(__builtin_amdgcn_ds_bpermute((lz ^ (of)) << 2, __float_as_uint(v)))
    lsum0 += SHX(lsum0, 32); lsum1 += SHX(lsum1, 32);
    if (hi == 0) { li_l[r32] = lsum0; li_l[32 + r32] = lsum1; }
    asm volatile("s_waitcnt lgkmcnt(0)" ::: "memory");
    float gsub[4];
#pragma unroll
    for (int d0 = 0; d0 < 4; ++d0) gsub[d0] = subg[d0 * 32 + r32] * osc;
#pragma unroll
    for (int r = 0; r < 16; ++r) {
        const float ra = 1.f / li_l[crow(r, hi)], rb = lam / li_l[32 + crow(r, hi)];
        float res[4], ss = 0.f;
#pragma unroll
        for (int d0 = 0; d0 < 4; ++d0) { res[d0] = o0[d0][r] * ra - o1[d0][r] * rb; ss += res[d0] * res[d0]; }
#pragma unroll
        for (int of = 1; of < 32; of <<= 1) ss += SHX(ss, of);
        const float rstd = rsqrtf(ss * (1.f / 128.f) + EPS);
        unsigned short* op = (unsigned short*)AO + (size_t)(qrow0 + wz * 32 + crow(r, hi)) * D + h * 128 + r32;
#pragma unroll
        for (int d0 = 0; d0 < 4; ++d0) op[d0 * 32] = f2bf(res[d0] * rstd * gsub[d0]);
        SBAR();
    }
#undef SHX
}

__device__ __forceinline__ void ph_attention(const Ctx& F, int layer, int s, bool need_ctx, const bf16* QKV, bf16* AO) {
    const float* lamp = F.in[I_DALAM] + s * 256;
    float d01 = 0.f, d23 = 0.f, mq = 0.f, mk = 0.f;
    for (int i = 0; i < 64; ++i) { d01 += lamp[i] * lamp[64 + i]; d23 += lamp[128 + i] * lamp[192 + i];
        mq = fmaxf(mq, fabsf(F.in[I_DAQN][s * 64 + i])); mk = fmaxf(mk, fabsf(F.in[I_DAKN][s * 64 + i])); }
    const float lam_init = 0.8f - 0.6f * expf(-0.3f * (float)layer);
    const float lam = expf(d01) - expf(d23) + lam_init;
    const float Mb = 8.f * mq * mk, shift = fmaxf(0.f, Mb - 30.f);
    const float C = 0.125f * 1.4426950408889634f, nsh = __uint_as_float(__builtin_amdgcn_readfirstlane(__float_as_uint(-shift * 1.4426950408889634f)));
    const float lam_u = __uint_as_float(__builtin_amdgcn_readfirstlane(__float_as_uint(lam))), osc_u = __uint_as_float(__builtin_amdgcn_readfirstlane(__float_as_uint(1.f - lam_init)));
    const float* subg = F.in[I_DASUB] + s * 128;
    const int nlat = NB * 8 * (SEQL / 256), nctx = need_ctx ? NB * 8 : 0;
#define AT_UNITS(SH) for (int u0 = F.bid; u0 < nlat + nctx; u0 += F.G) { \
        int u = u0; \
        if (u0 < nlat && F.G == 256) { const int s_ = (u0 >> 8) * 8 + (F.bid & 7); u = (s_ >> 1) * 64 + (s_ & 1) * 32 + (F.bid >> 3); }     \
        if (u < nlat) { const int qb = u % (SEQL / 256), bh = u / (SEQL / 256), h = bh % 8, b = bh / 8; \
            attn_unit<SH>(F, QKV, AO, b * NTOK + CTX + qb * 256, b * NTOK, NTOK, h, C, nsh, lam_u, osc_u, subg); } \
        else { const int bh = u - nlat, h = bh % 8, b = bh / 8; \
            attn_unit<SH>(F, QKV, AO, b * NTOK, b * NTOK, CTX, h, C, nsh, lam_u, osc_u, subg); } }
    if (nsh == 0.f) { AT_UNITS(false) } else { AT_UNITS(true) }
#undef AT_UNITS
}

__device__ __forceinline__ void cvt_tile_f8(const Ctx& F, const float* __restrict__ src, int ldsrc, unsigned char* __restrict__ dst, int lddst, int k0, int n0, int mode) {
    float* t = (float*)F.lds;
    const int kk = F.tid >> 5, nn = (F.tid & 31) * 4;
    f32x4 v[8];
#pragma unroll
    for (int h = 0; h < 8; ++h) v[h] = *reinterpret_cast<const f32x4*>(src + (size_t)(k0 + kk + 16 * h) * ldsrc + n0 + nn);
    __syncthreads();
#pragma unroll
    for (int h = 0; h < 8; ++h) *reinterpret_cast<f32x4*>(t + (kk + 16 * h) * 132 + nn) = v[h];
    __syncthreads();
#pragma unroll
    for (int h = 0; h < 4; ++h) {
        const int n = (F.tid & 31) + 32 * h, k8 = (F.tid >> 5) * 8;
        const float* p = t + k8 * 132 + n;
        float q[8];
#pragma unroll
        for (int j = 0; j < 8; ++j) q[j] = fminf(fmaxf(p[j * 132] * 32.f, -448.f), 448.f);
        unsigned w0 = 0u, w1 = 0u;
        w0 = __builtin_amdgcn_cvt_pk_fp8_f32(q[0], q[1], w0, false); w0 = __builtin_amdgcn_cvt_pk_fp8_f32(q[2], q[3], w0, true);
        w1 = __builtin_amdgcn_cvt_pk_fp8_f32(q[4], q[5], w1, false); w1 = __builtin_amdgcn_cvt_pk_fp8_f32(q[6], q[7], w1, true);
        const int ng = n0 + n;
        const int row = (mode == 0) ? ng : ((ng >> 7) * 256 + ((ng >> 2) & 1) * 128 + ((ng >> 5) & 3) * 32 + (mode == 2 ? 16 : 0) + ((ng >> 3) & 3) * 4 + (ng & 3));
        u32x2 w = {w0, w1};
        *reinterpret_cast<u32x2*>(dst + (size_t)row * lddst + k0 + k8) = w;
    }
}
__device__ __forceinline__ void cvt_matrix_f8(const Ctx& F, const float* src, int K, int N, unsigned char* dst, int lddst, int mode, int& rot, int lo) {
    const int tk = K / 128, tn = N / 128, ntile = tk * tn, Gs = F.G - lo;
    if (F.bid >= lo) {
        int first = (F.bid - lo - rot) % Gs; if (first < 0) first += Gs;
        for (int i = first; i < ntile; i += Gs) cvt_tile_f8(F, src, N, dst, lddst, (i / tn) * 128, (i % tn) * 128, mode);
    }
    rot = (rot + ntile) % Gs;
}
__device__ __forceinline__ void ph_cvt_experts(const Ctx& F, int layer, unsigned char* EXPW8) {
    int rot = 0;
    for (int e = 0; e < NEXP; ++e) {
        const size_t wo = ((size_t)layer * NEXP + e) * 1024 * 1024;
        unsigned char* dst = EXPW8 + (size_t)e * 3072 * 1024;
        const int lo = (F.G > 128) ? 64 : 0;
        cvt_matrix_f8(F, F.in[I_EW1] + wo, 1024, 1024, dst, 1024, 1, rot, lo);
        cvt_matrix_f8(F, F.in[I_EW3] + wo, 1024, 1024, dst, 1024, 2, rot, lo);
        cvt_matrix_f8(F, F.in[I_EW2] + wo, 1024, 1024, dst + (size_t)2048 * 1024, 1024, 0, rot, lo);
    }
}
__device__ __forceinline__ void ph_ffn_modulate_router(const Ctx& F, int layer, unsigned char* __restrict__ H8, bool need_ctx) {
    float* rw = (float*)F.lds;
    unsigned* __restrict__ H8w = reinterpret_cast<unsigned*>(H8);
    __syncthreads();
    for (int i = F.tid; i < 1024 * 16; i += NTHR) rw[(i & 15) * 1024 + (i >> 4)] = F.in[I_RTW][(size_t)layer * 1024 * 16 + i];
    __syncthreads();
    const float* gn = F.in[I_NFG] + layer * D;
    float* affl = (float*)(F.ws + WS_AFFL); float* affc = (float*)(F.ws + WS_AFFC);
    for (int r = F.bid * 8 + F.wave; r < MALL; r += F.G * 8) {
        const int b = r / NTOK, t = r - b * NTOK;
        if (!need_ctx && t < CTX) continue;
        const float* xp = xrow(F, r);
        const float* mb = (const float*)(F.ws + WS_MODS) + ((size_t)layer * 3 + ((t < CTX) ? 2 : b)) * 6144 + 3072;
        float4 v[4]; float ss = 0.f;
        float4 gA[4], shA[4], scA[4];
#pragma unroll
        for (int i = 0; i < 4; ++i) v[i] = *reinterpret_cast<const float4*>(xp + i * 256 + F.lane * 4);
#pragma unroll
        for (int i = 0; i < 4; ++i) { const int e0 = i * 256 + F.lane * 4; gA[i] = *reinterpret_cast<const float4*>(gn + e0); shA[i] = *reinterpret_cast<const float4*>(mb + e0); scA[i] = *reinterpret_cast<const float4*>(mb + 1024 + e0); }
#pragma unroll
        for (int i = 0; i < 4; ++i) ss += v[i].x * v[i].x + v[i].y * v[i].y + v[i].z * v[i].z + v[i].w * v[i].w;
        ss = wave_sum(ss);
        const float rstd = rsqrtf(ss * (1.f / D) + EPS);
        float lg[16];
#pragma unroll
        for (int e = 0; e < 16; ++e) lg[e] = 0.f;
#pragma unroll
        for (int i = 0; i < 4; ++i) {
            const int e0 = i * 256 + F.lane * 4;
            const float4 g = gA[i], sh = shA[i], sc = scA[i];
            float hv[4];
            hv[0] = v[i].x * rstd * g.x * (1.f + sc.x) + sh.x; hv[1] = v[i].y * rstd * g.y * (1.f + sc.y) + sh.y;
            hv[2] = v[i].z * rstd * g.z * (1.f + sc.z) + sh.z; hv[3] = v[i].w * rstd * g.w * (1.f + sc.w) + sh.w;
            { unsigned w = 0u; w = __builtin_amdgcn_cvt_pk_fp8_f32(__builtin_amdgcn_fmed3f(hv[0], -448.f, 448.f), __builtin_amdgcn_fmed3f(hv[1], -448.f, 448.f), w, false);
              w = __builtin_amdgcn_cvt_pk_fp8_f32(__builtin_amdgcn_fmed3f(hv[2], -448.f, 448.f), __builtin_amdgcn_fmed3f(hv[3], -448.f, 448.f), w, true);
              H8w[((size_t)r * D + e0) >> 2] = w; }
#pragma unroll
            for (int e = 0; e < 16; ++e) { const float4 w4 = *reinterpret_cast<const float4*>(rw + e * 1024 + e0); lg[e] += hv[0] * w4.x + hv[1] * w4.y + hv[2] * w4.z + hv[3] * w4.w; }
            __builtin_amdgcn_sched_barrier(0);
        }
        float r8[8], r4[4], r2[2], r1;
        { const bool up = (F.lane & 32) != 0;
#pragma unroll
          for (int i = 0; i < 8; ++i) { const float keep = up ? lg[8 + i] : lg[i], give = up ? lg[i] : lg[8 + i]; r8[i] = keep + __shfl_xor(give, 32, 64); } }
        { const bool up = (F.lane & 16) != 0;
#pragma unroll
          for (int i = 0; i < 4; ++i) { const float keep = up ? r8[4 + i] : r8[i], give = up ? r8[i] : r8[4 + i]; r4[i] = keep + __shfl_xor(give, 16, 64); } }
        { const bool up = (F.lane & 8) != 0;
#pragma unroll
          for (int i = 0; i < 2; ++i) { const float keep = up ? r4[2 + i] : r4[i], give = up ? r4[i] : r4[2 + i]; r2[i] = keep + __shfl_xor(give, 8, 64); } }
        { const bool up = (F.lane & 4) != 0; const float keep = up ? r2[1] : r2[0], give = up ? r2[0] : r2[1]; r1 = keep + __shfl_xor(give, 4, 64); }
        r1 += __shfl_xor(r1, 1, 64); r1 += __shfl_xor(r1, 2, 64);
        float mx = r1;
#pragma unroll
        for (int o = 4; o < 64; o <<= 1) mx = fmaxf(mx, __shfl_xor(mx, o, 64));
        const float pe = expf(r1 - mx);
        float se = pe;
#pragma unroll
        for (int o = 4; o < 64; o <<= 1) se += __shfl_xor(se, o, 64);
        if ((F.lane & 3) == 0) {
            const int e = ((F.lane >> 5) & 1) * 8 + ((F.lane >> 4) & 1) * 4 + ((F.lane >> 3) & 1) * 2 + ((F.lane >> 2) & 1);
            const float a = pe / se;
            if (t < CTX) affc[((size_t)(b * NEXP + e)) * CTX + t] = a; else affl[((size_t)(b * NEXP + e)) * SEQL + (t - CTX)] = a;
        }
    }
}
__device__ __forceinline__ int block_exscan(int v, int* tmp, int& total) {
    const int tid_ = TIDX, lane = tid_ & 63, w = tid_ >> 6;
    int inc = v;
#pragma unroll
    for (int o = 1; o < 64; o <<= 1) { const int t = __shfl_up(inc, o, 64); if (lane >= o) inc += t; }
    __syncthreads();
    if (lane == 63) tmp[w] = inc;
    __syncthreads();
    int base = 0, tot = 0;
#pragma unroll
    for (int i = 0; i < 8; ++i) { const int x = tmp[i]; if (i < w) base += x; tot += x; }
    total = tot;
    return base + inc - v;
}
__device__ __forceinline__ void topk_select(const Ctx& F, const float* __restrict__ aff, int n, int cap, int* __restrict__ rows_out, float* __restrict__ gate_out,
                                            int* __restrict__ slot_out, int rowbase, int padTo) {
    int* hist = (int*)F.lds; int* sh = hist + 4096; int* tmp = sh + 8;
    unsigned key[32];
#pragma unroll
    for (int q = 0; q < 8; ++q) {
        const int i = F.tid * 32 + q * 4;
        u32x4 v = {0u, 0u, 0u, 0u};
        if (i < n) v = *reinterpret_cast<const u32x4*>(aff + i);
        key[q * 4 + 0] = v[0]; key[q * 4 + 1] = v[1]; key[q * 4 + 2] = v[2]; key[q * 4 + 3] = v[3];
    }
    unsigned prefix = 0u; int k = cap;
#pragma unroll 1
    for (int pass = 0; pass < 3; ++pass) {
        const int shift = (pass == 0) ? 20 : (pass == 1 ? 10 : 0), nb = (pass == 0) ? 4096 : 1024, pb = nb >> 9;
        __syncthreads();
        for (int b = F.tid; b < nb; b += NTHR) hist[b] = 0;
        __syncthreads();
#pragma unroll
        for (int j = 0; j < 32; ++j) { const bool in = (pass == 0) || ((key[j] >> (shift + 10)) == prefix); if (in) atomicAdd(&hist[(key[j] >> shift) & (unsigned)(nb - 1)], 1); }
        __syncthreads();
        int mysum = 0;
        for (int b = 0; b < pb; ++b) mysum += hist[F.tid * pb + b];
        int total; const int below = block_exscan(mysum, tmp, total);
        const int above0 = total - below - mysum;
        if (above0 < k && k <= above0 + mysum) {
            int above = above0, d = F.tid * pb + pb - 1;
            for (; d > F.tid * pb; --d) { const int c = hist[d]; if (above + c >= k) break; above += c; }
            sh[0] = d; sh[1] = k - above;
        }
        __syncthreads();
        prefix = (prefix << ((pass == 0) ? 12 : 10)) | (unsigned)sh[0]; k = sh[1];
    }
    const unsigned T = prefix;
    int cgt = 0, ceq = 0;
#pragma unroll
    for (int j = 0; j < 32; ++j) { cgt += (key[j] > T) ? 1 : 0; ceq += (key[j] == T) ? 1 : 0; }
    int tot; const int eq_before = block_exscan(ceq, tmp, tot);
    int take = k - eq_before; take = take < 0 ? 0 : (take > ceq ? ceq : take);
    int slot = block_exscan(cgt + take, tmp, tot);
#pragma unroll
    for (int j = 0; j < 32; ++j) {
        const int i = F.tid * 32 + j;
        bool sel = key[j] > T;
        if (key[j] == T && take > 0) { sel = true; --take; }
        if (i < n) {
            if (sel) { rows_out[slot] = rowbase + i; gate_out[slot] = __uint_as_float(key[j]); slot_out[i] = slot; ++slot; }
            else slot_out[i] = -1;
        }
    }
    for (int s2 = cap + F.tid; s2 < padTo; s2 += NTHR) { rows_out[s2] = rowbase; gate_out[s2] = 0.f; }
}
__device__ __forceinline__ void ph_topk(const Ctx& F, bool need_ctx) {
    int* rows = (int*)(F.ws + WS_ROWS); float* gv = (float*)(F.ws + WS_GATEV);
    const int nprob = NB * NEXP * (need_ctx ? 2 : 1);
    for (int p = F.bid; p < nprob; p += F.G) {
        if (p < NB * NEXP) { const int b = p / NEXP;
            topk_select(F, (const float*)(F.ws + WS_AFFL) + (size_t)p * SEQL, SEQL, CAPL, rows + p * CAPL, gv + p * CAPL, (int*)(F.ws + WS_SLOTL) + (size_t)p * SEQL, b * NTOK + CTX, CAPL);
        } else { const int q = p - NB * NEXP, b = q / NEXP;
            topk_select(F, (const float*)(F.ws + WS_AFFC) + (size_t)q * CTX, CTX, CAPC, rows + NB * NEXP * CAPL + q * 256, gv + NB * NEXP * CAPL + q * 256, (int*)(F.ws + WS_SLOTC) + (size_t)q * CTX, b * NTOK, 256);
        }
    }
}
__device__ __forceinline__ void ph_gather(const Ctx& F, const bf16* __restrict__ H, bf16* __restrict__ XG, int nflat) {
    const int* rows = (const int*)(F.ws + WS_ROWS);
    for (int f = F.bid * 8 + F.wave; f < nflat; f += F.G * 8) {
        const u32x4* s = reinterpret_cast<const u32x4*>(H + (size_t)rows[f] * D);
        u32x4* d = reinterpret_cast<u32x4*>(XG + (size_t)f * D);
        d[F.lane] = s[F.lane]; d[64 + F.lane] = s[64 + F.lane];
    }
}
__device__ __forceinline__ bool moe_unit(int bid, int G, int i, int nN, int nrt, int& rt, int& pn) {
    if ((G & 7) != 0 || (nN & 3) != 0) { const int t = bid + i * G; if (t >= nrt * nN) return false; rt = t / nN; pn = t - rt * nN; return true; }
    const int x = bid & 7, lb = bid >> 3, W = G >> 3, v = lb + i * W;
    const int per_g = 8 * nN, nlat = 4 * per_g;
    if (v < nlat) { const int gl = v / per_g, rem = v - gl * per_g, pnb = rem >> 5, r2 = rem & 31; rt = (x + 8 * gl) * 8 + (r2 >> 2); pn = pnb * 4 + (r2 & 3); return true; }
    const int w = v - nlat, nct = (nrt > 256) ? 4 : 0;
    if (w >= nct * nN) return false;
    const int c = w / nN; rt = 256 + x + 8 * c; pn = w - c * nN; return true;
}
struct MoeSched {
    const char* A; const char* W; size_t wsub; int nN, nrt, bid, G; size_t rowb;
    __device__ __forceinline__ bool get(int i, GUnit& u) const {
        int rt, pn; if (!moe_unit(bid, G, i, nN, nrt, rt, pn)) return false;
        const int e = (rt < 256) ? ((rt >> 3) & 15) : ((rt - 256) & 15);
        u.a = A + (size_t)rt * 256 * rowb; u.b = W + (size_t)e * 3072 * rowb + wsub + (size_t)pn * 256 * rowb; u.id = rt * nN + pn; return true; }
};
struct EpiMoeUp { unsigned char* HID;
    __device__ __forceinline__ bool operator()(Acc& acc, int t) const {
        const int brow = (t / 8) * 256, bcol = (t % 8) * 256;
        const int _t = opaque_tid(), _w = _t >> 6, _l = _t & 63, _wr = _w >> 2, _wc = _w & 3, _fr = _l & 15, _fq = _l >> 4;
#pragma unroll
        for (int ai = 0; ai < 2; ++ai)
#pragma unroll
            for (int m = 0; m < 4; ++m) {
                const int row = brow + ai * 128 + _wr * 64 + m * 16 + _fr, f = bcol / 2 + _wc * 32 + _fq * 8;
                unsigned w2[2];
#pragma unroll
                for (int bj = 0; bj < 2; ++bj) {
                    const f32x4 a = acc[ai][bj][m][0] * 0.03125f, g = acc[ai][bj][m][1] * 0.03125f;
                    float h[4];
#pragma unroll
                    for (int j = 0; j < 4; ++j) h[j] = __builtin_amdgcn_fmed3f(silu_fast(a[j]) * g[j], -448.f, 448.f);
                    unsigned w = 0u; w = __builtin_amdgcn_cvt_pk_fp8_f32(h[0], h[1], w, false); w = __builtin_amdgcn_cvt_pk_fp8_f32(h[2], h[3], w, true);
                    w2[bj] = w;
                }
                const u32x2 ww = {w2[0], w2[1]};
                *reinterpret_cast<u32x2*>(HID + (size_t)row * D + f) = ww;
            }
        return true; } };
struct EpiMoeDown { bf16* Y; const float* gate;
    __device__ __forceinline__ bool operator()(Acc& acc, int t) const {
        const int brow = (t / 4) * 256, bcol = (t % 4) * 256;
        const int _t = opaque_tid(), _w = _t >> 6, _l = _t & 63, _wr = _w >> 2, _wc = _w & 3, _fr = _l & 15, _fq = _l >> 4;
        const float* gp = gate + brow + _wr * 64 + _fr;
        float g8[2][4];
#pragma unroll
        for (int ai = 0; ai < 2; ++ai)
#pragma unroll
            for (int m = 0; m < 4; ++m) g8[ai][m] = gp[ai * 128 + m * 16] * 0.03125f;
        bf16* dst = Y + (size_t)(brow + _wr * 64) * D + bcol + _wc * 64;
#pragma unroll
        for (int ai = 0; ai < 2; ++ai)
#pragma unroll
            for (int m = 0; m < 4; ++m) {
                const float g = g8[ai][m];
                store_rows_bf16(dst + (size_t)(ai * 128 + m * 16) * D, D, _fr, _fq, acc[ai][0][m][0] * g, acc[ai][0][m][1] * g, acc[ai][1][m][0] * g, acc[ai][1][m][1] * g);
                __builtin_amdgcn_sched_barrier(0);
            }
        return true; } };
struct MoeGSched {
    const char* A; const char* W; const int* rowidx; int nN, nrt, bid, G; size_t rowb;
    __device__ __forceinline__ bool get(int i, GUnit& u) const {
        int rt, pn; if (!moe_unit(bid, G, i, nN, nrt, rt, pn)) return false;
        const int e = (rt < 256) ? ((rt >> 3) & 15) : ((rt - 256) & 15);
        u.a = A; u.b = W + (size_t)e * 3072 * rowb + (size_t)pn * 256 * rowb; u.id = rt * nN + pn; return true; }
    __device__ __forceinline__ const int* rows(const GUnit& u) const { return rowidx + (u.id / nN) * 256; }
};
__device__ __forceinline__ void ph_moe_up(const Ctx& F, const unsigned char* H8, const unsigned char* EXPW8, unsigned char* HID8, int nrt) {
    MoeGSched S; S.A = (const char*)H8; S.W = (const char*)EXPW8; S.rowidx = (const int*)(F.ws + WS_ROWS); S.nN = 8; S.nrt = nrt; S.bid = F.bid; S.G = F.G; S.rowb = 1024;
    const EpiMoeUp E{HID8};
    gemm_phase<true, MoeGSched, EpiMoeUp, true, true>(F.lds, 512, 512, 512, S, E);
}
__device__ __forceinline__ void ph_moe_down(const Ctx& F, const unsigned char* HID8, const unsigned char* EXPW8, bf16* Y, int nrt) {
    MoeSched S; S.A = (const char*)HID8; S.W = (const char*)EXPW8; S.wsub = (size_t)2048 * 1024; S.nN = 4; S.nrt = nrt; S.bid = F.bid; S.G = F.G; S.rowb = 1024;
    const EpiMoeDown E{Y, (const float*)(F.ws + WS_GATEV)};
    gemm_phase<true, MoeSched, EpiMoeDown, false, true, true>(F.lds, 512, 512, 512, S, E);
}
__device__ __forceinline__ void ph_moe_combine(const Ctx& F, int layer, const bf16* __restrict__ Y, bool need_ctx, int next_layer, bf16* __restrict__ H) {
    const int* slotl = (const int*)(F.ws + WS_SLOTL); const int* slotc = (const int*)(F.ws + WS_SLOTC);
    for (int r = F.bid * 8 + F.wave; r < MALL; r += F.G * 8) {
        const int b = r / NTOK, t = r - b * NTOK;
        if (!need_ctx && t < CTX) continue;
        float acc[16];
#pragma unroll
        for (int i = 0; i < 16; ++i) acc[i] = 0.f;
        int flatv = -1;
        if (F.lane < NEXP) {
            if (t < CTX) { const int s = slotc[(size_t)(b * NEXP + F.lane) * CTX + t]; flatv = (s < 0) ? -1 : NB * NEXP * CAPL + (b * NEXP + F.lane) * 256 + s; }
            else { const int s = slotl[(size_t)(b * NEXP + F.lane) * SEQL + (t - CTX)]; flatv = (s < 0) ? -1 : (b * NEXP + F.lane) * CAPL + s; }
        }
        float* xp = xrow(F, r) + F.lane * 4;
        float4 xv[4];
#pragma unroll
        for (int i = 0; i < 4; ++i) xv[i] = *reinterpret_cast<const float4*>(xp + i * 256);
        unsigned long long mask = __ballot(flatv >= 0);
        while (mask) {
            const int e0 = __builtin_ctzll(mask); mask &= mask - 1;
            const bool two = mask != 0ull;
            const int e1 = two ? __builtin_ctzll(mask) : e0; if (two) mask &= mask - 1;
            const int f0 = __shfl(flatv, e0, 64), f1 = __shfl(flatv, e1, 64);
            const u32x2* yp0 = reinterpret_cast<const u32x2*>(Y + (size_t)f0 * D + F.lane * 4);
            const u32x2* yp1 = reinterpret_cast<const u32x2*>(Y + (size_t)f1 * D + F.lane * 4);
            u32x2 a[4], c[4];
#pragma unroll
            for (int i = 0; i < 4; ++i) { a[i] = yp0[i * 64]; c[i] = yp1[i * 64]; }
            const float w1 = two ? 1.f : 0.f;
#pragma unroll
            for (int i = 0; i < 4; ++i) {
                acc[i * 4 + 0] += __uint_as_float(a[i][0] << 16) + w1 * __uint_as_float(c[i][0] << 16); acc[i * 4 + 1] += __uint_as_float(a[i][0] & 0xffff0000u) + w1 * __uint_as_float(c[i][0] & 0xffff0000u);
                acc[i * 4 + 2] += __uint_as_float(a[i][1] << 16) + w1 * __uint_as_float(c[i][1] << 16); acc[i * 4 + 3] += __uint_as_float(a[i][1] & 0xffff0000u) + w1 * __uint_as_float(c[i][1] & 0xffff0000u);
            }
        }
        const int ms = (t < CTX) ? 2 : b;
        const float* g2 = (const float*)(F.ws + WS_MODS) + ((size_t)layer * 3 + ms) * 6144 + 5120 + F.lane * 4;
        float ss = 0.f;
#pragma unroll
        for (int i = 0; i < 4; ++i) {
            float4 x = xv[i]; const float4 g = *reinterpret_cast<const float4*>(g2 + i * 256);
            x.x += g.x * acc[i * 4 + 0]; x.y += g.y * acc[i * 4 + 1]; x.z += g.z * acc[i * 4 + 2]; x.w += g.w * acc[i * 4 + 3];
            *reinterpret_cast<float4*>(xp + i * 256) = x;
            xv[i] = x;
            ss += x.x * x.x + x.y * x.y + x.z * x.z + x.w * x.w;
        }
        if (next_layer >= 0) {
            ss = wave_sum(ss);
            const float rstd = rsqrtf(ss * (1.f / D) + EPS);
            const float* gn = F.in[I_NMG] + next_layer * D + F.lane * 4;
            const float* mb = (const float*)(F.ws + WS_MODS) + ((size_t)next_layer * 3 + ms) * 6144 + F.lane * 4;
            bf16* hp = H + (size_t)r * D + F.lane * 4;
#pragma unroll
            for (int i = 0; i < 4; ++i) {
                const float4 g = *reinterpret_cast<const float4*>(gn + i * 256), sh = *reinterpret_cast<const float4*>(mb + i * 256), sc = *reinterpret_cast<const float4*>(mb + 1024 + i * 256);
                const float4 x = xv[i];
                u32x2 w = {cvtpk(x.x * rstd * g.x * (1.f + sc.x) + sh.x, x.y * rstd * g.y * (1.f + sc.y) + sh.y), cvtpk(x.z * rstd * g.z * (1.f + sc.z) + sh.z, x.w * rstd * g.w * (1.f + sc.w) + sh.w)};
                *reinterpret_cast<u32x2*>(hp + i * 256) = w;
            }
        }
    }
}

struct RetC { const float* tab;
    __device__ __forceinline__ float lg2(int dir, int h) const { return tab[dir * 4 + h]; } };
__device__ __forceinline__ RetC ret_consts(const Ctx& F) { RetC c; c.tab = (const float*)(F.ws + WS_RETC); return c; }
struct EpiRetIn { bf16 *Q, *KR, *KFT, *KBT, *VT, *SG; RetC rc; const float* rope;
    __device__ __forceinline__ bool operator()(Acc& acc, int t) const {
        const int pm = t / 24, pn = t - pm * 24, brow = pm * 256;
        const int b = brow / NTOK, tt0 = brow - b * NTOK;
        const int _t = opaque_tid(), _w = _t >> 6, _l = _t & 63, _wr = _w >> 2, _wc = _w & 3, _fr = _l & 15, _fq = _l >> 4;
        if (pn < 8) {
            const bool isk = pn >= 4; const int h = pn & 3;
            if (isk) {
#pragma unroll
                for (int ai = 0; ai < 2; ++ai) for (int bj = 0; bj < 2; ++bj) for (int m = 0; m < 4; ++m) for (int n = 0; n < 2; ++n) acc[ai][bj][m][n] *= 0.0625f;
            }
            if (tt0 >= CTX) {
                const float* rbase = rope + ((size_t)(tt0 - CTX + _wr * 64 + _fr) * 128 + _wc * 32 + 4 * _fq) * 2;
                f32x4 rc_[4], rn_[4] = {};
                { const f32x4* tp = reinterpret_cast<const f32x4*>(rbase); rc_[0] = tp[0]; rc_[1] = tp[1]; rc_[2] = tp[8]; rc_[3] = tp[9]; }
#pragma unroll
                for (int ai = 0; ai < 2; ++ai)
#pragma unroll
                    for (int m = 0; m < 4; ++m) {
                        if ((ai * 4 + m) < 7) { const int kn = ai * 4 + m + 1;
                            const f32x4* tp = reinterpret_cast<const f32x4*>(rbase + (size_t)((kn >> 2) * 128 + (kn & 3) * 16) * 256); rn_[0] = tp[0]; rn_[1] = tp[1]; rn_[2] = tp[8]; rn_[3] = tp[9]; }
#pragma unroll
                        for (int n = 0; n < 2; ++n) {
                            const f32x4 c01 = rc_[n * 2], c23 = rc_[n * 2 + 1];
                            const float cs[4] = {c01[0], c01[2], c23[0], c23[2]}, sn[4] = {c01[1], c01[3], c23[1], c23[3]};
#pragma unroll
                            for (int j = 0; j < 4; ++j) {
                                const float x1 = acc[ai][0][m][n][j], x2 = acc[ai][1][m][n][j];
                                acc[ai][0][m][n][j] = x1 * cs[j] - x2 * sn[j]; acc[ai][1][m][n][j] = x2 * cs[j] + x1 * sn[j];
                            }
                        }
#pragma unroll
                        for (int q = 0; q < 4; ++q) rc_[q] = rn_[q];
                        __builtin_amdgcn_sched_barrier(0);
                    }
            }
            bf16* dst = isk ? KR : Q;
            acc_foreach<true>(acc, [&](int row, int col4, f32x4 v) {
                u32x2 w = {cvtpk(v[0], v[1]), cvtpk(v[2], v[3])};
                *reinterpret_cast<u32x2*>(dst + (size_t)(brow + row) * D + h * 256 + col4) = w; });
            if (isk) {
                const float lf = rc.lg2(0, h), lb = rc.lg2(1, h);
                unsigned short* kft = (unsigned short*)KFT + (size_t)((b * 4 + h) * 256) * NTOK + tt0;
                unsigned short* kbt = (unsigned short*)KBT + (size_t)((b * 4 + h) * 256) * NTOK + tt0;
                acc_foreach<true>(acc, [&](int row, int col4, f32x4 v) {
                    const float wf = __builtin_amdgcn_exp2f((float)(RCH - 1 - row) * lf), wb = __builtin_amdgcn_exp2f((float)row * lb);
#pragma unroll
                    for (int j = 0; j < 4; ++j) { kft[(size_t)(col4 + j) * NTOK + row] = f2bf(v[j] * wf); kbt[(size_t)(col4 + j) * NTOK + row] = f2bf(v[j] * wb); } });
            }
        } else if (pn < 16) {
            const int h = (pn - 8) >> 1, e0 = ((pn - 8) & 1) * 256;
            unsigned short* vt = (unsigned short*)VT + (size_t)((b * 4 + h) * 512 + e0) * NTOK + tt0;
            acc_foreach<true>(acc, [&](int row, int col4, f32x4 v) {
#pragma unroll
                for (int j = 0; j < 4; ++j) vt[(size_t)(col4 + j) * NTOK + row] = f2bf(v[j]); });
        } else {
            const int c0 = (pn - 16) * 256;
            bf16* dst = SG + (size_t)(brow + _wr * 64) * 2048 + c0 + _wc * 64;
#pragma unroll
            for (int ai = 0; ai < 2; ++ai)
#pragma unroll
                for (int m = 0; m < 4; ++m) {
                    f32x4 s[2][2];
#pragma unroll
                    for (int bj = 0; bj < 2; ++bj)
#pragma unroll
                        for (int n = 0; n < 2; ++n)
#pragma unroll
                            for (int j = 0; j < 4; ++j) s[bj][n][j] = silu_fast(acc[ai][bj][m][n][j]);
                    store_rows_bf16(dst + (size_t)(ai * 128 + m * 16) * 2048, 2048, _fr, _fq, s[0][0], s[0][1], s[1][0], s[1][1]);
                    __builtin_amdgcn_sched_barrier(0);
                }
        }
        return true; } };
struct RetPSched { const char* Q; const char* K; int bid, G;
    __device__ __forceinline__ bool get(int i, GUnit& u) const {
        const int t = bid + i * G; if (t >= 8 * RNC) return false;
        const int bh = t / RNC, cc = t - bh * RNC, b = bh >> 2, h = bh & 3;
        const size_t off = ((size_t)(b * NTOK + cc * RCH) * D + h * 256) * 2;
        u.a = Q + off; u.b = K + off; u.id = t; return true; } };
struct EpiRetP { bf16* P; RetC rc;
    __device__ __forceinline__ bool operator()(Acc& acc, int t) const {
        const int bh = t / RNC, cc = t - bh * RNC, b = bh >> 2, h = bh & 3;
        const float lf = rc.lg2(0, h), lb = rc.lg2(1, h);
        const int _t = opaque_tid(), _w = _t >> 6, _l = _t & 63, _wr = _w >> 2, _wc = _w & 3, _fr = _l & 15, _fq = _l >> 4;
        bf16* dst = P + (size_t)(b * NTOK + cc * RCH + _wr * 64) * D + h * 256 + _wc * 64;
#pragma unroll
        for (int ai = 0; ai < 2; ++ai)
#pragma unroll
            for (int m = 0; m < 4; ++m) {
                const int row = ai * 128 + _wr * 64 + m * 16 + _fr;
                f32x4 o[2][2];
#pragma unroll
                for (int bj = 0; bj < 2; ++bj)
#pragma unroll
                    for (int n = 0; n < 2; ++n) {
                        const f32x4 v = acc[ai][bj][m][n];
#pragma unroll
                        for (int j = 0; j < 4; ++j) { const int d = row - (_wc * 64 + _fq * 16 + bj * 8 + n * 4 + j); o[bj][n][j] = v[j] * __builtin_amdgcn_exp2f(d >= 0 ? (float)d * lf : (float)(-d) * lb); }
                    }
                store_rows_bf16(dst + (size_t)(ai * 128 + m * 16) * D, D, _fr, _fq, o[0][0], o[0][1], o[1][0], o[1][1]);
                __builtin_amdgcn_sched_barrier(0);
            }
        return true; } };
struct RetSSched { const char* VT; const char* KFT; const char* KBT; int bid, G;
    __device__ __forceinline__ bool get(int i, GUnit& u) const {
        const int t = bid + i * G; if (t >= 2 * 8 * RNC * 2) return false;
        const int eh = t & 1, r = t >> 1, cc = r % RNC, q = r / RNC, bh = q & 7, dir = q >> 3;
        u.a = VT + ((size_t)(bh * 512 + eh * 256) * NTOK + cc * RCH) * 2;
        u.b = (dir ? KBT : KFT) + ((size_t)(bh * 256) * NTOK + cc * RCH) * 2; u.id = t; return true; } };
struct EpiRetS { bf16* ST;
    __device__ __forceinline__ bool operator()(Acc& acc, int t) const {
        const int eh = t & 1, r = t >> 1, cc = r % RNC, q = r / RNC;
        const int _t = opaque_tid(), _w = _t >> 6, _l = _t & 63, _wr = _w >> 2, _wc = _w & 3, _fr = _l & 15, _fq = _l >> 4;
        bf16* dst = ST + ((size_t)(q * 512 + eh * 256 + _wr * 64)) * NTOK + cc * RCH + _wc * 64;
#pragma unroll
        for (int ai = 0; ai < 2; ++ai)
#pragma unroll
            for (int m = 0; m < 4; ++m) {
                store_rows_bf16(dst + (size_t)(ai * 128 + m * 16) * NTOK, NTOK, _fr, _fq, acc[ai][0][m][0], acc[ai][0][m][1], acc[ai][1][m][0], acc[ai][1][m][1]);
                __builtin_amdgcn_sched_barrier(0);
            }
        return true; } };
__device__ __forceinline__ void ph_ret_scan(const Ctx& F, bf16* ST, const RetC& rc) {
    const int nel = 2 * 8 * 512 * 256;
    for (int x = F.bid * NTHR + F.tid; x < nel; x += F.G * NTHR) {
        const int d = x & 255, e = (x >> 8) & 511, q = x >> 17, dir = q >> 3, h = q & 3;
        unsigned short* p = (unsigned short*)ST + ((size_t)(q * 512 + e)) * NTOK + d;
        const float Dk = __builtin_amdgcn_exp2f((float)RCH * rc.lg2(dir, h));
        unsigned short v[RNC];
#pragma unroll
        for (int cc = 0; cc < RNC; ++cc) v[cc] = p[cc * RCH];
        if (dir == 0) {
            float st = 0.f;
#pragma unroll
            for (int cc = 0; cc < RNC; ++cc) { const float s = bf2f(v[cc]); p[cc * RCH] = f2bf(st); st = Dk * st + s; }
        } else {
            float st = bf2f(v[0]); p[0] = 0;
#pragma unroll
            for (int cc = RNC - 1; cc >= 1; --cc) { const float s = bf2f(v[cc]); p[cc * RCH] = f2bf(st); st = Dk * st + s; }
        }
    }
}
struct RetOSched { const char* Q; const char* P; const char* ST; const char* VT; int bid, G, cnt;
    __device__ __forceinline__ bool get(int i, GUnit& u) const {
        const int ti = i / 3, s = i - ti * 3; const int t = bid + ti * G; if (t >= 8 * RNC * 2) return false;
        const int eh = t & 1, r = t >> 1, cc = r % RNC, bh = r / RNC, b = bh >> 2, h = bh & 3;
        const size_t qoff = ((size_t)(b * NTOK + cc * RCH) * D + h * 256) * 2;
        if (s < 2) { u.a = Q + qoff; u.b = ST + ((size_t)((s * 8 + bh) * 512 + eh * 256) * NTOK + cc * RCH) * 2; }
        else { u.a = P + qoff; u.b = VT + ((size_t)(bh * 512 + eh * 256) * NTOK + cc * RCH) * 2; }
        u.id = t * 3 + s; return true; } };
struct EpiRetO { bf16* O; RetC rc;
    __device__ __forceinline__ bool operator()(Acc& acc, int id) const {
        const int t = id / 3, s = id - t * 3;
        const int eh = t & 1, r = t >> 1, cc = r % RNC, bh = r / RNC, b = bh >> 2, h = bh & 3;
        const float lf = rc.lg2(0, h), lb = rc.lg2(1, h);
        const int _t = opaque_tid(), _w = _t >> 6, _l = _t & 63, _wr = _w >> 2, _fr = _l & 15;
#pragma unroll
        for (int ai = 0; ai < 2; ++ai)
#pragma unroll
            for (int m = 0; m < 4; ++m) {
                const int il = ai * 128 + _wr * 64 + m * 16 + _fr;
                const float xf = (float)(il + 1) * lf, xb = (float)(RCH - il) * lb;
                const float sc = __builtin_amdgcn_exp2f(s == 0 ? xf - xb : (s == 1 ? xb : 0.f));
#pragma unroll
                for (int bj = 0; bj < 2; ++bj)
#pragma unroll
                    for (int n = 0; n < 2; ++n) acc[ai][bj][m][n] *= sc;
            }
        if (s < 2) return false;
        const int _wc = _w & 3, _fq = _l >> 4;
        bf16* dst = O + (size_t)(b * NTOK + cc * RCH + _wr * 64) * 2048 + h * 512 + eh * 256 + _wc * 64;
#pragma unroll
        for (int ai = 0; ai < 2; ++ai)
#pragma unroll
            for (int m = 0; m < 4; ++m) {
                store_rows_bf16(dst + (size_t)(ai * 128 + m * 16) * 2048, 2048, _fr, _fq, acc[ai][0][m][0], acc[ai][0][m][1], acc[ai][1][m][0], acc[ai][1][m][1]);
                __builtin_amdgcn_sched_barrier(0);
            }
        return true; } };
__device__ __forceinline__ void ph_ret_gate(const Ctx& F, bf16* __restrict__ O, const bf16* __restrict__ SG) {
    const float* gng = F.in[I_RGN] + F.lane * 8;
    const f32x4 ga = *reinterpret_cast<const f32x4*>(gng), gb = *reinterpret_cast<const f32x4*>(gng + 4);
    const float gn[8] = {ga[0], ga[1], ga[2], ga[3], gb[0], gb[1], gb[2], gb[3]};
    for (int r = F.bid * 8 + F.wave; r < MALL; r += F.G * 8) {
        u32x4* op = reinterpret_cast<u32x4*>(O + (size_t)r * 2048 + F.lane * 8);
        const u32x4* gp = reinterpret_cast<const u32x4*>(SG + (size_t)r * 2048 + F.lane * 8);
        u32x4 ov[4], gv[4];
#pragma unroll
        for (int h = 0; h < 4; ++h) { ov[h] = op[h * 64]; gv[h] = gp[h * 64]; }
#pragma unroll
        for (int h = 0; h < 4; ++h) {
            float x[8]; float ss = 0.f;
#pragma unroll
            for (int q = 0; q < 4; ++q) { x[2 * q] = __uint_as_float(ov[h][q] << 16); x[2 * q + 1] = __uint_as_float(ov[h][q] & 0xffff0000u); ss += x[2 * q] * x[2 * q] + x[2 * q + 1] * x[2 * q + 1]; }
            ss = wave_sum(ss);
            const float rstd = rsqrtf(ss * (1.f / 512.f) + EPS);
            u32x4 w;
#pragma unroll
            for (int q = 0; q < 4; ++q) w[q] = cvtpk(x[2 * q] * rstd * gn[2 * q] * __uint_as_float(gv[h][q] << 16), x[2 * q + 1] * rstd * gn[2 * q + 1] * __uint_as_float(gv[h][q] & 0xffff0000u));
            op[h * 64] = w;
        }
    }
}

__device__ __forceinline__ void hy_features(const Ctx& F, int n, bf16* A2P, float* A2C) {
    const float* w1 = F.in[I_HW1]; const float* b1 = F.in[I_HB1]; const float* w2 = F.in[I_HW2]; const float* b2 = F.in[I_HB2]; const float* fr = F.in[I_HFREQ];
    const int j = F.lane;
    for (int t = F.bid * 8 + F.wave; t < n; t += F.G * 8) {
        const float tn = (float)t / (float)(n - 1), w = 6.283185307179586f * (float)t / (float)n;
        float s = tn * w1[j] + b1[j];
        const float fl = 1e-4f + (float)(j & 15) * ((15.f - 1e-4f) / 15.f);
        const float csv = (j & 16) ? sinf(fl * w) : cosf(fl * w);
#pragma unroll
        for (int k = 0; k < 16; ++k) s += __shfl(csv, k, 64) * w1[(1 + k) * 64 + j] - __shfl(csv, 16 + k, 64) * w1[(17 + k) * 64 + j];
        const float a1 = sinf(fr[j] * s);
        float s2 = b2[j];
        for (int i = 0; i < 64; ++i) s2 += __shfl(a1, i, 64) * w2[i * 64 + j];
        const float a2 = sinf(fr[64 + j] * s2);
        if (A2C) A2C[t * 64 + j] = a2;
        else { const unsigned short hi = f2bf(a2), lo = f2bf(a2 - bf2f(hi)); unsigned short* p = (unsigned short*)A2P + (size_t)t * 256;
            p[j] = hi; p[64 + j] = lo; p[128 + j] = hi; p[192 + j] = 0; }
    }
}
__device__ __forceinline__ void hy_prologue(const Ctx& F) {
    hy_features(F, FN, (bf16*)(F.ws + WS_A2P), nullptr);
    hy_features(F, CTX, nullptr, (float*)(F.ws + WS_A2C));
    unsigned short* w3p = (unsigned short*)(F.ws + WS_W3P);
    for (int i = F.bid * NTHR + F.tid; i < 4096 * 64; i += F.G * NTHR) {
        const int k = i >> 12, col = i & 4095; const float w = F.in[I_HW3][i];
        const unsigned short hi = f2bf(w), lo = f2bf(w - bf2f(hi)); unsigned short* p = w3p + (size_t)col * 256;
        p[k] = hi; p[64 + k] = hi; p[128 + k] = lo; p[192 + k] = 0; }
}
struct EpiHyIn { bf16* PT; const float* bin;
    __device__ __forceinline__ bool operator()(Acc& acc, int t) const {
        const int brow = (t / 12) * 256, bcol = (t % 12) * 256;
        acc_foreach<false>(acc, [&](int row4, int col, f32x4 v) {
            const float bs = bin[bcol + col];
            u32x2 w = {cvtpk(v[0] + bs, v[1] + bs), cvtpk(v[2] + bs, v[3] + bs)};
            *reinterpret_cast<u32x2*>(PT + (size_t)(bcol + col) * MALL + brow + row4) = w; });
        return true; } };
struct EpiHyTaps { bf16* HT;
    __device__ __forceinline__ bool operator()(Acc& acc, int t) const {
        const int brow = (t / 64) * 256, bcol = (t % 64) * 256;
        const int _t = opaque_tid(), _w = _t >> 6, _l = _t & 63, _wr = _w >> 2, _wc = _w & 3, _fr = _l & 15, _fq = _l >> 4;
        bf16* dst = HT + (size_t)(brow + _wr * 64) * FN + bcol + _wc * 64;
#pragma unroll
        for (int ai = 0; ai < 2; ++ai)
#pragma unroll
            for (int m = 0; m < 4; ++m) {
                const int c = (brow + ai * 128 + _wr * 64 + m * 16 + _fr) & 1023;
                const float delta = fabsf(-3.0701134573253944f + (-15.350567286626972f + 3.0701134573253944f) * ((float)c * (1.f / 1023.f)));
                f32x4 o[2][2];
#pragma unroll
                for (int bj = 0; bj < 2; ++bj)
#pragma unroll
                    for (int n = 0; n < 2; ++n)
#pragma unroll
                        for (int j = 0; j < 4; ++j) o[bj][n][j] = acc[ai][bj][m][n][j] * __expf(-(float)(bcol + _wc * 64 + _fq * 16 + bj * 8 + n * 4 + j) * (1.f / (float)(FN - 1)) * delta);
                store_rows_bf16(dst + (size_t)(ai * 128 + m * 16) * FN, FN, _fr, _fq, o[0][0], o[0][1], o[1][0], o[1][1]);
                __builtin_amdgcn_sched_barrier(0);
            }
        return true; } };

__device__ __forceinline__ int fphys(int i) { return i + ((i >> 5) << 1); }
constexpr int FFT_LDS = (FN + 2 * (FN / 32)) * 8;
__device__ __forceinline__ float2 cmul(float2 a, float2 b) { return make_float2(a.x * b.x - a.y * b.y, a.x * b.y + a.y * b.x); }
__device__ __forceinline__ float2 cmulc(float2 a, float2 b) { return make_float2(a.x * b.x + a.y * b.y, a.y * b.x - a.x * b.y); }
__device__ __forceinline__ float2 unitrev(float x) { return make_float2(__builtin_amdgcn_cosf(x), __builtin_amdgcn_sinf(x)); }
template <int L, bool INV> __device__ __forceinline__ void bfly(float2 (&x)[1 << L]) {
    constexpr int n = 1 << L;
    constexpr float C32[16] = {1.000000000e+00f, 9.807852804e-01f, 9.238795325e-01f, 8.314696123e-01f, 7.071067812e-01f, 5.555702330e-01f, 3.826834324e-01f, 1.950903220e-01f, 6.123233996e-17f, -1.950903220e-01f, -3.826834324e-01f, -5.555702330e-01f, -7.071067812e-01f, -8.314696123e-01f, -9.238795325e-01f, -9.807852804e-01f};
    constexpr float S32[16] = {0.000000000e+00f, 1.950903220e-01f, 3.826834324e-01f, 5.555702330e-01f, 7.071067812e-01f, 8.314696123e-01f, 9.238795325e-01f, 9.807852804e-01f, 1.000000000e+00f, 9.807852804e-01f, 9.238795325e-01f, 8.314696123e-01f, 7.071067812e-01f, 5.555702330e-01f, 3.826834324e-01f, 1.950903220e-01f};
    if (!INV) {
#pragma unroll
        for (int j = L - 1; j >= 0; --j) {
#pragma unroll
            for (int k = 0; k < n; ++k) if (!(k & (1 << j))) {
                const int e = ((k & ((1 << j) - 1)) << (L - 1 - j)) * (32 / n);
                const float2 a = x[k], b = x[k + (1 << j)];
                x[k] = make_float2(a.x + b.x, a.y + b.y);
                const float2 d = make_float2(a.x - b.x, a.y - b.y);
                if (e == 0) x[k + (1 << j)] = d;
                else if (e == 8) x[k + (1 << j)] = make_float2(d.y, -d.x);
                else x[k + (1 << j)] = make_float2(d.x * C32[e] + d.y * S32[e], d.y * C32[e] - d.x * S32[e]);
            }
        }
    } else {
#pragma unroll
        for (int j = 0; j < L; ++j) {
#pragma unroll
            for (int k = 0; k < n; ++k) if (!(k & (1 << j))) {
                const int e = ((k & ((1 << j) - 1)) << (L - 1 - j)) * (32 / n);
                const float2 a = x[k], b = x[k + (1 << j)];
                float2 t;
                if (e == 0) t = b;
                else if (e == 8) t = make_float2(-b.y, b.x);
                else t = make_float2(b.x * C32[e] - b.y * S32[e], b.y * C32[e] + b.x * S32[e]);
                x[k] = make_float2(a.x + t.x, a.y + t.y); x[k + (1 << j)] = make_float2(a.x - t.x, a.y - t.y);
            }
        }
    }
}
constexpr int rev_bits(int k, int L) { int r = 0; for (int j = 0; j < L; ++j) if (k & (1 << j)) r |= 1 << (L - 1 - j); return r; }
template <int L, bool INV> __device__ __forceinline__ void apply_tw(float2 (&x)[1 << L], int r, float inv_n) {
    float2 tw[L];
#pragma unroll
    for (int j = 0; j < L; ++j) tw[j] = unitrev((float)(r << j) * inv_n);
#pragma unroll
    for (int k = 1; k < (1 << L); ++k) {
#pragma unroll
        for (int j = 0; j < L; ++j) if ((rev_bits(k, L) >> j) & 1) x[k] = INV ? cmul(x[k], tw[j]) : cmulc(x[k], tw[j]);
    }
}
template <bool INV> __device__ __forceinline__ void fft_pass_a(float2* X, int tid) {
#pragma unroll 1
    for (int g = 0; g < 2; ++g) {
        const int r = tid + 512 * g; float2 x[16];
#pragma unroll
        for (int k = 0; k < 16; ++k) x[k] = X[fphys(r + k * 1024)];
        if (INV) { apply_tw<4, true>(x, r, 1.f / 16384.f); bfly<4, true>(x); }
        else { bfly<4, false>(x); apply_tw<4, false>(x, r, 1.f / 16384.f); }
#pragma unroll
        for (int k = 0; k < 16; ++k) X[fphys(r + k * 1024)] = x[k];
    }
}
template <bool INV> __device__ __forceinline__ void fft_pass_b(float2* X, int tid) {
    const int r = tid & 31, base = (tid >> 5) * 1024 + r; float2 x[32];
#pragma unroll
    for (int k = 0; k < 32; ++k) x[k] = X[fphys(base + k * 32)];
    if (INV) { apply_tw<5, true>(x, r, 1.f / 1024.f); bfly<5, true>(x); }
    else { bfly<5, false>(x); apply_tw<5, false>(x, r, 1.f / 1024.f); }
#pragma unroll
    for (int k = 0; k < 32; ++k) X[fphys(base + k * 32)] = x[k];
}
typedef _Float16 f16x2 __attribute__((ext_vector_type(2)));
__device__ __forceinline__ unsigned pack_h2(float2 v) { f16x2 h = {(_Float16)v.x, (_Float16)v.y}; return *reinterpret_cast<unsigned*>(&h); }
__device__ __forceinline__ float2 unpack_h2(unsigned u) { const f16x2 h = *reinterpret_cast<const f16x2*>(&u); return make_float2((float)h[0], (float)h[1]); }
template <class Gen> __device__ __forceinline__ void fwd_a(float2* X, Gen gen) {
    const int tid = opaque_tid();
#pragma unroll 1
    for (int g = 0; g < 2; ++g) {
        const int r = tid + 512 * g; float2 x[16];
#pragma unroll
        for (int k = 0; k < 16; ++k) x[k] = gen(r + k * 1024);
        bfly<4, false>(x); apply_tw<4, false>(x, r, 1.f / 16384.f);
#pragma unroll
        for (int k = 0; k < 16; ++k) X[fphys(r + k * 1024)] = x[k];
    }
}
template <class Out> __device__ __forceinline__ void inv_a(float2* X, Out out) {
    const int tid = opaque_tid();
#pragma unroll 1
    for (int g = 0; g < 2; ++g) {
        const int r = tid + 512 * g; float2 x[16];
#pragma unroll
        for (int k = 0; k < 16; ++k) x[k] = X[fphys(r + k * 1024)];
        apply_tw<4, true>(x, r, 1.f / 16384.f); bfly<4, true>(x);
        out(r, x);
    }
}
__device__ __forceinline__ void mid_c(float2* X, const unsigned* __restrict__ fs) {
    const int tid = opaque_tid();
    float2 x[32]; f32x4* p = reinterpret_cast<f32x4*>(X + fphys(tid * 32));
    const u32x4* fp = reinterpret_cast<const u32x4*>(fs + tid * 32);
    u32x4 fv[8];
#pragma unroll
    for (int k = 0; k < 8; ++k) fv[k] = fp[k];
#pragma unroll
    for (int k = 0; k < 16; ++k) { const f32x4 v = p[k]; x[2 * k] = make_float2(v[0], v[1]); x[2 * k + 1] = make_float2(v[2], v[3]); }
    bfly<5, false>(x);
#pragma unroll
    for (int k = 0; k < 32; ++k) x[k] = cmul(x[k], unpack_h2(fv[k >> 2][k & 3]));
    bfly<5, true>(x);
#pragma unroll
    for (int k = 0; k < 16; ++k) { f32x4 v = {x[2 * k].x, x[2 * k].y, x[2 * k + 1].x, x[2 * k + 1].y}; p[k] = v; }
}
__device__ __forceinline__ void spec_c(float2* X, unsigned* __restrict__ fs, float scl) {
    const int tid = opaque_tid();
    float2 x[32]; const f32x4* p = reinterpret_cast<const f32x4*>(X + fphys(tid * 32));
#pragma unroll
    for (int k = 0; k < 16; ++k) { const f32x4 v = p[k]; x[2 * k] = make_float2(v[0], v[1]); x[2 * k + 1] = make_float2(v[2], v[3]); }
    bfly<5, false>(x);
    u32x4* fp = reinterpret_cast<u32x4*>(fs + tid * 32);
#pragma unroll
    for (int k = 0; k < 8; ++k) { u32x4 w;
#pragma unroll
        for (int j = 0; j < 4; ++j) w[j] = pack_h2(make_float2(x[4 * k + j].x * scl, x[4 * k + j].y * scl));
        fp[k] = w; }
}
__device__ __forceinline__ void fwd_b(float2* X) { fft_pass_b<false>(X, opaque_tid()); }
__device__ __forceinline__ void inv_b(float2* X) { fft_pass_b<true>(X, opaque_tid()); }

__device__ __forceinline__ float block_sum(float v, float* red) {
    v = wave_sum(v);
    __syncthreads();
    { const int tid_ = TIDX; if ((tid_ & 63) == 0) red[tid_ >> 6] = v; }
    __syncthreads();
    float s = 0.f;
#pragma unroll
    for (int i = 0; i < 8; ++i) s += red[i];
    return s;
}
__device__ __forceinline__ float sconv(const unsigned short* __restrict__ p, int t, int n, float w0, float w1, float w2, float cb) {
    const float a = (t > 0) ? bf2f(p[t - 1]) : 0.f, b = bf2f(p[t]), c = (t < n - 1) ? bf2f(p[t + 1]) : 0.f;
    return a * w0 + b * w1 + c * w2 + cb;
}
__device__ __forceinline__ void hy_stage_conv(const Ctx& F, const bf16* __restrict__ PT, int ch, unsigned* __restrict__ dst) {
    unsigned short* rows = (unsigned short*)F.lds;
    const float w0 = F.in[I_HCW][ch], w1 = F.in[I_HCW][3072 + ch], w2 = F.in[I_HCW][6144 + ch], cb = F.in[I_HCB][ch];
    __syncthreads();
#pragma unroll
    for (int b = 0; b < 2; ++b) {
        const u32x4* s = reinterpret_cast<const u32x4*>(PT + (size_t)ch * MALL + b * NTOK + CTX);
        u32x4* d = reinterpret_cast<u32x4*>(rows + b * (FN + 16) + 8);
#pragma unroll
        for (int k = 0; k < 4; ++k) d[F.tid + 512 * k] = s[F.tid + 512 * k];
        if (F.tid == 0) { rows[b * (FN + 16) + 7] = 0; rows[b * (FN + 16) + 8 + FN] = 0; }
    }
    __syncthreads();
#pragma unroll 4
    for (int k = 0; k < 32; ++k) { const int i = F.tid + 512 * k;
        const unsigned short* r0 = rows + 8 + i; const unsigned short* r1 = r0 + (FN + 16);
        dst[i] = pack_h2(make_float2(bf2f(r0[-1]) * w0 + bf2f(r0[0]) * w1 + bf2f(r0[1]) * w2 + cb, bf2f(r1[-1]) * w0 + bf2f(r1[0]) * w1 + bf2f(r1[1]) * w2 + cb)); }
    __syncthreads();
}
__device__ __forceinline__ void hyena_channel_latent(const Ctx& F, int c, const bf16* __restrict__ PT, const bf16* __restrict__ HT, bf16* __restrict__ ZT, unsigned* __restrict__ WG) {
    float2* X = (float2*)F.lds; float* red = (float*)(F.lds + FFT_LDS);
    unsigned* FS = WG; unsigned* U = WG + 4 * FN; unsigned* G1 = WG + 5 * FN; unsigned* G2 = WG + 6 * FN; unsigned* SC0 = WG + 7 * FN; unsigned* SC1 = WG + 8 * FN;
    hy_stage_conv(F, PT, c, U); hy_stage_conv(F, PT, 1024 + c, G1); hy_stage_conv(F, PT, 2048 + c, G2);
#pragma unroll 1
    for (int o = 0; o < 2; ++o) {
        const unsigned short* hf = (const unsigned short*)HT + (size_t)((o * 2 + 0) * 1024 + c) * FN; const unsigned short* hb = (const unsigned short*)HT + (size_t)((o * 2 + 1) * 1024 + c) * FN;
        float asum = 0.f;
        fwd_a(X, [&](int i) { const float a = bf2f(hf[i]), b = i ? bf2f(hb[FN - i]) : 0.f; asum += fabsf(a) + fabsf(b); return make_float2(a + b, 0.f); });
        const float nrm = block_sum(asum, red), scl = 1.f / (2.f * (float)FN * nrm);
        fwd_b(X); __syncthreads(); spec_c(X, FS + (o * 2 + 0) * FN, scl); __syncthreads();
        fwd_a(X, [&](int i) { const float d = bf2f(hf[i]) - (i ? bf2f(hb[FN - i]) : 0.f); const float2 w = unitrev((float)i * (0.5f / (float)FN)); return make_float2(d * w.x, d * w.y); });
        __syncthreads(); fwd_b(X); __syncthreads(); spec_c(X, FS + (o * 2 + 1) * FN, scl); __syncthreads();
    }
    const float bias0 = F.in[I_HFB][c], bias1 = F.in[I_HFB][1024 + c];
    fwd_a(X, [&](int i) { return unpack_h2(U[i]); });
    __syncthreads(); fwd_b(X); __syncthreads(); mid_c(X, FS + 0 * FN); __syncthreads(); inv_b(X); __syncthreads();
    inv_a(X, [&](int r, float2 (&x)[16]) {
        unsigned uw[16];
#pragma unroll
        for (int k = 0; k < 16; ++k) uw[k] = U[r + k * 1024];
#pragma unroll
        for (int k = 0; k < 16; ++k) SC0[r + k * 1024] = pack_h2(x[k]);
#pragma unroll
        for (int k = 0; k < 16; ++k) x[k] = cmul(unpack_h2(uw[k]), unitrev((float)(r + k * 1024) * (0.5f / (float)FN)));
        bfly<4, false>(x); apply_tw<4, false>(x, r, 1.f / 16384.f);
#pragma unroll
        for (int k = 0; k < 16; ++k) X[fphys(r + k * 1024)] = x[k]; });
    __syncthreads(); fwd_b(X); __syncthreads(); mid_c(X, FS + 1 * FN); __syncthreads(); inv_b(X); __syncthreads();
    inv_a(X, [&](int r, float2 (&x)[16]) {
        unsigned ycw[16], uw[16], gw[16];
#pragma unroll
        for (int k = 0; k < 16; ++k) { const int i = r + k * 1024; ycw[k] = SC0[i]; uw[k] = U[i]; gw[k] = G1[i]; }
#pragma unroll
        for (int k = 0; k < 16; ++k) { const int i = r + k * 1024;
            const float2 yn = cmulc(x[k], unitrev((float)i * (0.5f / (float)FN))), yc = unpack_h2(ycw[k]), u = unpack_h2(uw[k]), g = unpack_h2(gw[k]);
            const float2 z = make_float2(g.x * (yc.x + yn.x + u.x * bias0), g.y * (yc.y + yn.y + u.y * bias0));
            SC1[i] = pack_h2(z); x[k] = z; }
        bfly<4, false>(x); apply_tw<4, false>(x, r, 1.f / 16384.f);
#pragma unroll
        for (int k = 0; k < 16; ++k) X[fphys(r + k * 1024)] = x[k]; });
    __syncthreads(); fwd_b(X); __syncthreads(); mid_c(X, FS + 2 * FN); __syncthreads(); inv_b(X); __syncthreads();
    inv_a(X, [&](int r, float2 (&x)[16]) {
        unsigned uw[16];
#pragma unroll
        for (int k = 0; k < 16; ++k) uw[k] = SC1[r + k * 1024];
#pragma unroll
        for (int k = 0; k < 16; ++k) SC0[r + k * 1024] = pack_h2(x[k]);
#pragma unroll
        for (int k = 0; k < 16; ++k) x[k] = cmul(unpack_h2(uw[k]), unitrev((float)(r + k * 1024) * (0.5f / (float)FN)));
        bfly<4, false>(x); apply_tw<4, false>(x, r, 1.f / 16384.f);
#pragma unroll
        for (int k = 0; k < 16; ++k) X[fphys(r + k * 1024)] = x[k]; });
    __syncthreads(); fwd_b(X); __syncthreads(); mid_c(X, FS + 3 * FN); __syncthreads(); inv_b(X); __syncthreads();
    unsigned short* zt = (unsigned short*)ZT + (size_t)c * MALL + CTX;
    inv_a(X, [&](int r, float2 (&x)[16]) {
        unsigned ycw[16], uw[16], gw[16];
#pragma unroll
        for (int k = 0; k < 16; ++k) { const int i = r + k * 1024; ycw[k] = SC0[i]; uw[k] = SC1[i]; gw[k] = G2[i]; }
#pragma unroll
        for (int k = 0; k < 16; ++k) { const int i = r + k * 1024;
            const float2 yn = cmulc(x[k], unitrev((float)i * (0.5f / (float)FN))), yc = unpack_h2(ycw[k]), u = unpack_h2(uw[k]), g = unpack_h2(gw[k]);
            zt[i] = f2bf(g.x * (yc.x + yn.x + u.x * bias1)); zt[NTOK + i] = f2bf(g.y * (yc.y + yn.y + u.y * bias1)); } });
    __syncthreads();
}
__device__ __forceinline__ void hyena_channel_ctx(const Ctx& F, int c, const bf16* __restrict__ PT, bf16* __restrict__ ZT) {
    float* base = (float*)F.lds; float* filt = base;
    float* uv = base + 1024; float* ux1 = uv + 512; float* ux2 = ux1 + 512; float* zz = ux2 + 512; float* red = zz + 512;
    const int tid = F.tid, b = tid >> 8, t = tid & 255;
    const float* A2C = (const float*)(F.ws + WS_A2C); const float* w3 = F.in[I_HW3];
    const float* cw = F.in[I_HCW]; const float* cbp = F.in[I_HCB];
    __syncthreads();
    {
        const float delta = fabsf(-3.0701134573253944f + (-15.350567286626972f + 3.0701134573253944f) * ((float)c * (1.f / 1023.f)));
        const float win = __expf(-((float)t * (1.f / 255.f)) * delta);
        const int o = b;
        float hf = 0.f, hb = 0.f;
        for (int k = 0; k < 64; ++k) { const float a = A2C[t * 64 + k]; hf += a * w3[k * 4096 + (o * 2 + 0) * 1024 + c]; hb += a * w3[k * 4096 + (o * 2 + 1) * 1024 + c]; }
        filt[(o * 2 + 0) * 256 + t] = hf * win; filt[(o * 2 + 1) * 256 + t] = hb * win;
    }
    {
        const unsigned short* pv = (const unsigned short*)PT + (size_t)c * MALL + b * NTOK;
        uv[tid] = sconv(pv, t, CTX, cw[c], cw[3072 + c], cw[6144 + c], cbp[c]);
        ux1[tid] = sconv(pv + (size_t)1024 * MALL, t, CTX, cw[1024 + c], cw[3072 + 1024 + c], cw[6144 + 1024 + c], cbp[1024 + c]);
        ux2[tid] = sconv(pv + (size_t)2048 * MALL, t, CTX, cw[2048 + c], cw[3072 + 2048 + c], cw[6144 + 2048 + c], cbp[2048 + c]);
    }
    __syncthreads();
    float nrm[2];
#pragma unroll
    for (int o = 0; o < 2; ++o) { const float s = (tid < 256) ? fabsf(filt[(o * 2) * 256 + tid]) + (tid ? fabsf(filt[(o * 2 + 1) * 256 + tid]) : 0.f) : 0.f; nrm[o] = block_sum(s, red); }
    float* src = uv;
#pragma unroll 1
    for (int o = 0; o < 2; ++o) {
        const float* hf = filt + (o * 2) * 256; const float* hb = hf + 256; const float* u = src + b * 256;
        float y = 0.f;
        for (int s = 0; s <= t; ++s) y += u[s] * hf[t - s];
        for (int s = t + 1; s < 256; ++s) y += u[s] * hb[s - t];
        y = y / nrm[o] + u[t] * F.in[I_HFB][o * 1024 + c];
        const float g = (o == 0 ? ux1 : ux2)[tid] * y;
        __syncthreads();
        zz[tid] = g; src = zz;
        __syncthreads();
    }
    ((unsigned short*)ZT)[(size_t)c * MALL + b * NTOK + t] = f2bf(zz[tid]);
    __syncthreads();
}
__device__ __forceinline__ void ph_hyena_core(const Ctx& F, bool need_ctx, const bf16* PT, const bf16* HT, bf16* ZT, unsigned* WGS) {
    for (int c = F.bid; c < 1024; c += F.G) {
        hyena_channel_latent(F, c, PT, HT, ZT, WGS + (size_t)F.bid * 9 * FN);
        if (need_ctx) hyena_channel_ctx(F, c, PT, ZT);
    }
}
__device__ __forceinline__ void ph_transpose_z(const Ctx& F, const bf16* __restrict__ ZT, bf16* __restrict__ Z) {
    unsigned short* t = (unsigned short*)F.lds;
    const int ntile = (1024 / 64) * (MALL / 64);
    const int cc = F.tid >> 3, r8 = (F.tid & 7) * 8;
    bf16x8 v = {}, vn = {};
    if (F.bid < ntile) v = *reinterpret_cast<const bf16x8*>(ZT + (size_t)((F.bid % 16) * 64 + cc) * MALL + (F.bid / 16) * 64 + r8);
    for (int i = F.bid; i < ntile; i += F.G) {
        const int c0 = (i % 16) * 64, r0 = (i / 16) * 64;
        __syncthreads();
#pragma unroll
        for (int j = 0; j < 8; ++j) t[(r8 + j) * 66 + cc] = (unsigned short)v[j];
        { const int in = i + F.G; if (in < ntile) vn = *reinterpret_cast<const bf16x8*>(ZT + (size_t)((in % 16) * 64 + cc) * MALL + (in / 16) * 64 + r8); }
        __syncthreads();
        { const int rr = F.tid >> 3, c8 = (F.tid & 7) * 8; bf16x8 w;
#pragma unroll
          for (int j = 0; j < 8; ++j) w[j] = (short)t[rr * 66 + c8 + j];
          *reinterpret_cast<bf16x8*>(Z + (size_t)(r0 + rr) * D + c0 + c8) = w; }
        v = vn;
    }
}

__global__ void __launch_bounds__(NTHR, 2) mega_fwd(Args args) {
    {
        const unsigned hw = (unsigned)__builtin_amdgcn_s_getreg((5 << 11) | 4) & 63u;
        if ((threadIdx.x & 63) == 0) *(volatile LAS int*)((LAS unsigned char*)lds_raw + LDS_WTAB + hw * 4) = (int)(threadIdx.x >> 6);
        __syncthreads();
    }
    Ctx F; F.in = args.in; F.out = args.out; F.ws = args.ws; F.lds = (char*)lds_raw;
    F.tid = opaque_tid(); F.lane = F.tid & 63; F.wave = F.tid >> 6; F.G = gridDim.x; F.bid = blockIdx.x;
    volatile LAS unsigned* bst = (volatile LAS unsigned*)(lds_raw + LDS_WTAB + 256);
    if (F.tid == 0) { bst[0] = 0u; bst[1] = 0u; bst[2] = 0u; bst[3] = 0u; }
    __syncthreads();
    XcdBarrier bar = xcd_barrier_post((unsigned*)(args.ws + WS_CTL), bst);
    const int lo = args.ph_lo, hi = args.ph_hi;
    int ph = 0;
#ifndef PH_MASK
#define PH_MASK 0xFFFFFFFFFFFFFFFFull
#endif
    int phc = 0;
#define PHASE(...) do { if (lo <= ph && ph < hi) { if ((PH_MASK >> (__COUNTER__ - CNT0 - 1)) & 1ull) { F.tid = opaque_tid(); F.lane = F.tid & 63; F.wave = F.tid >> 6;   __VA_ARGS__; } if (ph + 1 < hi) xcd_barrier(bar); } ++ph; } while (0)
    constexpr int CNT0 = __COUNTER__;

    PHASE((p0_prologue(F), hy_prologue(F)));
    bf16* const WT = (bf16*)(args.ws + WS_WT);
    bf16* const Hb = (bf16*)(args.ws + S_H);
    {
        bf16* QKV = (bf16*)(args.ws + S_QKV); bf16* AO = (bf16*)(args.ws + S_AO);
        PHASE(ph_modulate(F, 0, 0, Hb, true));
        PHASE(ph_gemm_qkv(F, 0, Hb, WT + WT_DAIN, QKV));
        PHASE(ph_attention(F, 0, 0, true, QKV, AO));
        PHASE(ph_gemm_resid(F, AO, D, WT + WT_DAOUT, D, 0, 2048, nullptr, true));
    }
#define MOE_PHASES(layer, need_ctx) do { \
        unsigned char* EXPW8 = (unsigned char*)(args.ws + S_EXPW); unsigned char* HID8 = (unsigned char*)(args.ws + S_HID); bf16* Yb = (bf16*)(args.ws + S_Y); unsigned char* H8 = (unsigned char*)Hb; \
        const int nrt = (need_ctx) ? 288 : 256; \
        PHASE(ph_ffn_modulate_router(F, layer, H8, need_ctx)); \
        PHASE((ph_topk(F, need_ctx), ph_cvt_experts(F, layer, EXPW8))); \
        PHASE(ph_moe_up(F, H8, EXPW8, HID8, nrt)); \
        PHASE(ph_moe_down(F, HID8, EXPW8, Yb, nrt)); \
        PHASE(ph_moe_combine(F, layer, Yb, need_ctx, (layer) < 3 ? (layer) + 1 : -1, Hb)); } while (0)
    MOE_PHASES(0, true);
    {
        bf16 *RQ = (bf16*)(args.ws + R_Q), *RKR = (bf16*)(args.ws + R_KR), *RKFT = (bf16*)(args.ws + R_KFT), *RKBT = (bf16*)(args.ws + R_KBT), *RVT = (bf16*)(args.ws + R_VT),
             *RSG = (bf16*)(args.ws + R_SG), *RST = (bf16*)(args.ws + R_ST), *RP = (bf16*)(args.ws + R_P), *RO = (bf16*)(args.ws + R_O);
        const RetC rc = ret_consts(F);
        PHASE({ const DenseSched S = dense_sched(F, Hb, D, WT + WT_RIN, D, MALL, 6144); const EpiRetIn E{RQ, RKR, RKFT, RKBT, RVT, RSG, rc, (const float*)(args.ws + WS_RROPE)}; gemm_phase<true>(F.lds, D, D, D, S, E); });
        PHASE({ { const RetPSched S{(const char*)RQ, (const char*)RKR, F.bid, F.G}; const EpiRetP E{RP, rc}; gemm_phase<true, RetPSched, EpiRetP, false, false, true>(F.lds, D, D, RCH, S, E); }
                { const RetSSched S{(const char*)RVT, (const char*)RKFT, (const char*)RKBT, F.bid, F.G}; const EpiRetS E{RST}; gemm_phase<true, RetSSched, EpiRetS, false, false, true>(F.lds, NTOK, NTOK, RCH, S, E); } });
        PHASE(ph_ret_scan(F, RST, rc));
        PHASE({ const RetOSched S{(const char*)RQ, (const char*)RP, (const char*)RST, (const char*)RVT, F.bid, F.G, 0}; const EpiRetO E{RO, rc}; gemm_phase<true, RetOSched, EpiRetO, false, false, true>(F.lds, D, NTOK, RCH, S, E); });
        PHASE(ph_ret_gate(F, RO, RSG));
        PHASE(ph_gemm_resid(F, RO, 2048, WT + WT_ROUT, 2048, 1, 2048, nullptr));
    }
    MOE_PHASES(1, true);
    {
        bf16 *PT = (bf16*)(args.ws + H_PT), *ZT = (bf16*)(args.ws + H_ZT), *Zb = (bf16*)(args.ws + H_Z), *HT = (bf16*)(args.ws + H_HT);
        PHASE({ { const DenseSched S = dense_sched(F, Hb, D, WT + WT_HIN, D, MALL, 3072); const EpiHyIn E{PT, F.in[I_HBIN]}; gemm_phase<false>(F.lds, D, D, D, S, E); }
                { const DenseSched S = dense_sched(F, (const bf16*)(args.ws + WS_W3P), 256, (const bf16*)(args.ws + WS_A2P), 256, 4096, FN); const EpiHyTaps E{HT}; gemm_phase<true, DenseSched, EpiHyTaps, false, false, true>(F.lds, 256, 256, 256, S, E); } });
        PHASE(ph_hyena_core(F, true, PT, HT, ZT, (unsigned*)(args.ws + H_WG)));
        PHASE(ph_transpose_z(F, ZT, Zb));
        PHASE(ph_gemm_resid(F, Zb, D, WT + WT_HOUT, D, 2, 2048, F.in[I_HBOUT]));
    }
    MOE_PHASES(2, true);
    {
        bf16* QKV = (bf16*)(args.ws + S_QKV); bf16* AO = (bf16*)(args.ws + S_AO);
        PHASE(ph_gemm_qkv(F, 1, Hb, WT + WT_DAIN + (size_t)3072 * 1024, QKV));
        PHASE(ph_attention(F, 3, 1, false, QKV, AO));
        PHASE(ph_gemm_resid(F, AO, D, WT + WT_DAOUT + (size_t)1024 * 1024, D, 3, 2048, nullptr, false, true));
    }
    MOE_PHASES(3, false);
}

extern "C" void kernel_launch(void* const* d_in, const int* in_sizes, int n_in, void* d_out, int out_size, void* d_ws, size_t ws_size, hipStream_t stream) {
    static int grid = 0;
    if (grid == 0) {
        if (n_in != N_IN || out_size != NB * SEQL * D || ws_size < WS_NEED) {
            fprintf(stderr, "kernel_launch: unexpected shapes: n_in %d out %d ws %zu (need %zu)\n", n_in, out_size, ws_size, (size_t)WS_NEED); grid = -1; return; }
        int dev = 0, cus = 0, per_cu = 0;
        if (hipGetDevice(&dev) != hipSuccess || hipDeviceGetAttribute(&cus, hipDeviceAttributeMultiprocessorCount, dev) != hipSuccess) { grid = -1; return; }
        if (hipFuncSetAttribute((const void*)mega_fwd, hipFuncAttributeMaxDynamicSharedMemorySize, LDS_BYTES) != hipSuccess) { fprintf(stderr, "kernel_launch: LDS attribute failed\n"); grid = -1; return; }
        if (hipOccupancyMaxActiveBlocksPerMultiprocessor(&per_cu, (const void*)mega_fwd, NTHR, LDS_BYTES) != hipSuccess || per_cu < 1)
            fprintf(stderr, "kernel_launch: occupancy query says %d\n", per_cu);
        (void)hipGetLastError();
        grid = cus;
    }
    if (grid < 0) return;
    (void)hipMemsetAsync((char*)d_ws + WS_CTL, 0, 65536, stream);
    Args a{};
    for (int i = 0; i < N_IN; ++i) a.in[i] = (const float*)d_in[i];
    a.out = (float*)d_out; a.ws = (unsigned char*)d_ws; a.ph_lo = 0; a.ph_hi = 1000;
    hipLaunchKernelGGL(mega_fwd, dim3(grid), dim3(NTHR), LDS_BYTES, stream, a);
    const hipError_t le = hipPeekAtLastError();
    if (le != hipSuccess) fprintf(stderr, "kernel_launch: launch failed: %s\n", hipGetErrorName(le));
}
```
